# Optimizing an MI355X kernel written in HIP

```python
import numpy as np
import jax
import jax.numpy as jnp
from jax import lax

D_MODEL = 1024
BATCH = 4
SEQ = 8192
DEPTH = 1

HEAD_DIM = 64
NSA_HEADS = 8
NSA_KV_HEADS = 2
NSA_GROUP = NSA_HEADS // NSA_KV_HEADS
MOBA_HEADS = 8
D_NSA = NSA_HEADS * HEAD_DIM
D_NSA_KV = NSA_KV_HEADS * HEAD_DIM
D_MOBA = MOBA_HEADS * HEAD_DIM
D_MIX = D_NSA + D_MOBA
N_NSA_BRANCHES = 3
ROPE_THETA = 500000.0
ROPE_DIM = HEAD_DIM // 4
CMP_BLOCK = 32
CMP_STRIDE = 16
CMP_HIDDEN = 4 * HEAD_DIM
SEL_BLOCK = 64
SEL_TOPK = 16
WINDOW = 512
NSA_Q_CHUNK = 64
MOBA_BLOCK = 256
MOBA_TOPK = 3
MOBA_Q_CHUNK = 32
LN_EPS = 1e-5
DEEPNORM_ALPHA = (2.0 * DEPTH) ** 0.25
DEEPNORM_BETA = (8.0 * DEPTH) ** -0.25
NEG_BIG = -1e30
POS_BIG = 1e30

PROJ_SIZES = (D_NSA, D_NSA_KV, D_NSA_KV, D_NSA_KV, D_NSA_KV, D_NSA_KV, D_NSA_KV,
              N_NSA_BRANCHES * NSA_HEADS, D_NSA, D_MOBA, D_MOBA, D_MOBA, D_MOBA)
VALUE_SLOTS = (2, 4, 6, 11)
D_PROJ = sum(PROJ_SIZES)
PROJ_OFFSETS = tuple(int(o) for o in np.cumsum(PROJ_SIZES)[:-1])

kernel_name = "hymba_nsa_moba_deepnorm_block"


def rope_tables(T):
    inv_freq = ROPE_THETA ** (-jnp.arange(0, ROPE_DIM, 2, dtype=jnp.float32) / ROPE_DIM)
    ang = jnp.arange(T, dtype=jnp.float32)[:, None] * inv_freq[None, :]
    return jnp.cos(ang), jnp.sin(ang)


def partial_rope(x, cos, sin):
    half = ROPE_DIM // 2
    xr = x[..., :ROPE_DIM].astype(jnp.float32)
    x1, x2 = xr[..., :half], xr[..., half:]
    c = cos[None, :, None, :]
    s = sin[None, :, None, :]
    rot = jnp.concatenate([x1 * c - x2 * s, x2 * c + x1 * s], axis=-1).astype(x.dtype)
    return jnp.concatenate([rot, x[..., ROPE_DIM:]], axis=-1)


def masked_softmax(s, mask):
    s = jnp.where(mask, s.astype(jnp.float32), NEG_BIG)
    m = jnp.max(s, axis=-1, keepdims=True)
    e = jnp.where(mask, jnp.exp(s - m), 0.0)
    d = jnp.sum(e, axis=-1, keepdims=True)
    return e / jnp.where(d > 0, d, 1.0)


def layer_norm(h, gain, bias):
    hf = h.astype(jnp.float32)
    mu = jnp.mean(hf, axis=-1, keepdims=True)
    var = jnp.mean(jnp.square(hf - mu), axis=-1, keepdims=True)
    y = (hf - mu) * lax.rsqrt(var + LN_EPS) * gain.astype(jnp.float32) + bias.astype(jnp.float32)
    return y.astype(h.dtype)


def gather_blocks(blocks, idx):
    return jax.vmap(jax.vmap(lambda bl, ix: bl[ix]))(blocks, idx)


def compress(kv, pos, w1, b1, w2):
    B, T, G, d = kv.shape
    n_per = CMP_BLOCK // CMP_STRIDE
    nc0 = T // CMP_STRIDE
    nc = nc0 - n_per + 1
    ch = kv.reshape(B, nc0, CMP_STRIDE, G, d)
    blocks = jnp.concatenate([ch[:, i:i + nc] for i in range(n_per)], axis=2)
    blocks = blocks + pos[None, None, :, None, :]
    flat = blocks.transpose(0, 3, 1, 2, 4).reshape(B, G, nc, CMP_BLOCK * d)
    return jax.nn.silu(flat @ w1 + b1) @ w2


def nsa_attention(q, k_cmp, v_cmp, k_slc, v_slc, k_win, v_win, gate_logits,
                  cmp_pos_k, cmp_w1_k, cmp_b1_k, cmp_w2_k,
                  cmp_pos_v, cmp_w1_v, cmp_b1_v, cmp_w2_v, cos, sin):
    B, T = q.shape[0], q.shape[1]
    G, R, d = NSA_KV_HEADS, NSA_GROUP, HEAD_DIM
    scale = d ** -0.5

    def to_groups(a):
        return a.reshape(B, T, G, R, d).transpose(0, 2, 3, 1, 4)

    q_raw = to_groups(q)
    q_rot = to_groups(partial_rope(q, cos, sin))

    kc = compress(k_cmp, cmp_pos_k, cmp_w1_k, cmp_b1_k, cmp_w2_k)
    vc = compress(v_cmp, cmp_pos_v, cmp_w1_v, cmp_b1_v, cmp_w2_v)
    nc = kc.shape[2]
    ns = T // SEL_BLOCK
    ks = partial_rope(k_slc, cos, sin).transpose(0, 2, 1, 3).reshape(B, G, ns, SEL_BLOCK, d)
    vs = v_slc.transpose(0, 2, 1, 3).reshape(B, G, ns, SEL_BLOCK, d)
    pad = ((0, 0), (0, 0), (WINDOW, 0), (0, 0))
    kw = jnp.pad(partial_rope(k_win, cos, sin).transpose(0, 2, 1, 3), pad)
    vw = jnp.pad(v_win.transpose(0, 2, 1, 3), pad)
    gates = jax.nn.sigmoid(gate_logits.astype(jnp.float32)).reshape(B, T, G, R, N_NSA_BRANCHES)
    gates = gates.transpose(0, 2, 3, 1, 4)

    c_start = jnp.arange(nc)[:, None] * CMP_STRIDE
    s_start = jnp.arange(ns)[None, :] * SEL_BLOCK
    overlap = ((c_start < s_start + SEL_BLOCK) & (c_start + CMP_BLOCK > s_start)).astype(jnp.float32)
    cmp_end = jnp.arange(nc) * CMP_STRIDE + CMP_BLOCK - 1
    n_sel = min(SEL_TOPK, ns)
    Qc = NSA_Q_CHUNK
    blk_ids = jnp.arange(ns)

    def chunk(c):
        s0 = c * Qc
        t = s0 + jnp.arange(Qc)
        qr = lax.dynamic_slice_in_dim(q_rot, s0, Qc, axis=3)
        qn = lax.dynamic_slice_in_dim(q_raw, s0, Qc, axis=3)
        g = lax.dynamic_slice_in_dim(gates, s0, Qc, axis=3)

        sc = jnp.einsum('bghqd,bgcd->bghqc', qn, kc) * scale
        pc = masked_softmax(sc, cmp_end[None, :] <= t[:, None])
        o_cmp = jnp.einsum('bghqc,bgcd->bghqd', pc.astype(vc.dtype), vc)

        imp = jnp.einsum('bghqc,cs->bgqs', pc, overlap)
        qblk = (t // SEL_BLOCK)[:, None]
        forced = (blk_ids[None, :] == 0) | (blk_ids[None, :] == qblk) | (blk_ids[None, :] == qblk - 1)
        imp = jnp.where(forced, POS_BIG, jnp.where(blk_ids[None, :] > qblk, NEG_BIG, imp))
        _, idx = lax.top_k(imp, n_sel)
        gk = gather_blocks(ks, idx)
        gv = gather_blocks(vs, idx)
        kpos = idx[..., None] * SEL_BLOCK + jnp.arange(SEL_BLOCK)
        ms = (kpos <= t[None, None, :, None, None]).reshape(B, G, 1, Qc, n_sel * SEL_BLOCK)
        ss = jnp.einsum('bghqd,bgqnld->bghqnl', qr, gk) * scale
        ps = masked_softmax(ss.reshape(B, G, R, Qc, n_sel * SEL_BLOCK), ms)
        ps = ps.reshape(ss.shape).astype(gv.dtype)
        o_slc = jnp.einsum('bghqnl,bgqnld->bghqd', ps, gv)

        kwin = lax.dynamic_slice_in_dim(kw, s0, Qc + WINDOW, axis=2)
        vwin = lax.dynamic_slice_in_dim(vw, s0, Qc + WINDOW, axis=2)
        kpos_w = (s0 - WINDOW + jnp.arange(Qc + WINDOW))[None, :]
        mw = (kpos_w <= t[:, None]) & (kpos_w > t[:, None] - WINDOW) & (kpos_w >= 0)
        sw = jnp.einsum('bghqd,bgkd->bghqk', qr, kwin) * scale
        pw = masked_softmax(sw, mw).astype(vwin.dtype)
        o_win = jnp.einsum('bghqk,bgkd->bghqd', pw, vwin)

        o = g[..., 0:1] * o_cmp + g[..., 1:2] * o_slc + g[..., 2:3] * o_win
        return o.astype(q.dtype)

    out = lax.map(chunk, jnp.arange(T // Qc))
    return out.transpose(1, 0, 4, 2, 3, 5).reshape(B, T, D_NSA)


def moba_attention(q, k, v, cos, sin):
    B, T = q.shape[0], q.shape[1]
    H, d, MB = MOBA_HEADS, HEAD_DIM, MOBA_BLOCK
    scale = d ** -0.5
    nb = max(-(-T // MB), 2)
    Tp = nb * MB
    pad = ((0, 0), (0, Tp - T), (0, 0), (0, 0))
    qp = jnp.pad(partial_rope(q, cos, sin), pad).transpose(0, 2, 1, 3)
    kp = jnp.pad(partial_rope(k, cos, sin), pad).transpose(0, 2, 1, 3)
    vp = jnp.pad(v, pad).transpose(0, 2, 1, 3)
    kb = kp.reshape(B, H, nb, MB, d)
    vb = vp.reshape(B, H, nb, MB, d)
    kmean = jnp.mean(kb.astype(jnp.float32), axis=3)
    k_top = min(MOBA_TOPK, nb - 1)
    Qc = MOBA_Q_CHUNK
    blk_ids = jnp.arange(nb)

    def chunk(c):
        s0 = c * Qc
        own = s0 // MB
        t = s0 + jnp.arange(Qc)
        qc = lax.dynamic_slice_in_dim(qp, s0, Qc, axis=2)
        sg = jnp.einsum('bhqd,bhnd->bhqn', qc.astype(jnp.float32), kmean)
        sg = jnp.where(blk_ids < own, sg, NEG_BIG)
        _, idx = lax.top_k(sg, k_top)
        valid = idx < own
        gk = gather_blocks(kb, idx)
        gv = gather_blocks(vb, idx)
        sp = jnp.einsum('bhqd,bhqnld->bhqnl', qc, gk).reshape(B, H, Qc, k_top * MB)
        mp = jnp.broadcast_to(valid[..., None], (B, H, Qc, k_top, MB)).reshape(B, H, Qc, k_top * MB)
        ko = lax.dynamic_slice_in_dim(kp, own * MB, MB, axis=2)
        vo = lax.dynamic_slice_in_dim(vp, own * MB, MB, axis=2)
        so = jnp.einsum('bhqd,bhld->bhql', qc, ko)
        mo = jnp.broadcast_to((own * MB + jnp.arange(MB))[None, :] <= t[:, None], so.shape)
        s = jnp.concatenate([sp, so], axis=-1) * scale
        m = jnp.concatenate([mp, mo], axis=-1)
        p = masked_softmax(s, m).astype(v.dtype)
        pp = p[..., :k_top * MB].reshape(B, H, Qc, k_top, MB)
        o = jnp.einsum('bhqnl,bhqnld->bhqd', pp, gv) + jnp.einsum('bhql,bhld->bhqd', p[..., k_top * MB:], vo)
        return o.astype(q.dtype)

    out = lax.map(chunk, jnp.arange(Tp // Qc))
    return out.transpose(1, 0, 3, 2, 4).reshape(B, Tp, D_MOBA)[:, :T]


def hybrid_layer(x, w_in, cmp_pos_k, cmp_w1_k, cmp_b1_k, cmp_w2_k,
                 cmp_pos_v, cmp_w1_v, cmp_b1_v, cmp_w2_v, w_out, ln_gain, ln_bias, cos, sin):
    B, T, _ = x.shape
    proj = x @ w_in
    (nsa_q, nsa_kc, nsa_vc, nsa_ks, nsa_vs, nsa_kw, nsa_vw, nsa_g, nsa_z,
     moba_q, moba_k, moba_v, moba_z) = jnp.split(proj, list(PROJ_OFFSETS), axis=-1)

    def heads(a, h):
        return a.reshape(B, T, h, HEAD_DIM)

    y_nsa = nsa_attention(heads(nsa_q, NSA_HEADS),
                          heads(nsa_kc, NSA_KV_HEADS), heads(nsa_vc, NSA_KV_HEADS),
                          heads(nsa_ks, NSA_KV_HEADS), heads(nsa_vs, NSA_KV_HEADS),
                          heads(nsa_kw, NSA_KV_HEADS), heads(nsa_vw, NSA_KV_HEADS),
                          nsa_g, cmp_pos_k, cmp_w1_k, cmp_b1_k, cmp_w2_k,
                          cmp_pos_v, cmp_w1_v, cmp_b1_v, cmp_w2_v, cos, sin)
    y_moba = moba_attention(heads(moba_q, MOBA_HEADS), heads(moba_k, MOBA_HEADS),
                            heads(moba_v, MOBA_HEADS), cos, sin)
    y = jnp.concatenate([y_nsa * jax.nn.silu(nsa_z), y_moba * jax.nn.silu(moba_z)], axis=-1)
    sub = y @ w_out
    return layer_norm(DEEPNORM_ALPHA * x + sub, ln_gain, ln_bias)


def setup_inputs(seed: int = 0) -> dict:
    key = jax.random.key(seed)
    ks = jax.random.split(key, 13)
    f32 = jnp.float32
    col_scale = np.ones((D_PROJ,), np.float32)
    starts = (0,) + PROJ_OFFSETS
    for slot in VALUE_SLOTS:
        col_scale[starts[slot]:starts[slot] + PROJ_SIZES[slot]] = DEEPNORM_BETA
    fan_c = CMP_BLOCK * HEAD_DIM
    x = jax.random.normal(ks[0], (BATCH, SEQ, D_MODEL), f32)
    w_in = jax.random.normal(ks[1], (DEPTH, D_MODEL, D_PROJ), f32) * (D_MODEL ** -0.5) * jnp.asarray(col_scale)
    cmp_pos_k = 0.02 * jax.random.normal(ks[2], (DEPTH, CMP_BLOCK, HEAD_DIM), f32)
    cmp_w1_k = jax.random.normal(ks[3], (DEPTH, fan_c, CMP_HIDDEN), f32) * fan_c ** -0.5
    cmp_b1_k = 0.01 * jax.random.normal(ks[4], (DEPTH, CMP_HIDDEN), f32)
    cmp_w2_k = jax.random.normal(ks[5], (DEPTH, CMP_HIDDEN, HEAD_DIM), f32) * CMP_HIDDEN ** -0.5
    cmp_pos_v = 0.02 * jax.random.normal(ks[6], (DEPTH, CMP_BLOCK, HEAD_DIM), f32)
    cmp_w1_v = jax.random.normal(ks[7], (DEPTH, fan_c, CMP_HIDDEN), f32) * fan_c ** -0.5
    cmp_b1_v = 0.01 * jax.random.normal(ks[8], (DEPTH, CMP_HIDDEN), f32)
    cmp_w2_v = jax.random.normal(ks[9], (DEPTH, CMP_HIDDEN, HEAD_DIM), f32) * CMP_HIDDEN ** -0.5
    w_out = jax.random.normal(ks[10], (DEPTH, D_MIX, D_MODEL), f32) * (D_MIX ** -0.5) * DEEPNORM_BETA
    ln_gain = 1.0 + 0.02 * jax.random.normal(ks[11], (DEPTH, D_MODEL), f32)
    ln_bias = 0.02 * jax.random.normal(ks[12], (DEPTH, D_MODEL), f32)
    return {"x": x, "w_in": w_in,
            "cmp_pos_k": cmp_pos_k, "cmp_w1_k": cmp_w1_k, "cmp_b1_k": cmp_b1_k, "cmp_w2_k": cmp_w2_k,
            "cmp_pos_v": cmp_pos_v, "cmp_w1_v": cmp_w1_v, "cmp_b1_v": cmp_b1_v, "cmp_w2_v": cmp_w2_v,
            "w_out": w_out, "ln_gain": ln_gain, "ln_bias": ln_bias}


def reference(x, w_in, cmp_pos_k, cmp_w1_k, cmp_b1_k, cmp_w2_k,
              cmp_pos_v, cmp_w1_v, cmp_b1_v, cmp_w2_v, w_out, ln_gain, ln_bias):
    cos, sin = rope_tables(x.shape[1])
    h = x
    for layer in range(DEPTH):
        h = hybrid_layer(h, w_in[layer],
                         cmp_pos_k[layer], cmp_w1_k[layer], cmp_b1_k[layer], cmp_w2_k[layer],
                         cmp_pos_v[layer], cmp_w1_v[layer], cmp_b1_v[layer], cmp_w2_v[layer],
                         w_out[layer], ln_gain[layer], ln_bias[layer], cos, sin)
    return h
```

```cpp
#include <hip/hip_runtime.h>
#include <hip/hip_cooperative_groups.h>
#include <cstdio>
#include <cstdint>
namespace cg = cooperative_groups;
#define DI __device__ __forceinline__
namespace pg8 {
#define PG8_LAS __attribute__((address_space(3)))
typedef unsigned short bf16_t;
typedef short bf16x8 __attribute__((ext_vector_type(8)));
typedef float f32x4 __attribute__((ext_vector_type(4)));
typedef unsigned u32x4 __attribute__((ext_vector_type(4)));
constexpr int BM = 256, BK = 64, HALF = 128, HTB = HALF * BK * 2  , STAGE_BYTES = 8 * HTB, NXCD = 8, WGM = 8;

__host__ __device__ __forceinline__ int lds_byte(int r, int c) { const int st = (r >> 4) * 2 + (c >> 5), rr = r & 15, cc = c & 31, ob = rr * 64 + cc * 2; return st * 1024 + (ob ^ (((ob >> 9) & 1) << 5)); }
__host__ __device__ __forceinline__ void stage_rc(int b, int& R, int& C) { const int st = b / 1024, sb = b % 1024, swz = sb ^ (((sb >> 9) & 1) << 5); R = (st >> 1) * 16 + swz / 64; C = (st & 1) * 32 + (swz % 64) / 2; }
__host__ __device__ __forceinline__ int perm32(int rho) { const int n = rho >> 4, i = rho & 15; return 8 * (i >> 2) + 4 * n + (i & 3); }

struct Unit { int pm, pn; };
struct Gemm { const bf16_t* A; const bf16_t* Bt; int M, N, K; };

struct StaticOrder {
    int nM, nN, nwg, G, c;
    __host__ __device__ void init(int M, int N, int G_, int c_) { nM = M / BM; nN = N / BM; nwg = nM * nN; G = G_; c = c_; }
    __host__ __device__ bool next(int i, Unit& u) const {
        const long L = (long)i * G + c; if (L >= nwg) return false;
        int wgid = (int)L; { const int q = nwg / NXCD, r = nwg % NXCD, xcd = wgid % NXCD, off = wgid / NXCD; wgid = (xcd < r ? xcd * (q + 1) : r * (q + 1) + (xcd - r) * q) + off; }
        const int nig = WGM * nN, gid = wgid / nig, fm = gid * WGM, gsz = (nM - fm) < WGM ? (nM - fm) : WGM;
        u.pm = fm + ((wgid % nig) % gsz); u.pn = (wgid % nig) / gsz; return true;
    }
    __device__ __forceinline__ void a_ready(const Unit&) const {}
    __device__ __forceinline__ void done(const Unit&) const {}
};

typedef float f32x2_t __attribute__((ext_vector_type(2))); typedef __bf16 bf16x2_t __attribute__((ext_vector_type(2)));
DI unsigned cvtpk(float lo, float hi) { f32x2_t v = {lo, hi}; bf16x2_t b = __builtin_convertvector(v, bf16x2_t); return __builtin_bit_cast(unsigned, b); }
DI float silu_f(float v) { return v / (1.0f + __expf(-v)); }
DI float sigm_f(float v) { return 1.0f / (1.0f + __expf(-v)); }
constexpr int SEQ = 8192;
struct EpiProj {
    static constexpr bool PERM = true, AFTER_DRAIN = false;
    bf16_t *QN, *QR, *KC, *VC, *KS, *VS, *KW, *VW, *ZS, *MQ, *MK, *MV; float* GT; const float* ROPE;
    DI void store8(bf16_t* dst, const float (&v)[8]) const { u32x4 w; w.x = cvtpk(v[0], v[1]); w.y = cvtpk(v[2], v[3]); w.z = cvtpk(v[4], v[5]); w.w = cvtpk(v[6], v[7]); *(u32x4*)dst = w; }
    DI void operator()(const f32x4 (&acc)[2][2][4][2], const Unit& u, int wr, int wc, int fr, int fq) const {
        const int pn = u.pn;
#pragma unroll
        for (int ai = 0; ai < 2; ++ai)
#pragma unroll
            for (int m = 0; m < 4; ++m) {
                const int row = u.pm * BM + ai * HALF + wr * 64 + m * 16 + fr; const int b = row >> 13, t = row & (SEQ - 1);
#pragma unroll
                for (int bj = 0; bj < 2; ++bj) {
                    const int col0 = bj * HALF + wc * 32 + 8 * fq; const int hd = col0 >> 6, d0 = col0 & 63;
                    float v[8];
#pragma unroll
                    for (int i = 0; i < 4; ++i) { v[i] = acc[ai][bj][m][0][i]; v[4 + i] = acc[ai][bj][m][1][i]; }
                    int kind = 0; bf16_t* dst = nullptr; bf16_t* dst2 = nullptr; float sc = 1.0f;
                    if (pn <= 1)      { kind = 1; sc = 0.125f; const size_t o = ((size_t)(b * 8 + pn * 4 + hd) * SEQ + t) * 64 + d0; dst = QR + o; dst2 = QN + o; }
                    else if (pn == 2) { const size_t o = ((size_t)(b * 2 + (hd & 1)) * SEQ + t) * 64 + d0; dst = (hd < 2 ? KC : VC) + o; }
                    else if (pn == 3) { const size_t o = ((size_t)(b * 2 + (hd & 1)) * SEQ + t) * 64 + d0; dst = (hd < 2 ? KS : VS) + o; kind = hd < 2 ? 1 : 0; }
                    else if (pn == 4) { const size_t o = ((size_t)(b * 2 + (hd & 1)) * SEQ + t) * 64 + d0; dst = (hd < 2 ? KW : VW) + o; kind = hd < 2 ? 1 : 0; }
                    else if (pn <= 6) { kind = 2; dst = ZS + (size_t)row * 1024 + (pn - 5) * 256 + col0; }
                    else if (pn <= 8) { kind = 1; sc = 0.125f; dst = MQ + ((size_t)(b * 8 + (pn - 7) * 4 + hd) * SEQ + t) * 64 + d0; }
                    else if (pn <= 10) { kind = 1; dst = MK + ((size_t)(b * 8 + (pn - 9) * 4 + hd) * SEQ + t) * 64 + d0; }
                    else if (pn <= 12) { dst = MV + ((size_t)(b * 8 + (pn - 11) * 4 + hd) * SEQ + t) * 64 + d0; }
                    else if (pn <= 14) { kind = 2; dst = ZS + (size_t)row * 1024 + 512 + (pn - 13) * 256 + col0; }
                    else kind = 3;
                    if (kind == 3) {
                        if (col0 < 24) {
#pragma unroll
                            for (int i = 0; i < 8; ++i) v[i] = sigm_f(v[i]);
                            float* gp = GT + (size_t)row * 32 + col0; *(f32x4*)gp = (f32x4){v[0], v[1], v[2], v[3]}; *(f32x4*)(gp + 4) = (f32x4){v[4], v[5], v[6], v[7]};
                        }
                        continue;
                    }
                    if (kind == 2) {
#pragma unroll
                        for (int i = 0; i < 8; ++i) v[i] = silu_f(v[i]);
                        store8(dst, v); continue;
                    }
                    if (sc != 1.0f) {
#pragma unroll
                        for (int i = 0; i < 8; ++i) v[i] *= sc;
                    }
                    if (kind == 1) {
                        if (dst2) store8(dst2, v);
                        if ((wc & 1) == 0) {
                            float pr[8];
#pragma unroll
                            for (int i = 0; i < 8; ++i) pr[i] = __shfl_xor(v[i], 16);
                            if (fq < 2) {
                                const f32x4 c0 = *(const f32x4*)(ROPE + (size_t)t * 16), c1 = *(const f32x4*)(ROPE + (size_t)t * 16 + 4), s0 = *(const f32x4*)(ROPE + (size_t)t * 16 + 8), s1 = *(const f32x4*)(ROPE + (size_t)t * 16 + 12);
                                const float sg = fq == 0 ? -1.0f : 1.0f;
#pragma unroll
                                for (int i = 0; i < 4; ++i) { v[i] = v[i] * c0[i] + sg * pr[i] * s0[i]; v[4 + i] = v[4 + i] * c1[i] + sg * pr[4 + i] * s1[i]; }
                            }
                        }
                    }
                    store8(dst, v);
                }
            }
    }
};
struct EpiOut {
    static constexpr bool PERM = false, AFTER_DRAIN = false;
    const float* X; float* O; float alpha;
    DI void operator()(const f32x4 (&acc)[2][2][4][2], const Unit& u, int wr, int wc, int fr, int fq) const {
#pragma unroll
        for (int ai = 0; ai < 2; ++ai)
#pragma unroll
            for (int m = 0; m < 4; ++m) {
                const size_t row = (size_t)(u.pm * BM + ai * HALF + wr * 64 + m * 16 + fr);
#pragma unroll
                for (int bj = 0; bj < 2; ++bj)
#pragma unroll
                    for (int n = 0; n < 2; ++n) { const size_t off = row * 1024 + u.pn * BM + bj * HALF + wc * 32 + n * 16 + 4 * fq; const f32x4 xv = *(const f32x4*)(X + off); *(f32x4*)(O + off) = xv * alpha + acc[ai][bj][m][n]; }
            }
    }
};
template <class Epi, class Sched, bool ALIGN_EPI = false, bool SP2 = false>
__device__ __forceinline__ void gemm_phase(PG8_LAS unsigned char* lds, const Gemm g, const Sched& S, const Epi& E) {
    const int tid = threadIdx.x, wid = __builtin_amdgcn_readfirstlane(tid >> 6), lane = tid & 63, wr = wid >> 2, wc = wid & 3, fr = lane & 15, fq = lane >> 4;
    const int K = g.K, nt = K / BK;
    unsigned voffA[2], voffB[2];
#pragma unroll
    for (int i = 0; i < 2; ++i) { int R, C; stage_rc(tid * 16 + i * 8192, R, C); const int Rb = Epi::PERM ? ((R & ~31) + perm32(R & 31)) : R;
        voffA[i] = (unsigned)(R * K + C) * 2u; voffB[i] = (unsigned)(Rb * K + C) * 2u; }
    const size_t kstep = (size_t)(BK * 2);
    const size_t hstep = (size_t)HALF * K * 2;
    const size_t tstep = 2 * hstep;
    const unsigned ldsw = (unsigned)wid * 1024u;
    const int aoff = lds_byte(wr * 64 + fr, fq * 8), boff = lds_byte(wc * 32 + fr, fq * 8);
#define PG8_SA(b, h) (((b) * 2 + (h)) * HTB)
#define PG8_SB(b, h) ((4 + (b) * 2 + (h)) * HTB)
#define PG8_STAGE(bufoff, gbase, voff) do { _Pragma("unroll") for (int _i = 0; _i < 2; ++_i) \
        __builtin_amdgcn_global_load_lds((const unsigned*)((const char*)(gbase) + (voff)[_i]), (PG8_LAS unsigned*)(lds + (bufoff) + ldsw + _i * 8192), 16, 0, 0); } while (0)
#define PG8_LDA(dst, b, h) do { _Pragma("unroll") for (int m = 0; m < 4; ++m) _Pragma("unroll") for (int k = 0; k < 2; ++k) dst[m][k] = *(const PG8_LAS bf16x8*)(lds + PG8_SA(b, h) + aoff + m * 2048 + k * 1024); } while (0)
#define PG8_LDB(dst, b, h) do { _Pragma("unroll") for (int n = 0; n < 2; ++n) _Pragma("unroll") for (int k = 0; k < 2; ++k) dst[n][k] = *(const PG8_LAS bf16x8*)(lds + PG8_SB(b, h) + boff + n * 2048 + k * 1024); } while (0)
#define PG8_MMA(ai, bj, At, Bt) do { __builtin_amdgcn_s_setprio(1); _Pragma("unroll") for (int m = 0; m < 4; ++m) _Pragma("unroll") for (int n = 0; n < 2; ++n) _Pragma("unroll") for (int k = 0; k < 2; ++k) \
        acc[ai][bj][m][n] = __builtin_amdgcn_mfma_f32_16x16x32_bf16(Bt[n][k], At[m][k], acc[ai][bj][m][n], 0, 0, 0); __builtin_amdgcn_s_setprio(0); } while (0)
#define PG8_WAIT_V(n) asm volatile("s_waitcnt vmcnt(" #n ")" ::: "memory")
#define PG8_WAIT_L(n) asm volatile("s_waitcnt lgkmcnt(" #n ")" ::: "memory")
#define PG8_BAR __builtin_amdgcn_s_barrier()
#define PG8_SCHED __builtin_amdgcn_sched_barrier(0)
    Unit cur, nxt; int ui = 0;
    if (!S.next(0, cur)) return;
    f32x4 acc[2][2][4][2];
#pragma unroll
    for (int a = 0; a < 2; ++a)
#pragma unroll
        for (int b = 0; b < 2; ++b)
#pragma unroll
            for (int m = 0; m < 4; ++m)
#pragma unroll
                for (int n = 0; n < 2; ++n) acc[a][b][m][n] = (f32x4){0.f, 0.f, 0.f, 0.f};
    bf16x8 At[4][2], B0[2][2], B1[2][2];
    const char* cA = (const char*)g.A + (size_t)cur.pm * tstep; const char* cB = (const char*)g.Bt + (size_t)cur.pn * tstep;
    S.a_ready(cur);
    if constexpr (SP2) {
        PG8_STAGE(PG8_SB(0, 0), cB, voffB); PG8_STAGE(PG8_SB(0, 1), cB + hstep, voffB); PG8_STAGE(PG8_SA(0, 0), cA, voffA); PG8_STAGE(PG8_SA(0, 1), cA + hstep, voffA);
        if (wr == 1) PG8_BAR;
        PG8_WAIT_V(2); PG8_BAR;
        PG8_STAGE(PG8_SB(1, 0), cB + kstep, voffB); PG8_STAGE(PG8_SA(1, 0), cA + kstep, voffA); PG8_STAGE(PG8_SB(1, 1), cB + hstep + kstep, voffB);
        PG8_WAIT_V(6); PG8_BAR;
    } else {
        PG8_STAGE(PG8_SB(0, 0), cB, voffB); PG8_STAGE(PG8_SA(0, 0), cA, voffA); PG8_STAGE(PG8_SB(0, 1), cB + hstep, voffB); PG8_STAGE(PG8_SA(0, 1), cA + hstep, voffA);
        if (wr == 1) PG8_BAR;
        PG8_WAIT_V(4); PG8_BAR;
        PG8_STAGE(PG8_SB(1, 0), cB + kstep, voffB); PG8_STAGE(PG8_SA(1, 0), cA + kstep, voffA); PG8_STAGE(PG8_SB(1, 1), cB + hstep + kstep, voffB);
        PG8_WAIT_V(6); PG8_BAR;
    }
    for (;;) {
        const bool has_next = S.next(ui + 1, nxt);
        const char* nA = has_next ? (const char*)g.A + (size_t)nxt.pm * tstep : cA; const char* nB = has_next ? (const char*)g.Bt + (size_t)nxt.pn * tstep : cB;
        for (int t = 0; t < nt; t += 2) {
            const bool last = (t == nt - 2);
            const char* a1 = cA + (size_t)(t + 1) * kstep;
            const char* a2 = last ? nA : cA + (size_t)(t + 2) * kstep; const char* b2 = last ? nB : cB + (size_t)(t + 2) * kstep;
            const char* a3 = a2 + kstep; const char* b3 = b2 + kstep;
            if (last && has_next) S.a_ready(nxt);
            if constexpr (SP2) {
            PG8_LDB(B0, 0, 0); PG8_LDB(B1, 0, 1); PG8_SCHED; PG8_LDA(At, 0, 0); PG8_STAGE(PG8_SA(1, 1), a1 + hstep, voffA);
            PG8_WAIT_V(8); PG8_WAIT_L(0); PG8_BAR; PG8_MMA(0, 0, At, B0); PG8_MMA(0, 1, At, B1); PG8_BAR; PG8_SCHED;
            PG8_LDA(At, 0, 1); PG8_STAGE(PG8_SB(0, 0), b2, voffB); PG8_STAGE(PG8_SB(0, 1), b2 + hstep, voffB); PG8_STAGE(PG8_SA(0, 0), a2, voffA);
            PG8_WAIT_V(8); PG8_WAIT_L(0); PG8_BAR; PG8_MMA(1, 0, At, B0); PG8_MMA(1, 1, At, B1); PG8_BAR; PG8_SCHED;
            PG8_LDB(B0, 1, 0); PG8_LDB(B1, 1, 1); PG8_SCHED; PG8_LDA(At, 1, 0); PG8_STAGE(PG8_SA(0, 1), a2 + hstep, voffA);
            PG8_WAIT_V(8); PG8_WAIT_L(0); PG8_BAR; PG8_MMA(0, 0, At, B0); PG8_MMA(0, 1, At, B1); PG8_BAR; PG8_SCHED;
            PG8_LDA(At, 1, 1); PG8_STAGE(PG8_SB(1, 0), b3, voffB); PG8_STAGE(PG8_SB(1, 1), b3 + hstep, voffB); PG8_STAGE(PG8_SA(1, 0), a3, voffA);
            PG8_WAIT_V(8); PG8_WAIT_L(0); PG8_BAR; PG8_MMA(1, 0, At, B0); PG8_MMA(1, 1, At, B1); PG8_BAR; PG8_SCHED;
            } else {
            PG8_LDB(B0, 0, 0); PG8_SCHED; PG8_LDA(At, 0, 0); PG8_STAGE(PG8_SA(1, 1), a1 + hstep, voffA);
            PG8_WAIT_L(8); PG8_BAR; PG8_WAIT_L(0); PG8_MMA(0, 0, At, B0); PG8_BAR; PG8_SCHED;
            PG8_LDB(B1, 0, 1); PG8_STAGE(PG8_SB(0, 0), b2, voffB);
            PG8_BAR; PG8_WAIT_L(0); PG8_MMA(0, 1, At, B1); PG8_BAR;
            PG8_LDA(At, 0, 1); PG8_STAGE(PG8_SA(0, 0), a2, voffA);
            PG8_BAR; PG8_WAIT_L(0); PG8_MMA(1, 0, At, B0); PG8_BAR; PG8_SCHED;
            PG8_STAGE(PG8_SB(0, 1), b2 + hstep, voffB);
            PG8_WAIT_V(6); PG8_BAR; PG8_MMA(1, 1, At, B1); PG8_BAR;
            PG8_LDB(B0, 1, 0); PG8_SCHED; PG8_LDA(At, 1, 0); PG8_STAGE(PG8_SA(0, 1), a2 + hstep, voffA);
            PG8_WAIT_L(8); PG8_BAR; PG8_WAIT_L(0); PG8_MMA(0, 0, At, B0); PG8_BAR; PG8_SCHED;
            PG8_LDB(B1, 1, 1); PG8_STAGE(PG8_SB(1, 0), b3, voffB);
            PG8_BAR; PG8_WAIT_L(0); PG8_MMA(0, 1, At, B1); PG8_BAR;
            PG8_LDA(At, 1, 1); PG8_STAGE(PG8_SA(1, 0), a3, voffA);
            PG8_BAR; PG8_WAIT_L(0); PG8_MMA(1, 0, At, B0); PG8_BAR; PG8_SCHED;
            PG8_STAGE(PG8_SB(1, 1), b3 + hstep, voffB);
            PG8_WAIT_V(6); PG8_BAR; PG8_MMA(1, 1, At, B1); PG8_BAR;
            }
        }
        if constexpr (ALIGN_EPI) { if (wr == 0) PG8_BAR; }
        if constexpr (!Epi::AFTER_DRAIN) { E(acc, cur, wr, wc, fr, fq); S.done(cur); }
        if (!has_next) break;
#pragma unroll
        for (int a = 0; a < 2; ++a)
#pragma unroll
            for (int b = 0; b < 2; ++b)
#pragma unroll
                for (int m = 0; m < 4; ++m)
#pragma unroll
                    for (int n = 0; n < 2; ++n) acc[a][b][m][n] = (f32x4){0.f, 0.f, 0.f, 0.f};
        cur = nxt; cA = nA; cB = nB; ++ui;
        if constexpr (ALIGN_EPI) { if (wr == 1) PG8_BAR; }
    }
    PG8_WAIT_V(0);
    if constexpr (!ALIGN_EPI) { if (wr == 0) PG8_BAR; }
    PG8_BAR;
    if constexpr (Epi::AFTER_DRAIN) { E.fused(acc, cur, wr, wc, fr, fq, lds, wid, lane); S.done(cur); }
#undef PG8_SA
#undef PG8_SB
#undef PG8_STAGE
#undef PG8_LDA
#undef PG8_LDB
#undef PG8_MMA
#undef PG8_WAIT_V
#undef PG8_WAIT_L
#undef PG8_BAR
#undef PG8_SCHED
}
}

namespace att {
using pg8::bf16_t; using pg8::bf16x8; using pg8::u32x4; using pg8::f32x4;
typedef float f32x16 __attribute__((ext_vector_type(16)));
typedef short s16x4 __attribute__((ext_vector_type(4)));
typedef short v4i16_t __attribute__((ext_vector_type(4)));
typedef unsigned u32x2 __attribute__((ext_vector_type(2)));
#define LAS __attribute__((address_space(3)))
typedef LAS char* lptr; typedef const LAS char* lcptr;
constexpr float L2E = 1.4426950408889634f;
constexpr float NEG_INIT = -1e30f;
constexpr int SEQ = 8192;
#define MFMA32(a, b, c) __builtin_amdgcn_mfma_f32_32x32x16_bf16((a), (b), (c), 0, 0, 0)
DI int crow(int r, int hi) { return (r & 3) + 8 * (r >> 2) + 4 * hi; }
DI s16x4 vtr(lcptr p) { return __builtin_bit_cast(s16x4, __builtin_amdgcn_ds_read_tr16_b64_v4i16((LAS v4i16_t*)p)); }
DI float xhalf(float v) { return __shfl_xor(v, 32); }
DI void stage_load(const bf16_t* Kt, const bf16_t* Vt, int wid, int lane, u32x4& kr, u32x4& vr, bool needV) {
    kr = *(const u32x4*)(Kt + lane * 64 + wid * 8);
    if (needV) vr = *(const u32x4*)(Vt + (16 * (wid & 3) + (lane >> 2)) * 64 + (wid >> 2) * 32 + (lane & 3) * 8);
}
DI void stage_write(lptr slot, int wid, int lane, const u32x4& kr, const u32x4& vr, bool needV) {
    *(LAS u32x4*)(slot + wid * 1024 + lane * 16) = kr;
    if (needV) *(LAS u32x4*)(slot + 8192 + wid * 1024 + lane * 16) = vr;
}
DI void qk_tile(f32x16& p0, f32x16& p1, lcptr Ks, const bf16x8 (&qr)[4], int r32, int hi) {
    lcptr kb = Ks + hi * 1024 + r32 * 16;
    f32x16 z;
#pragma unroll
    for (int i = 0; i < 16; ++i) z[i] = 0.f;
    p0 = z; p1 = z;
#pragma unroll
    for (int d0 = 0; d0 < 4; ++d0) {
        const bf16x8 b0 = *(const LAS bf16x8*)(kb + d0 * 2048), b1 = *(const LAS bf16x8*)(kb + d0 * 2048 + 512);
        p0 = MFMA32(b0, qr[d0], p0); p1 = MFMA32(b1, qr[d0], p1);
    }
}
DI bf16x8 pack8(const f32x16& p, int base) {
    u32x4 w; w.x = pg8::cvtpk(p[base], p[base + 1]); w.y = pg8::cvtpk(p[base + 2], p[base + 3]); w.z = pg8::cvtpk(p[base + 4], p[base + 5]); w.w = pg8::cvtpk(p[base + 6], p[base + 7]);
    return __builtin_bit_cast(bf16x8, w);
}
DI void pv_tile(f32x16 (&o)[2], lcptr Vs, const f32x16& p0, const f32x16& p1, int lane, int hi) {
    lcptr vb = Vs + ((lane >> 4) & 1) * 32 + (lane & 3) * 8 + (4 * hi + ((lane & 15) >> 2)) * 64;
    bf16x8 pf[4]; pf[0] = pack8(p0, 0); pf[1] = pack8(p0, 8); pf[2] = pack8(p1, 0); pf[3] = pack8(p1, 8);
#pragma unroll
    for (int dh = 0; dh < 2; ++dh)
#pragma unroll
        for (int ks = 0; ks < 4; ++ks) {
            const s16x4 lo = vtr(vb + dh * 4096 + ks * 1024), hh = vtr(vb + dh * 4096 + ks * 1024 + 512);
            const bf16x8 vf = (bf16x8){lo[0], lo[1], lo[2], lo[3], hh[0], hh[1], hh[2], hh[3]};
            o[dh] = MFMA32(vf, pf[ks], o[dh]);
        }
}
DI float mask_scale(f32x16& p0, f32x16& p1, int klo, int khi, int hi) {
    const bool full = (klo <= 0) && (khi >= 63), none = (khi < klo) || (khi < 0) || (klo > 63);
    float mx;
    if (__all(full || none)) {
        const float bias = full ? 0.f : -INFINITY;
        float a = fmaxf(p0[0], p1[0]);
#pragma unroll
        for (int r = 1; r < 16; ++r) a = fmaxf(a, fmaxf(p0[r], p1[r]));
#pragma unroll
        for (int r = 0; r < 16; ++r) { p0[r] = p0[r] * L2E + bias; p1[r] = p1[r] * L2E + bias; }
        mx = a * L2E + bias;
    } else {
        const int lo2 = klo - 4 * hi, hi2 = khi - 4 * hi;
        float a = -INFINITY;
#pragma unroll
        for (int r = 0; r < 16; ++r) { const int kc = (r & 3) + 8 * (r >> 2);
            p0[r] = (kc >= lo2 && kc <= hi2) ? p0[r] * L2E : -INFINITY; p1[r] = (kc + 32 >= lo2 && kc + 32 <= hi2) ? p1[r] * L2E : -INFINITY; a = fmaxf(a, fmaxf(p0[r], p1[r])); }
        mx = a;
    }
    return fmaxf(mx, xhalf(mx));
}
DI void tile_online(lcptr slot, const bf16x8 (&qr)[4], int klo, int khi, float& m, float& l, f32x16 (&o)[2], int lane, int r32, int hi) {
    { const bool none = (khi < klo) || (khi < 0) || (klo > 63); if (__all(none)) return; }
    f32x16 p0, p1; qk_tile(p0, p1, slot, qr, r32, hi);
    const float mt = mask_scale(p0, p1, klo, khi, hi);
    const float mn = fmaxf(m, mt), alpha = __builtin_amdgcn_exp2f(m - mn); m = mn;
    float s = 0.f;
#pragma unroll
    for (int r = 0; r < 16; ++r) { p0[r] = __builtin_amdgcn_exp2f(p0[r] - mn); p1[r] = __builtin_amdgcn_exp2f(p1[r] - mn); s += p0[r] + p1[r]; }
    l = l * alpha + s;
#pragma unroll
    for (int r = 0; r < 16; ++r) { o[0][r] *= alpha; o[1][r] *= alpha; }
    pv_tile(o, slot + 8192, p0, p1, lane, hi);
}
DI void tile_stats(lcptr slot, const bf16x8 (&qr)[4], int klo, int khi, float& m, float& l, int r32, int hi) {
    f32x16 p0, p1; qk_tile(p0, p1, slot, qr, r32, hi);
    const float mt = mask_scale(p0, p1, klo, khi, hi);
    const float mn = fmaxf(m, mt), alpha = __builtin_amdgcn_exp2f(m - mn); m = mn;
    float s = 0.f;
#pragma unroll
    for (int r = 0; r < 16; ++r) s += __builtin_amdgcn_exp2f(p0[r] - mn) + __builtin_amdgcn_exp2f(p1[r] - mn);
    l = l * alpha + s;
}
DI void tile_final(lcptr slot, const bf16x8 (&qr)[4], int klo, int khi, float m, float inv, f32x16 (&o)[2], float& carry, LAS float* imp_row  , bool writer, int lane, int r32, int hi) {
    f32x16 p0, p1; qk_tile(p0, p1, slot, qr, r32, hi);
    (void)mask_scale(p0, p1, klo, khi, hi);
#pragma unroll
    for (int r = 0; r < 16; ++r) { p0[r] = __builtin_amdgcn_exp2f(p0[r] - m) * inv; p1[r] = __builtin_amdgcn_exp2f(p1[r] - m) * inv; }
    float y3[8];
#pragma unroll
    for (int x = 0; x < 4; ++x) { y3[x] = xhalf(p0[4 * x + 3]); y3[4 + x] = xhalf(p1[4 * x + 3]); }
#pragma unroll
    for (int x = 0; x < 8; ++x) {
        const float bs = (x < 4) ? (p0[4 * x] + p0[4 * x + 1]) + (p0[4 * x + 2] + p0[4 * x + 3]) : (p1[4 * (x - 4)] + p1[4 * (x - 4) + 1]) + (p1[4 * (x - 4) + 2] + p1[4 * (x - 4) + 3]);
        const float prev = (x == 0) ? carry : y3[x == 0 ? 0 : x - 1];
        float v = bs + (hi ? y3[x] : prev);
        v += __shfl_xor(v, 1); v += __shfl_xor(v, 2);
        if (writer) imp_row[2 * x + hi] = v;
    }
    carry = y3[7];
    pv_tile(o, slot + 8192, p0, p1, lane, hi);
}
struct AP {
    const bf16_t *QN, *QR, *KCC, *VCC, *KS, *VS, *KW, *VW, *ZS, *MQ, *MK, *MV; const float* GT; const float* KM; bf16_t* Y;
};
#define TILE_LOOP(NT, KPTR_EXPR, VPTR_EXPR, NEEDV, BOUNDS_STMT, COMPUTE_STMT) \
  { u32x4 kr_ = {0u, 0u, 0u, 0u}, vr_ = {0u, 0u, 0u, 0u}; \
    { const int i = 0; (void)i; stage_load(KPTR_EXPR, VPTR_EXPR, wid, lane, kr_, vr_, NEEDV); } \
    stage_write(lds, wid, lane, kr_, vr_, NEEDV); __syncthreads(); \
    const int nt_ = (NT); \
    for (int i_ = 0; i_ < nt_; ++i_) { \
      const bool more_ = i_ + 1 < nt_; \
      if (more_) { const int i = i_ + 1; (void)i; stage_load(KPTR_EXPR, VPTR_EXPR, wid, lane, kr_, vr_, NEEDV); } \
      { const int i = i_; (void)i; lcptr slot = lds + (i_ & 1) * 16384; int klo, khi; BOUNDS_STMT; COMPUTE_STMT; } \
      if (more_) stage_write(lds + ((i_ + 1) & 1) * 16384, wid, lane, kr_, vr_, NEEDV); \
      __syncthreads(); } }
DI void zero2(f32x16 (&o)[2]) {
#pragma unroll
    for (int r = 0; r < 16; ++r) { o[0][r] = 0.f; o[1][r] = 0.f; }
}
DI void load_q(bf16x8 (&qr)[4], const bf16_t* qrow, int hi) {
#pragma unroll
    for (int d0 = 0; d0 < 4; ++d0) qr[d0] = *(const bf16x8*)(qrow + 16 * d0 + 8 * hi);
}
DI float bf_lo(unsigned w) { return __uint_as_float(w << 16); }
DI float bf_hi(unsigned w) { return __uint_as_float(w & 0xffff0000u); }
DI void write_y(const f32x16 (&o)[2], float scale, const bf16_t* zrow, bf16_t* yrow, int hi) {
#pragma unroll
    for (int dh = 0; dh < 2; ++dh)
#pragma unroll
        for (int gq = 0; gq < 4; ++gq) {
            const int d = 32 * dh + 8 * gq + 4 * hi;
            const u32x2 z = *(const u32x2*)(zrow + d);
            u32x2 w; w.x = pg8::cvtpk(o[dh][4 * gq] * scale * bf_lo(z.x), o[dh][4 * gq + 1] * scale * bf_hi(z.x)); w.y = pg8::cvtpk(o[dh][4 * gq + 2] * scale * bf_lo(z.y), o[dh][4 * gq + 3] * scale * bf_hi(z.y));
            *(u32x2*)(yrow + d) = w;
        }
}
DI void nsa_item(const AP& P, lptr lds, int b, int g, int c, int wid, int lane) {
    const int r32 = lane & 31, hi = lane >> 5, qi = r32 >> 2, hh = r32 & 3, H = 4 * g + hh;
    const int tq = 64 * c + 8 * wid + qi;
    const size_t qoff = ((size_t)(b * 8 + H) * SEQ + tq) * 64;
    const size_t row = (size_t)b * SEQ + tq;
    bf16x8 qr[4]; load_q(qr, P.QN + qoff, hi);
    const float* gp = P.GT + row * 32 + H * 3; const float g0 = gp[0], g1 = gp[1], g2 = gp[2];
    f32x16 o[2];
    LAS float* otl = (LAS float*)(lds + 69632) + (wid * 64 + lane);
    const int ntok = (4 * c + 3) < 511 ? (4 * c + 3) : 511, ntc = (ntok + 63) >> 6;
    const bf16_t* kcc = P.KCC + (size_t)(b * 2 + g) * 512 * 64; const bf16_t* vcc = P.VCC + (size_t)(b * 2 + g) * 512 * 64;
    int khi_abs = (tq - 31) >> 4; khi_abs = khi_abs < 510 ? khi_abs : 510;
    float m = NEG_INIT, l = 0.f;
    TILE_LOOP(ntc, kcc + i * 4096, vcc + i * 4096, false, { klo = -64 * i; khi = khi_abs - 64 * i; }, tile_stats(slot, qr, klo, khi, m, l, r32, hi));
    l += xhalf(l);
    { const float inv = l > 0.f ? 1.0f / l : 0.f; float carry = 0.f; zero2(o);
      LAS float* imp = (LAS float*)(lds + 32768) + (8 * wid + qi) * 128;
      TILE_LOOP(ntc, kcc + i * 4096, vcc + i * 4096, true, { klo = -64 * i; khi = khi_abs - 64 * i; }, tile_final(slot, qr, klo, khi, m, inv, o, carry, imp + 16 * i, hh == 0, lane, r32, hi));
#pragma unroll
      for (int r = 0; r < 16; ++r) { otl[r * 512] = g0 * o[0][r]; otl[(16 + r) * 512] = g0 * o[1][r]; } }
    LAS unsigned* selb = (LAS unsigned*)(lds + 65536);
    for (int q2 = 0; q2 < 8; ++q2) {
        unsigned long long s0, s1;
        if (c <= 15) { s0 = (2ull << c) - 1ull; s1 = 0ull; }
        else {
            const LAS float* ir = (const LAS float*)(lds + 32768) + (8 * wid + q2) * 128;
            const float v0 = ir[lane], v1 = ir[64 + lane];
            const int nc2 = c - 2;
            const unsigned k0 = (lane >= 1 && lane <= nc2) ? __float_as_uint(v0) + 1u : 0u, k1 = (lane + 64 <= nc2) ? __float_as_uint(v1) + 1u : 0u;
            unsigned lo = 1u, hb = 0x7f800002u; unsigned long long m0 = 0ull, m1 = 0ull; bool exact = false;
            while (hb - lo > 1u) {
                const unsigned mid = lo + ((hb - lo) >> 1);
                m0 = __ballot(k0 >= mid); m1 = __ballot(k1 >= mid);
                const int cnt = __popcll(m0) + __popcll(m1);
                if (cnt == 13) { exact = true; break; }
                if (cnt > 13) lo = mid; else hb = mid;
            }
            if (!exact) {
                const unsigned long long gg0 = __ballot(k0 > lo), gg1 = __ballot(k1 > lo), e0 = __ballot(k0 == lo), e1 = __ballot(k1 == lo);
                const int need = 13 - __popcll(gg0) - __popcll(gg1);
                const unsigned long long lt = (1ull << lane) - 1ull;
                const int r0 = __popcll(e0 & lt), r1 = __popcll(e0) + __popcll(e1 & lt);
                m0 = gg0 | __ballot(k0 == lo && r0 < need); m1 = gg1 | __ballot(k1 == lo && r1 < need);
            }
            s0 = m0 | 1ull; s1 = m1;
            if (c - 1 < 64) s0 |= 1ull << (c - 1); else s1 |= 1ull << (c - 65);
            if (c < 64) s0 |= 1ull << c; else s1 |= 1ull << (c - 64);
        }
        if (lane == 0) { LAS unsigned* sp = selb + (8 * wid + q2) * 4; sp[0] = (unsigned)s0; sp[1] = (unsigned)(s0 >> 32); sp[2] = (unsigned)s1; sp[3] = (unsigned)(s1 >> 32); }
    }
    const unsigned sb0 = selb[(8 * wid + qi) * 4 + 0], sb1 = selb[(8 * wid + qi) * 4 + 1], sb2 = selb[(8 * wid + qi) * 4 + 2], sb3 = selb[(8 * wid + qi) * 4 + 3];
    load_q(qr, P.QR + qoff, hi);
    const bf16_t* ks = P.KS + (size_t)(b * 2 + g) * SEQ * 64; const bf16_t* vs = P.VS + (size_t)(b * 2 + g) * SEQ * 64;
    m = NEG_INIT; l = 0.f; zero2(o);
    TILE_LOOP(c + 1, ks + (size_t)i * 4096, vs + (size_t)i * 4096, true,
              { klo = 0; const unsigned w = i < 32 ? sb0 : i < 64 ? sb1 : i < 96 ? sb2 : sb3; khi = (i == c) ? (tq - 64 * c) : (((w >> (i & 31)) & 1u) ? 63 : -1); },
              tile_online(slot, qr, klo, khi, m, l, o, lane, r32, hi));
    l += xhalf(l);
    { const float f = l > 0.f ? g1 / l : 0.f;
#pragma unroll
      for (int r = 0; r < 16; ++r) { otl[r * 512] += f * o[0][r]; otl[(16 + r) * 512] += f * o[1][r]; } }
    const bf16_t* kw = P.KW + (size_t)(b * 2 + g) * SEQ * 64; const bf16_t* vw = P.VW + (size_t)(b * 2 + g) * SEQ * 64;
    const int j0 = c > 8 ? c - 8 : 0;
    m = NEG_INIT; l = 0.f; zero2(o);
    TILE_LOOP(c - j0 + 1, kw + (size_t)(j0 + i) * 4096, vw + (size_t)(j0 + i) * 4096, true,
              { const int base = 64 * (j0 + i); klo = tq - 511 - base; khi = tq - base; },
              tile_online(slot, qr, klo, khi, m, l, o, lane, r32, hi));
    l += xhalf(l);
    { const float f = l > 0.f ? g2 / l : 0.f;
#pragma unroll
      for (int r = 0; r < 16; ++r) { o[0][r] = otl[r * 512] + f * o[0][r]; o[1][r] = otl[(16 + r) * 512] + f * o[1][r]; } }
    write_y(o, 1.0f, P.ZS + row * 1024 + H * 64, P.Y + row * 1024 + H * 64, hi);
}
DI void moba_item(const AP& P, lptr lds, int b, int h, int own, int wid, int lane, int tid) {
    const int r32 = lane & 31, hi = lane >> 5;
    const int tq = 256 * own + 32 * wid + r32;
    const size_t hb = (size_t)(b * 8 + h) * SEQ * 64;
    const size_t row = (size_t)b * SEQ + tq;
    bf16x8 qr[4]; load_q(qr, P.MQ + hb + (size_t)tq * 64, hi);
    unsigned bits = 0u;
    if (own <= 3) bits = (1u << own) - 1u;
    else {
        { const int j = tid >> 4, d4 = (tid & 15) * 4;
          const f32x4 km = *(const f32x4*)(P.KM + ((size_t)(b * 8 + h) * 32 + j) * 64 + d4);
          const unsigned h01 = pg8::cvtpk(km[0], km[1]), h23 = pg8::cvtpk(km[2], km[3]);
          const unsigned l01 = pg8::cvtpk(km[0] - bf_lo(h01), km[1] - bf_hi(h01)), l23 = pg8::cvtpk(km[2] - bf_lo(h23), km[3] - bf_hi(h23));
          const int off = (d4 >> 3) * 1024 + j * 16 + (d4 & 7) * 2;
          *(LAS u32x2*)(lds + off) = (u32x2){h01, h23}; *(LAS u32x2*)(lds + 16384 + off) = (u32x2){l01, l23}; }
        __syncthreads();
        f32x16 sg;
#pragma unroll
        for (int r = 0; r < 16; ++r) sg[r] = 0.f;
        { lcptr kb = lds + hi * 1024 + r32 * 16;
#pragma unroll
          for (int d0 = 0; d0 < 4; ++d0) { const bf16x8 a = *(const LAS bf16x8*)(kb + d0 * 2048), a2 = *(const LAS bf16x8*)(kb + 16384 + d0 * 2048); sg = MFMA32(a, qr[d0], sg); sg = MFMA32(a2, qr[d0], sg); } }
#pragma unroll
        for (int r = 0; r < 16; ++r) if (crow(r, hi) >= own) sg[r] = -INFINITY;
#pragma unroll
        for (int rd = 0; rd < 3; ++rd) {
            float best = sg[0]; int bj = crow(0, hi);
#pragma unroll
            for (int r = 1; r < 16; ++r) if (sg[r] > best) { best = sg[r]; bj = crow(r, hi); }
            const float ob = xhalf(best); const int oj = __shfl_xor(bj, 32);
            if (ob > best || (ob == best && oj < bj)) { best = ob; bj = oj; }
            if (best > -INFINITY) bits |= 1u << bj;
#pragma unroll
            for (int r = 0; r < 16; ++r) if (crow(r, hi) == bj) sg[r] = -INFINITY;
        }
        __syncthreads();
    }
    const bf16_t* mk = P.MK + hb; const bf16_t* mv = P.MV + hb;
    float m = NEG_INIT, l = 0.f; f32x16 o[2]; zero2(o);
    TILE_LOOP(4 * (own + 1), mk + (size_t)i * 4096, mv + (size_t)i * 4096, true,
              { const int j = i >> 2; klo = 0; khi = (j < own) ? (((bits >> j) & 1u) ? 63 : -1) : (tq - 64 * i); },
              tile_online(slot, qr, klo, khi, m, l, o, lane, r32, hi));
    l += xhalf(l);
    write_y(o, l > 0.f ? 1.0f / l : 0.f, P.ZS + row * 1024 + 512 + h * 64, P.Y + row * 1024 + 512 + h * 64, hi);
}
}
using att::lptr; using att::lcptr;
using pg8::bf16_t; using pg8::bf16x8; using pg8::u32x4; using pg8::f32x4;
constexpr int NWAVES = 8, NTHREADS = 512;
constexpr int BATCH = 4, T = 8192, DM = 1024, M = BATCH * T;
constexpr int NPROJ = 4096;
constexpr float LN_EPS = 1e-5f;
constexpr size_t MiB = 1u << 20;
constexpr size_t WS_CTL = 0;
constexpr size_t WS_ROPE = 1 * MiB;
constexpr size_t WS_B1P = WS_ROPE + 512 * 1024;
constexpr size_t WS_KM = 2 * MiB;
constexpr size_t WS_KCC = WS_KM + 256 * 1024;
constexpr size_t WS_VCC = WS_KCC + 512 * 1024;
constexpr size_t WS_W2T = WS_VCC + 512 * 1024;
constexpr size_t WS_W1T = 4 * MiB;
constexpr size_t WS_WOT = 6 * MiB;
constexpr size_t WS_WT = 8 * MiB;
constexpr size_t WS_XB = 16 * MiB;
constexpr size_t WS_Y = WS_XB;
constexpr size_t WS_QN = 80 * MiB, WS_QR = 112 * MiB;
constexpr size_t WS_KC = 144 * MiB, WS_VC = 152 * MiB, WS_KS = 160 * MiB, WS_VS = 168 * MiB, WS_KW = 176 * MiB, WS_VW = 184 * MiB;
constexpr size_t WS_ZS = 192 * MiB;
constexpr size_t WS_MQ = 256 * MiB, WS_MK = 288 * MiB, WS_MV = 320 * MiB;
constexpr size_t WS_GT = 352 * MiB;
constexpr size_t WS_END = 356 * MiB;
constexpr int LDS_BYTES = 135168;

struct Args { const float* in[13]; float* out; unsigned char* ws; int ph_lo, ph_hi; };

DI unsigned pk2(float lo, float hi) { return pg8::cvtpk(lo, hi); }
template <class Map> DI void transpose_item(const float* W, int ldw, Map srccol, bf16_t* WT, int K, LAS float* scr, int kb, int nb, int lane) {
    const int k0 = 64 * kb, n0 = 32 * nb; const int sc = srccol(n0 + (lane & 31));
#pragma unroll 8
    for (int i = 0; i < 32; ++i) { const int kk = 2 * i + (lane >> 5); scr[kk * 33 + (lane & 31)] = sc >= 0 ? W[(size_t)(k0 + kk) * ldw + sc] : 0.f; }
    asm volatile("s_waitcnt lgkmcnt(0)" ::: "memory");
    const int c = lane & 7;
#pragma unroll
    for (int j = 0; j < 4; ++j) { const int n = (lane >> 3) + 8 * j; const LAS float* s = scr + (8 * c) * 33 + n;
        u32x4 o; o.x = pk2(s[0 * 33], s[1 * 33]); o.y = pk2(s[2 * 33], s[3 * 33]); o.z = pk2(s[4 * 33], s[5 * 33]); o.w = pk2(s[6 * 33], s[7 * 33]);
        *(u32x4*)(WT + (size_t)(n0 + n) * K + k0 + 8 * c) = o; }
    asm volatile("s_waitcnt lgkmcnt(0)" ::: "memory");
}
struct MapIdent { DI int operator()(int n) const { return n; } };
struct MapProj { DI int operator()(int n) const { return n < 1280 ? n : n < 3840 ? n + 24 : n < 3864 ? n - 2560 : -1; } };
DI float wave_sum(float v) {
#pragma unroll
    for (int o = 1; o < 64; o <<= 1) v += __shfl_xor(v, o);
    return v;
}
DI void sincos_d(double a, double& s, double& c) {
    const double q = __builtin_rint(a * 0.63661977236758134308);
    double r = __builtin_fma(-q, 1.57079632679489655800e+00, a); r = __builtin_fma(-q, 6.12323399573676603587e-17, r);
    const double r2 = r * r;
    double ps = -1.0 / 1307674368000.0; ps = ps * r2 + 1.0 / 6227020800.0; ps = ps * r2 - 1.0 / 39916800.0; ps = ps * r2 + 1.0 / 362880.0; ps = ps * r2 - 1.0 / 5040.0; ps = ps * r2 + 1.0 / 120.0; ps = ps * r2 - 1.0 / 6.0; ps = ps * r2 * r + r;
    double pc = 1.0 / 20922789888000.0; pc = pc * r2 - 1.0 / 87178291200.0; pc = pc * r2 + 1.0 / 479001600.0; pc = pc * r2 - 1.0 / 3628800.0; pc = pc * r2 + 1.0 / 40320.0; pc = pc * r2 - 1.0 / 720.0; pc = pc * r2 + 1.0 / 24.0; pc = pc * r2 - 0.5; pc = pc * r2 + 1.0;
    const int qi = (int)((long long)q & 3);
    s = (qi == 0) ? ps : (qi == 1) ? pc : (qi == 2) ? -ps : -pc;
    c = (qi == 0) ? pc : (qi == 1) ? -ps : (qi == 2) ? -pc : ps;
}
struct Frame { lptr lds; int tid, lane, wave, G, bx; };

DI void p0_prep(const Args& a, const Frame& F) {
    unsigned char* ws = a.ws;
    LAS float* scr = (LAS float*)(F.lds + F.wave * 16384);
    const int gw = F.bx * NWAVES + F.wave, NGW = F.G * NWAVES;
    if (F.bx == 0 && F.tid < 64) ((unsigned*)(ws + WS_CTL))[F.tid] = 0u;
    constexpr int I0 = 16 * 128, I1 = 16 * 32, I2 = 32 * 8, I3 = 4 * 2, I4 = 128;
    constexpr int NITEMS = I0 + I1 + 2 * I2 + 2 * I3 + I4;
    for (int it = gw; it < NITEMS; it += NGW) {
        int r = it;
        if (r < I0) { transpose_item(a.in[1], 3864, MapProj(), (bf16_t*)(ws + WS_WT), 1024, scr, r / 128, r % 128, F.lane); continue; } r -= I0;
        if (r < I1) { transpose_item(a.in[10], 1024, MapIdent(), (bf16_t*)(ws + WS_WOT), 1024, scr, r / 32, r % 32, F.lane); continue; } r -= I1;
        if (r < 2 * I2) { const int kv = r / I2; r %= I2; transpose_item(a.in[kv ? 7 : 3], 256, MapIdent(), (bf16_t*)(ws + WS_W1T) + (size_t)kv * 256 * 2048, 2048, scr, r / 8, r % 8, F.lane); continue; } r -= 2 * I2;
        if (r < 2 * I3) { const int kv = r / I3; r %= I3; transpose_item(a.in[kv ? 9 : 5], 64, MapIdent(), (bf16_t*)(ws + WS_W2T) + (size_t)kv * 64 * 256, 256, scr, r / 2, r % 2, F.lane); continue; } r -= 2 * I3;
        {
            float* pp = (float*)(ws + WS_B1P) + (size_t)r * 512;
#pragma unroll
            for (int e = 0; e < 8; ++e) { const int idx = e * 64 + F.lane, kv = idx >> 8, n = idx & 255; const float* pos = a.in[kv ? 6 : 2]; const float* w1 = a.in[kv ? 7 : 3];
                float s = 0.f;
#pragma unroll
                for (int k = 0; k < 16; ++k) s += pos[16 * r + k] * w1[(size_t)(16 * r + k) * 256 + n];
                pp[idx] = s; }
        }
    }
    { const f32x4* x4 = (const f32x4*)a.in[0]; u32x4* xb = (u32x4*)(ws + WS_XB); const size_t n8 = (size_t)M * DM / 8, stride = (size_t)F.G * NTHREADS;
      for (size_t i = (size_t)F.bx * NTHREADS + F.tid; i < n8; i += stride) { const f32x4 v0 = x4[2 * i], v1 = x4[2 * i + 1]; u32x4 o; o.x = pk2(v0[0], v0[1]); o.y = pk2(v0[2], v0[3]); o.z = pk2(v1[0], v1[1]); o.w = pk2(v1[2], v1[3]); xb[i] = o; } }
    { float* rp = (float*)(ws + WS_ROPE);
      for (int i = F.bx * NTHREADS + F.tid; i < T * 8; i += F.G * NTHREADS) { const int t = i >> 3, f = i & 7;
          const float invf = f == 0 ? 1.0f : f == 1 ? 0.19392274f : f == 2 ? 0.03760603f : f == 3 ? 0.0072926646f : f == 4 ? 0.0014142136f : f == 5 ? 0.0002742482f : f == 6 ? 5.318296e-05f : 1.0313386e-05f;
          const float ang = (float)t * invf; double s, c; sincos_d((double)ang, s, c);
          rp[t * 16 + f] = (float)c; rp[t * 16 + 8 + f] = (float)s; } }
}
DI void p2_compress_item(const Args& a, const Frame& F, int item) {
    unsigned char* ws = a.ws;
    const int kv = item >> 6, bg = (item >> 3) & 7, ib = item & 7;
    const bf16_t* src = (const bf16_t*)(ws + (kv ? WS_VC : WS_KC)) + (size_t)bg * T * 64;
    const bf16_t* w1t = (const bf16_t*)(ws + WS_W1T) + (size_t)kv * 256 * 2048;
    const bf16_t* w2t = (const bf16_t*)(ws + WS_W2T) + (size_t)kv * 64 * 256;
    bf16_t* dst = (bf16_t*)(ws + (kv ? WS_VCC : WS_KCC)) + (size_t)bg * 512 * 64;
    LAS float* b1p = (LAS float*)(F.lds);
    LAS float* red = (LAS float*)(F.lds + 1024);
    LAS bf16_t* Hs = (LAS bf16_t*)(F.lds + 4096);
    const int lane = F.lane, wid = F.wave, r32 = lane & 31, hi = lane >> 5;
    { const int n = F.tid & 255, half = F.tid >> 8; const float* pp = (const float*)(ws + WS_B1P) + kv * 256 + n; float s = 0.f;
      for (int j = 0; j < 64; ++j) s += pp[(size_t)(half * 64 + j) * 512];
      red[half * 256 + n] = s; }
    __syncthreads();
    if (F.tid < 256) b1p[F.tid] = red[F.tid] + red[256 + F.tid] + a.in[kv ? 8 : 4][F.tid];
    __syncthreads();
    att::f32x16 acc0, acc1;
#pragma unroll
    for (int r = 0; r < 16; ++r) { acc0[r] = 0.f; acc1[r] = 0.f; }
    { int i0 = 64 * ib + r32, i1 = i0 + 32; i0 = i0 < 510 ? i0 : 510; i1 = i1 < 510 ? i1 : 510;
      const bf16_t* a0p = src + (size_t)i0 * 16 * 64 + 8 * hi; const bf16_t* a1p = src + (size_t)i1 * 16 * 64 + 8 * hi; const bf16_t* bp = w1t + (size_t)(32 * wid + r32) * 2048 + 8 * hi;
#pragma unroll 4
      for (int s = 0; s < 128; ++s) { const bf16x8 fa0 = *(const bf16x8*)(a0p + 16 * s), fa1 = *(const bf16x8*)(a1p + 16 * s), fb = *(const bf16x8*)(bp + 16 * s);
          acc0 = MFMA32(fa0, fb, acc0); acc1 = MFMA32(fa1, fb, acc1); } }
    { const int n = 32 * wid + r32; const float bb = b1p[n];
#pragma unroll
      for (int r = 0; r < 16; ++r) { const int i = att::crow(r, hi);
          Hs[i * 264 + n] = (bf16_t)(pg8::cvtpk(pg8::silu_f(acc0[r] + bb), 0.f) & 0xffffu); Hs[(i + 32) * 264 + n] = (bf16_t)(pg8::cvtpk(pg8::silu_f(acc1[r] + bb), 0.f) & 0xffffu); } }
    __syncthreads();
    if (wid < 4) {
        const int rt = wid >> 1, ct = wid & 1; att::f32x16 acc2;
#pragma unroll
        for (int r = 0; r < 16; ++r) acc2[r] = 0.f;
#pragma unroll
        for (int s = 0; s < 16; ++s) { const bf16x8 fa = *(const LAS bf16x8*)(Hs + (32 * rt + r32) * 264 + 16 * s + 8 * hi), fb = *(const bf16x8*)(w2t + (size_t)(32 * ct + r32) * 256 + 16 * s + 8 * hi);
            acc2 = MFMA32(fa, fb, acc2); }
#pragma unroll
        for (int r = 0; r < 16; ++r) { const int i = 64 * ib + 32 * rt + att::crow(r, hi); dst[(size_t)i * 64 + 32 * ct + r32] = (bf16_t)(pg8::cvtpk(acc2[r], 0.f) & 0xffffu); }
    }
    __syncthreads();
}
DI void p2_kmean_item(const Args& a, const Frame& F, int item) {
    const bf16_t* mk = (const bf16_t*)(a.ws + WS_MK) + (size_t)item * 256 * 64;
    const int c = F.lane & 7, rg = F.lane >> 3; float s[8];
#pragma unroll
    for (int i = 0; i < 8; ++i) s[i] = 0.f;
#pragma unroll 4
    for (int p = 0; p < 32; ++p) { const u32x4 v = *(const u32x4*)(mk + (size_t)(8 * p + rg) * 64 + 8 * c);
        s[0] += att::bf_lo(v.x); s[1] += att::bf_hi(v.x); s[2] += att::bf_lo(v.y); s[3] += att::bf_hi(v.y); s[4] += att::bf_lo(v.z); s[5] += att::bf_hi(v.z); s[6] += att::bf_lo(v.w); s[7] += att::bf_hi(v.w); }
#pragma unroll
    for (int i = 0; i < 8; ++i) { s[i] += __shfl_xor(s[i], 8); s[i] += __shfl_xor(s[i], 16); s[i] += __shfl_xor(s[i], 32); }
    if (rg == 0) { float* o = (float*)(a.ws + WS_KM) + (size_t)item * 64 + 8 * c;
        *(f32x4*)o = (f32x4){s[0], s[1], s[2], s[3]} * (1.0f / 256.0f); *(f32x4*)(o + 4) = (f32x4){s[4], s[5], s[6], s[7]} * (1.0f / 256.0f); }
}
DI void p5_ln(const Args& a, const Frame& F) {
    const int gw = F.bx * NWAVES + F.wave, NGW = F.G * NWAVES;
    const f32x4* gn = (const f32x4*)a.in[11] + F.lane; const f32x4* bs = (const f32x4*)a.in[12] + F.lane;
    for (int r = gw; r < M; r += NGW) {
        f32x4* xr = (f32x4*)(a.out + (size_t)r * DM) + F.lane; f32x4 v[4]; float s = 0.f;
#pragma unroll
        for (int j = 0; j < 4; ++j) { v[j] = xr[64 * j]; s += (v[j][0] + v[j][1]) + (v[j][2] + v[j][3]); }
        const float mean = wave_sum(s) * (1.0f / DM); float s2 = 0.f;
#pragma unroll
        for (int j = 0; j < 4; ++j) { v[j] = v[j] - mean; s2 += (v[j][0] * v[j][0] + v[j][1] * v[j][1]) + (v[j][2] * v[j][2] + v[j][3] * v[j][3]); }
        const float rstd = 1.0f / sqrtf(wave_sum(s2) * (1.0f / DM) + LN_EPS);
#pragma unroll
        for (int j = 0; j < 4; ++j) xr[64 * j] = v[j] * rstd * gn[64 * j] + bs[64 * j];
    }
}
__global__ void __launch_bounds__(NTHREADS, 2) hymba_fwd(Args args) {
    extern __shared__ __attribute__((aligned(16))) unsigned char lds_raw[];
    cg::grid_group grid = cg::this_grid();
    Frame F; F.lds = (lptr)lds_raw; F.tid = threadIdx.x; F.lane = F.tid & 63; F.wave = __builtin_amdgcn_readfirstlane(F.tid >> 6); F.G = gridDim.x; F.bx = blockIdx.x;
    unsigned char* ws = args.ws;
    const int lo = args.ph_lo, hi = args.ph_hi;
#define IN(k) (lo <= (k) && (k) < hi)
#define SEAM(k) do { if (IN(k) && IN((k) + 1)) grid.sync(); } while (0)
#ifndef SKIP_P0
    if (IN(0)) { p0_prep(args, F); }
#endif
    SEAM(0);
#ifndef SKIP_P1
    if (IN(1)) {
        pg8::Gemm g{(const bf16_t*)(ws + WS_XB), (const bf16_t*)(ws + WS_WT), M, NPROJ, DM}; pg8::StaticOrder S; S.init(M, NPROJ, F.G, F.bx);
        pg8::EpiProj E{(bf16_t*)(ws + WS_QN), (bf16_t*)(ws + WS_QR), (bf16_t*)(ws + WS_KC), (bf16_t*)(ws + WS_VC), (bf16_t*)(ws + WS_KS), (bf16_t*)(ws + WS_VS), (bf16_t*)(ws + WS_KW), (bf16_t*)(ws + WS_VW),
                       (bf16_t*)(ws + WS_ZS), (bf16_t*)(ws + WS_MQ), (bf16_t*)(ws + WS_MK), (bf16_t*)(ws + WS_MV), (float*)(ws + WS_GT), (const float*)(ws + WS_ROPE)};
        pg8::gemm_phase<pg8::EpiProj, pg8::StaticOrder, true, true>((PG8_LAS unsigned char*)F.lds, g, S, E);
    }
#endif
    SEAM(1);
#ifndef SKIP_P2
    if (IN(2)) {
        for (int it = F.bx; it < 128; it += F.G) p2_compress_item(args, F, it);
        const int gw = ((F.bx + F.G - 128 % F.G) % F.G) * NWAVES + F.wave;
        for (int it = gw; it < 1024; it += F.G * NWAVES) p2_kmean_item(args, F, it);
    }
#endif
    SEAM(2);
#ifndef SKIP_P3
    if (IN(3)) {
        att::AP P{(const bf16_t*)(ws + WS_QN), (const bf16_t*)(ws + WS_QR), (const bf16_t*)(ws + WS_KCC), (const bf16_t*)(ws + WS_VCC), (const bf16_t*)(ws + WS_KS), (const bf16_t*)(ws + WS_VS), (const bf16_t*)(ws + WS_KW), (const bf16_t*)(ws + WS_VW),
                  (const bf16_t*)(ws + WS_ZS), (const bf16_t*)(ws + WS_MQ), (const bf16_t*)(ws + WS_MK), (const bf16_t*)(ws + WS_MV), (const float*)(ws + WS_GT), (const float*)(ws + WS_KM), (bf16_t*)(ws + WS_Y)};
        unsigned* qctr = (unsigned*)(ws + WS_CTL);
        LAS unsigned* qw = (LAS unsigned*)(F.lds + 66560);
        for (;;) {
            if (F.tid == 0) *qw = atomicAdd(qctr, 1u);
            __syncthreads();
            const unsigned n = *qw;
            __syncthreads();
            if (n >= 2048u) break;
            const unsigned k = n >> 1;
            if ((n & 1u) == 0u) { const int c = 127 - (int)(k >> 3), bg = (int)(k & 7);
#ifndef SKIP_NSA
 att::nsa_item(P, F.lds, bg >> 1, bg & 1, c, F.wave, F.lane);
#endif
 }
            else { const int own = 31 - (int)(k >> 5), bh = (int)(k & 31);
#ifndef SKIP_MOBA
 att::moba_item(P, F.lds, bh >> 3, bh & 7, own, F.wave, F.lane, F.tid);
#endif
 }
        }
    }
#endif
    SEAM(3);
#ifndef SKIP_P4
    if (IN(4)) {
        pg8::Gemm g{(const bf16_t*)(ws + WS_Y), (const bf16_t*)(ws + WS_WOT), M, DM, DM}; pg8::StaticOrder S; S.init(M, DM, F.G, F.bx);
        pg8::EpiOut E{args.in[0], args.out, 1.189207115002721f};
        pg8::gemm_phase<pg8::EpiOut, pg8::StaticOrder, true, true>((PG8_LAS unsigned char*)F.lds, g, S, E);
    }
#endif
    SEAM(4);
#ifndef SKIP_P5
    if (IN(5)) p5_ln(args, F);
#endif
#undef IN
#undef SEAM
}
#ifndef N_LAUNCHES
#define N_LAUNCHES 1
#endif
extern "C" void kernel_launch(void* const* d_in, const int* in_sizes, int n_in, void* d_out, int out_size, void* d_ws, size_t ws_size, hipStream_t stream) {
    static int grid = 0;
    if (grid == 0) {
        if (n_in != 13 || in_sizes[0] != M * DM || out_size != M * DM || ws_size < WS_END) { fprintf(stderr, "kernel_launch: unexpected shapes (n_in %d, in0 %d, out %d, ws %zu)\n", n_in, n_in > 0 ? in_sizes[0] : -1, out_size, ws_size); grid = -1; return; }
        int dev = 0, cus = 0, per_cu = 0;
        (void)hipGetDevice(&dev); (void)hipDeviceGetAttribute(&cus, hipDeviceAttributeMultiprocessorCount, dev);
        if (hipFuncSetAttribute((const void*)hymba_fwd, hipFuncAttributeMaxDynamicSharedMemorySize, LDS_BYTES) != hipSuccess) { fprintf(stderr, "kernel_launch: hipFuncSetAttribute failed\n"); grid = -1; return; }
        if (hipOccupancyMaxActiveBlocksPerMultiprocessor(&per_cu, (const void*)hymba_fwd, NTHREADS, LDS_BYTES) != hipSuccess || per_cu < 1) { fprintf(stderr, "kernel_launch: occupancy query failed (%d)\n", per_cu); (void)hipGetLastError(); per_cu = 1; }
        grid = cus * (per_cu < 1 ? 1 : 1);
    }
    if (grid < 0) return;
    Args a{};
    for (int i = 0; i < 13; ++i) a.in[i] = (const float*)d_in[i];
    a.out = (float*)d_out; a.ws = (unsigned char*)d_ws;
#if N_LAUNCHES == 1
    a.ph_lo = 0; a.ph_hi = 6;
    void* kargs[] = {&a};
    hipError_t e = hipLaunchCooperativeKernel((const void*)hymba_fwd, dim3(grid), dim3(NTHREADS), kargs, LDS_BYTES, stream);
    if (e != hipSuccess) fprintf(stderr, "cooperative launch failed: %s (grid %d)\n", hipGetErrorString(e), grid);
#else
    for (int p = 0; p < 6; ++p) { a.ph_lo = p; a.ph_hi = p + 1; hipLaunchKernelGGL(hymba_fwd, dim3(grid), dim3(NTHREADS), LDS_BYTES, stream, a); }
#endif
}
```

```cpp
#include <hip/hip_runtime.h>
#include <hip/hip_cooperative_groups.h>
#include <cstdio>
#include <cstdint>
namespace cg = cooperative_groups;
#define DI __device__ __forceinline__
namespace pg8 {
#define PG8_LAS __attribute__((address_space(3)))
typedef unsigned short bf16_t;
typedef short bf16x8 __attribute__((ext_vector_type(8)));
typedef float f32x4 __attribute__((ext_vector_type(4)));
typedef unsigned u32x4 __attribute__((ext_vector_type(4)));
constexpr int BM = 256, BK = 64, HALF = 128, HTB = HALF * BK * 2  , STAGE_BYTES = 8 * HTB, NXCD = 8, WGM = 8;

__host__ __device__ __forceinline__ int lds_byte(int r, int c) { const int st = (r >> 4) * 2 + (c >> 5), rr = r & 15, cc = c & 31, ob = rr * 64 + cc * 2; return st * 1024 + (ob ^ (((ob >> 9) & 1) << 5)); }
__host__ __device__ __forceinline__ void stage_rc(int b, int& R, int& C) { const int st = b / 1024, sb = b % 1024, swz = sb ^ (((sb >> 9) & 1) << 5); R = (st >> 1) * 16 + swz / 64; C = (st & 1) * 32 + (swz % 64) / 2; }
__host__ __device__ __forceinline__ int perm32(int rho) { const int n = rho >> 4, i = rho & 15; return 8 * (i >> 2) + 4 * n + (i & 3); }

struct Unit { int pm, pn; };
struct Gemm { const bf16_t* A; const bf16_t* Bt; int M, N, K; };

struct StaticOrder {
    int nM, nN, nwg, G, c;
    __host__ __device__ void init(int M, int N, int G_, int c_) { nM = M / BM; nN = N / BM; nwg = nM * nN; G = G_; c = c_; }
    __host__ __device__ bool next(int i, Unit& u) const {
        const long L = (long)i * G + c; if (L >= nwg) return false;
        int wgid = (int)L; { const int q = nwg / NXCD, r = nwg % NXCD, xcd = wgid % NXCD, off = wgid / NXCD; wgid = (xcd < r ? xcd * (q + 1) : r * (q + 1) + (xcd - r) * q) + off; }
        const int nig = WGM * nN, gid = wgid / nig, fm = gid * WGM, gsz = (nM - fm) < WGM ? (nM - fm) : WGM;
        u.pm = fm + ((wgid % nig) % gsz); u.pn = (wgid % nig) / gsz; return true;
    }
    __device__ __forceinline__ void a_ready(const Unit&) const {}
    __device__ __forceinline__ void done(const Unit&) const {}
};

typedef float f32x2_t __attribute__((ext_vector_type(2))); typedef __bf16 bf16x2_t __attribute__((ext_vector_type(2)));
DI unsigned cvtpk(float lo, float hi) { f32x2_t v = {lo, hi}; bf16x2_t b = __builtin_convertvector(v, bf16x2_t); return __builtin_bit_cast(unsigned, b); }
DI float silu_f(float v) { return v / (1.0f + __expf(-v)); }
DI float sigm_f(float v) { return 1.0f / (1.0f + __expf(-v)); }
constexpr int SEQ = 8192;
struct EpiProj {
    static constexpr bool PERM = true, AFTER_DRAIN = false;
    unsigned char* ws;
    DI void store8(bf16_t* dst, const float (&v)[8]) const { u32x4 w; w.x = cvtpk(v[0], v[1]); w.y = cvtpk(v[2], v[3]); w.z = cvtpk(v[4], v[5]); w.w = cvtpk(v[6], v[7]); *(u32x4*)dst = w; }
    DI void operator()(const f32x4 (&acc)[2][2][4][2], const Unit& u, int wr, int wc, int fr, int fq) const {
        const int pn = u.pn;
        bf16_t* const QN = (bf16_t*)(ws + (80ull << 20)); bf16_t* const QR = (bf16_t*)(ws + (112ull << 20)); bf16_t* const KC = (bf16_t*)(ws + (144ull << 20)); bf16_t* const VC = (bf16_t*)(ws + (152ull << 20));
        bf16_t* const KS = (bf16_t*)(ws + (160ull << 20)); bf16_t* const VS = (bf16_t*)(ws + (168ull << 20)); bf16_t* const KW = (bf16_t*)(ws + (176ull << 20)); bf16_t* const VW = (bf16_t*)(ws + (184ull << 20));
        bf16_t* const ZS = (bf16_t*)(ws + (192ull << 20)); bf16_t* const MQ = (bf16_t*)(ws + (256ull << 20)); bf16_t* const MK = (bf16_t*)(ws + (288ull << 20)); bf16_t* const MV = (bf16_t*)(ws + (320ull << 20));
        float* const GT = (float*)(ws + (352ull << 20)); const float* const ROPE = (const float*)(ws + (1ull << 20));
#pragma unroll
        for (int ai = 0; ai < 2; ++ai)
#pragma unroll
            for (int m = 0; m < 4; ++m) {
                const int row = u.pm * BM + ai * HALF + wr * 64 + m * 16 + fr; const int b = row >> 13, t = row & (SEQ - 1);
#pragma unroll
                for (int bj = 0; bj < 2; ++bj) {
                    const int col0 = bj * HALF + wc * 32 + 8 * fq; const int hd = col0 >> 6, d0 = col0 & 63;
                    float v[8];
#pragma unroll
                    for (int i = 0; i < 4; ++i) { v[i] = acc[ai][bj][m][0][i]; v[4 + i] = acc[ai][bj][m][1][i]; }
                    int kind = 0; bf16_t* dst = nullptr; bf16_t* dst2 = nullptr; float sc = 1.0f, sc2 = 1.0f;
                    if (pn <= 1)      { kind = 1; sc = 0.125f; sc2 = 1.4426950408889634f; const size_t o = ((size_t)(b * 8 + pn * 4 + hd) * SEQ + t) * 64 + d0; dst = QR + o; dst2 = QN + o; }
                    else if (pn == 2) { const size_t o = ((size_t)(b * 2 + (hd & 1)) * SEQ + t) * 64 + d0; dst = (hd < 2 ? KC : VC) + o; }
                    else if (pn == 3) { const size_t o = ((size_t)(b * 2 + (hd & 1)) * SEQ + t) * 64 + d0; dst = (hd < 2 ? KS : VS) + o; kind = hd < 2 ? 1 : 0; }
                    else if (pn == 4) { const size_t o = ((size_t)(b * 2 + (hd & 1)) * SEQ + t) * 64 + d0; dst = (hd < 2 ? KW : VW) + o; kind = hd < 2 ? 1 : 0; }
                    else if (pn <= 6) { kind = 2; dst = ZS + (size_t)row * 1024 + (pn - 5) * 256 + col0; }
                    else if (pn <= 8) { kind = 1; sc = 0.125f * 1.4426950408889634f; dst = MQ + ((size_t)(b * 8 + (pn - 7) * 4 + hd) * SEQ + t) * 64 + d0; }
                    else if (pn <= 10) { kind = 1; dst = MK + ((size_t)(b * 8 + (pn - 9) * 4 + hd) * SEQ + t) * 64 + d0; }
                    else if (pn <= 12) { dst = MV + ((size_t)(b * 8 + (pn - 11) * 4 + hd) * SEQ + t) * 64 + d0; }
                    else if (pn <= 14) { kind = 2; dst = ZS + (size_t)row * 1024 + 512 + (pn - 13) * 256 + col0; }
                    else kind = 3;
                    if (kind == 3) {
                        if (col0 < 24) {
#pragma unroll
                            for (int i = 0; i < 8; ++i) v[i] = sigm_f(v[i]);
                            float* gp = GT + (size_t)row * 32 + col0; *(f32x4*)gp = (f32x4){v[0], v[1], v[2], v[3]}; *(f32x4*)(gp + 4) = (f32x4){v[4], v[5], v[6], v[7]};
                        }
                        continue;
                    }
                    if (kind == 2) {
#pragma unroll
                        for (int i = 0; i < 8; ++i) v[i] = silu_f(v[i]);
                        store8(dst, v); continue;
                    }
                    if (sc != 1.0f) {
#pragma unroll
                        for (int i = 0; i < 8; ++i) v[i] *= sc;
                    }
                    if (kind == 1) {
                        if (dst2) { store8(dst2, v);
#pragma unroll
                            for (int i = 0; i < 8; ++i) v[i] *= sc2; }
                        if ((wc & 1) == 0) {
                            float pr[8];
#pragma unroll
                            for (int i = 0; i < 8; ++i) pr[i] = __shfl_xor(v[i], 16);
                            if (fq < 2) {
                                const f32x4 c0 = *(const f32x4*)(ROPE + (size_t)t * 16), c1 = *(const f32x4*)(ROPE + (size_t)t * 16 + 4), s0 = *(const f32x4*)(ROPE + (size_t)t * 16 + 8), s1 = *(const f32x4*)(ROPE + (size_t)t * 16 + 12);
                                const float sg = fq == 0 ? -1.0f : 1.0f;
#pragma unroll
                                for (int i = 0; i < 4; ++i) { v[i] = v[i] * c0[i] + sg * pr[i] * s0[i]; v[4 + i] = v[4 + i] * c1[i] + sg * pr[4 + i] * s1[i]; }
                            }
                        }
                    }
                    store8(dst, v);
                }
            }
    }
};
struct EpiOut {
    static constexpr bool PERM = false, AFTER_DRAIN = false;
    const float* Xin; float* O; float alpha;
    DI void operator()(const f32x4 (&acc)[2][2][4][2], const Unit& u, int wr, int wc, int fr, int fq) const {
#pragma unroll
        for (int ai = 0; ai < 2; ++ai)
#pragma unroll
            for (int m = 0; m < 4; ++m) {
                const size_t row = (size_t)(u.pm * BM + ai * HALF + wr * 64 + m * 16 + fr);
#pragma unroll
                for (int bj = 0; bj < 2; ++bj)
#pragma unroll
                    for (int n = 0; n < 2; ++n) { const size_t off = row * 1024 + u.pn * BM + bj * HALF + wc * 32 + n * 16 + 4 * fq; const f32x4 xv = *(const f32x4*)(Xin + off); *(f32x4*)(O + off) = xv * alpha + acc[ai][bj][m][n]; }
            }
    }
};
template <class Epi, class Sched, bool ALIGN_EPI = false, bool SP2 = false>
__device__ __forceinline__ void gemm_phase(PG8_LAS unsigned char* lds, const Gemm g, const Sched& S, const Epi& E) {
    const int tid = threadIdx.x, wid = __builtin_amdgcn_readfirstlane(tid >> 6), lane = tid & 63, wr = wid >> 2, wc = wid & 3, fr = lane & 15, fq = lane >> 4;
    const int K = g.K, nt = K / BK;
    unsigned voffA[2], voffB[2];
#pragma unroll
    for (int i = 0; i < 2; ++i) { int R, C; stage_rc(tid * 16 + i * 8192, R, C); const int Rb = Epi::PERM ? ((R & ~31) + perm32(R & 31)) : R;
        voffA[i] = (unsigned)(R * K + C) * 2u; voffB[i] = (unsigned)(Rb * K + C) * 2u; }
    const size_t kstep = (size_t)(BK * 2);
    const size_t hstep = (size_t)HALF * K * 2;
    const size_t tstep = 2 * hstep;
    const unsigned ldsw = (unsigned)wid * 1024u;
    const int aoff = lds_byte(wr * 64 + fr, fq * 8), boff = lds_byte(wc * 32 + fr, fq * 8);
#define PG8_SA(b, h) (((b) * 2 + (h)) * HTB)
#define PG8_SB(b, h) ((4 + (b) * 2 + (h)) * HTB)
#define PG8_STAGE(bufoff, gbase, voff) do { _Pragma("unroll") for (int _i = 0; _i < 2; ++_i) \
        __builtin_amdgcn_global_load_lds((const unsigned*)((const char*)(gbase) + (voff)[_i]), (PG8_LAS unsigned*)(lds + (bufoff) + ldsw + _i * 8192), 16, 0, 0); } while (0)
#define PG8_LDA(dst, b, h) do { _Pragma("unroll") for (int m = 0; m < 4; ++m) _Pragma("unroll") for (int k = 0; k < 2; ++k) dst[m][k] = *(const PG8_LAS bf16x8*)(lds + PG8_SA(b, h) + aoff + m * 2048 + k * 1024); } while (0)
#define PG8_LDB(dst, b, h) do { _Pragma("unroll") for (int n = 0; n < 2; ++n) _Pragma("unroll") for (int k = 0; k < 2; ++k) dst[n][k] = *(const PG8_LAS bf16x8*)(lds + PG8_SB(b, h) + boff + n * 2048 + k * 1024); } while (0)
#define PG8_MMA(ai, bj, At, Bt) do { __builtin_amdgcn_s_setprio(1); _Pragma("unroll") for (int m = 0; m < 4; ++m) _Pragma("unroll") for (int n = 0; n < 2; ++n) _Pragma("unroll") for (int k = 0; k < 2; ++k) \
        acc[ai][bj][m][n] = __builtin_amdgcn_mfma_f32_16x16x32_bf16(Bt[n][k], At[m][k], acc[ai][bj][m][n], 0, 0, 0); __builtin_amdgcn_s_setprio(0); } while (0)
#define PG8_WAIT_V(n) asm volatile("s_waitcnt vmcnt(" #n ")" ::: "memory")
#define PG8_WAIT_L(n) asm volatile("s_waitcnt lgkmcnt(" #n ")" ::: "memory")
#define PG8_BAR __builtin_amdgcn_s_barrier()
#define PG8_SCHED __builtin_amdgcn_sched_barrier(0)
    Unit cur, nxt; int ui = 0;
    if (!S.next(0, cur)) return;
    f32x4 acc[2][2][4][2];
#pragma unroll
    for (int a = 0; a < 2; ++a)
#pragma unroll
        for (int b = 0; b < 2; ++b)
#pragma unroll
            for (int m = 0; m < 4; ++m)
#pragma unroll
                for (int n = 0; n < 2; ++n) acc[a][b][m][n] = (f32x4){0.f, 0.f, 0.f, 0.f};
    bf16x8 At[4][2], B0[2][2], B1[2][2];
    const char* cA = (const char*)g.A + (size_t)cur.pm * tstep; const char* cB = (const char*)g.Bt + (size_t)cur.pn * tstep;
    S.a_ready(cur);
    if constexpr (SP2) {
        PG8_STAGE(PG8_SB(0, 0), cB, voffB); PG8_STAGE(PG8_SB(0, 1), cB + hstep, voffB); PG8_STAGE(PG8_SA(0, 0), cA, voffA); PG8_STAGE(PG8_SA(0, 1), cA + hstep, voffA);
        if (wr == 1) PG8_BAR;
        PG8_WAIT_V(2); PG8_BAR;
        PG8_STAGE(PG8_SB(1, 0), cB + kstep, voffB); PG8_STAGE(PG8_SA(1, 0), cA + kstep, voffA); PG8_STAGE(PG8_SB(1, 1), cB + hstep + kstep, voffB);
        PG8_WAIT_V(6); PG8_BAR;
    } else {
        PG8_STAGE(PG8_SB(0, 0), cB, voffB); PG8_STAGE(PG8_SA(0, 0), cA, voffA); PG8_STAGE(PG8_SB(0, 1), cB + hstep, voffB); PG8_STAGE(PG8_SA(0, 1), cA + hstep, voffA);
        if (wr == 1) PG8_BAR;
        PG8_WAIT_V(4); PG8_BAR;
        PG8_STAGE(PG8_SB(1, 0), cB + kstep, voffB); PG8_STAGE(PG8_SA(1, 0), cA + kstep, voffA); PG8_STAGE(PG8_SB(1, 1), cB + hstep + kstep, voffB);
        PG8_WAIT_V(6); PG8_BAR;
    }
    for (;;) {
        const bool has_next = S.next(ui + 1, nxt);
        const char* nA = has_next ? (const char*)g.A + (size_t)nxt.pm * tstep : cA; const char* nB = has_next ? (const char*)g.Bt + (size_t)nxt.pn * tstep : cB;
        for (int t = 0; t < nt; t += 2) {
            const bool last = (t == nt - 2);
            const char* a1 = cA + (size_t)(t + 1) * kstep;
            const char* a2 = last ? nA : cA + (size_t)(t + 2) * kstep; const char* b2 = last ? nB : cB + (size_t)(t + 2) * kstep;
            const char* a3 = a2 + kstep; const char* b3 = b2 + kstep;
            if (last && has_next) S.a_ready(nxt);
            if constexpr (SP2) {
            PG8_LDB(B0, 0, 0); PG8_LDB(B1, 0, 1); PG8_SCHED; PG8_LDA(At, 0, 0); PG8_STAGE(PG8_SA(1, 1), a1 + hstep, voffA);
            PG8_WAIT_V(8); PG8_WAIT_L(0); PG8_BAR; PG8_MMA(0, 0, At, B0); PG8_MMA(0, 1, At, B1); PG8_BAR; PG8_SCHED;
            PG8_LDA(At, 0, 1); PG8_STAGE(PG8_SB(0, 0), b2, voffB); PG8_STAGE(PG8_SB(0, 1), b2 + hstep, voffB); PG8_STAGE(PG8_SA(0, 0), a2, voffA);
            PG8_WAIT_V(8); PG8_WAIT_L(0); PG8_BAR; PG8_MMA(1, 0, At, B0); PG8_MMA(1, 1, At, B1); PG8_BAR; PG8_SCHED;
            PG8_LDB(B0, 1, 0); PG8_LDB(B1, 1, 1); PG8_SCHED; PG8_LDA(At, 1, 0); PG8_STAGE(PG8_SA(0, 1), a2 + hstep, voffA);
            PG8_WAIT_V(8); PG8_WAIT_L(0); PG8_BAR; PG8_MMA(0, 0, At, B0); PG8_MMA(0, 1, At, B1); PG8_BAR; PG8_SCHED;
            PG8_LDA(At, 1, 1); PG8_STAGE(PG8_SB(1, 0), b3, voffB); PG8_STAGE(PG8_SB(1, 1), b3 + hstep, voffB); PG8_STAGE(PG8_SA(1, 0), a3, voffA);
            PG8_WAIT_V(8); PG8_WAIT_L(0); PG8_BAR; PG8_MMA(1, 0, At, B0); PG8_MMA(1, 1, At, B1); PG8_BAR; PG8_SCHED;
            } else {
            PG8_LDB(B0, 0, 0); PG8_SCHED; PG8_LDA(At, 0, 0); PG8_STAGE(PG8_SA(1, 1), a1 + hstep, voffA);
            PG8_WAIT_L(8); PG8_BAR; PG8_WAIT_L(0); PG8_MMA(0, 0, At, B0); PG8_BAR; PG8_SCHED;
            PG8_LDB(B1, 0, 1); PG8_STAGE(PG8_SB(0, 0), b2, voffB);
            PG8_BAR; PG8_WAIT_L(0); PG8_MMA(0, 1, At, B1); PG8_BAR;
            PG8_LDA(At, 0, 1); PG8_STAGE(PG8_SA(0, 0), a2, voffA);
            PG8_BAR; PG8_WAIT_L(0); PG8_MMA(1, 0, At, B0); PG8_BAR; PG8_SCHED;
            PG8_STAGE(PG8_SB(0, 1), b2 + hstep, voffB);
            PG8_WAIT_V(6); PG8_BAR; PG8_MMA(1, 1, At, B1); PG8_BAR;
            PG8_LDB(B0, 1, 0); PG8_SCHED; PG8_LDA(At, 1, 0); PG8_STAGE(PG8_SA(0, 1), a2 + hstep, voffA);
            PG8_WAIT_L(8); PG8_BAR; PG8_WAIT_L(0); PG8_MMA(0, 0, At, B0); PG8_BAR; PG8_SCHED;
            PG8_LDB(B1, 1, 1); PG8_STAGE(PG8_SB(1, 0), b3, voffB);
            PG8_BAR; PG8_WAIT_L(0); PG8_MMA(0, 1, At, B1); PG8_BAR;
            PG8_LDA(At, 1, 1); PG8_STAGE(PG8_SA(1, 0), a3, voffA);
            PG8_BAR; PG8_WAIT_L(0); PG8_MMA(1, 0, At, B0); PG8_BAR; PG8_SCHED;
            PG8_STAGE(PG8_SB(1, 1), b3 + hstep, voffB);
            PG8_WAIT_V(6); PG8_BAR; PG8_MMA(1, 1, At, B1); PG8_BAR;
            }
        }
        if constexpr (ALIGN_EPI) { if (wr == 0) PG8_BAR; }
        if constexpr (!Epi::AFTER_DRAIN) { E(acc, cur, wr, wc, fr, fq); S.done(cur); }
        if (!has_next) break;
#pragma unroll
        for (int a = 0; a < 2; ++a)
#pragma unroll
            for (int b = 0; b < 2; ++b)
#pragma unroll
                for (int m = 0; m < 4; ++m)
#pragma unroll
                    for (int n = 0; n < 2; ++n) acc[a][b][m][n] = (f32x4){0.f, 0.f, 0.f, 0.f};
        cur = nxt; cA = nA; cB = nB; ++ui;
        if constexpr (ALIGN_EPI) { if (wr == 1) PG8_BAR; }
    }
    PG8_WAIT_V(0);
    if constexpr (!ALIGN_EPI) { if (wr == 0) PG8_BAR; }
    PG8_BAR;
    if constexpr (Epi::AFTER_DRAIN) { E.fused(acc, cur, wr, wc, fr, fq, lds, wid, lane); S.done(cur); }
#undef PG8_SA
#undef PG8_SB
#undef PG8_STAGE
#undef PG8_LDA
#undef PG8_LDB
#undef PG8_MMA
#undef PG8_WAIT_V
#undef PG8_WAIT_L
#undef PG8_BAR
#undef PG8_SCHED
}
}

namespace att {
using pg8::bf16_t; using pg8::bf16x8; using pg8::u32x4; using pg8::f32x4;
typedef float f32x16 __attribute__((ext_vector_type(16)));
typedef short s16x4 __attribute__((ext_vector_type(4)));
typedef short v4i16_t __attribute__((ext_vector_type(4)));
typedef unsigned u32x2 __attribute__((ext_vector_type(2)));
#define LAS __attribute__((address_space(3)))
typedef LAS char* lptr; typedef const LAS char* lcptr;
constexpr float L2E = 1.4426950408889634f;
constexpr float NEG_INIT = -1e30f;
constexpr int SEQ = 8192;
#define MFMA32(a, b, c) __builtin_amdgcn_mfma_f32_32x32x16_bf16((a), (b), (c), 0, 0, 0)
DI int crow(int r, int hi) { return (r & 3) + 8 * (r >> 2) + 4 * hi; }
DI s16x4 vtr(lcptr p) { return __builtin_bit_cast(s16x4, __builtin_amdgcn_ds_read_tr16_b64_v4i16((LAS v4i16_t*)p)); }
DI float xhalf(float v) { return __shfl_xor(v, 32); }
DI void stage_load(const bf16_t* Kt, const bf16_t* Vt, int wid, int lane, u32x4& kr, u32x4& vr, bool needV) {
    kr = *(const u32x4*)(Kt + lane * 64 + wid * 8);
    if (needV) vr = *(const u32x4*)(Vt + (16 * (wid & 3) + (lane >> 2)) * 64 + (wid >> 2) * 32 + (lane & 3) * 8);
}
DI void stage_write(lptr slot, int wid, int lane, const u32x4& kr, const u32x4& vr, bool needV) {
    *(LAS u32x4*)(slot + wid * 1024 + lane * 16) = kr;
    if (needV) *(LAS u32x4*)(slot + 8192 + wid * 1024 + lane * 16) = vr;
}
DI void qk_tile(f32x16& p0, f32x16& p1, lcptr Ks, const bf16x8 (&qr)[4], int r32, int hi) {
    lcptr kb = Ks + hi * 1024 + r32 * 16;
    f32x16 z;
#pragma unroll
    for (int i = 0; i < 16; ++i) z[i] = 0.f;
    p0 = z; p1 = z;
#pragma unroll
    for (int d0 = 0; d0 < 4; ++d0) {
        const bf16x8 b0 = *(const LAS bf16x8*)(kb + d0 * 2048), b1 = *(const LAS bf16x8*)(kb + d0 * 2048 + 512);
        p0 = MFMA32(b0, qr[d0], p0); p1 = MFMA32(b1, qr[d0], p1);
    }
}
DI bf16x8 pack8(const f32x16& p, int base) {
    u32x4 w; w.x = pg8::cvtpk(p[base], p[base + 1]); w.y = pg8::cvtpk(p[base + 2], p[base + 3]); w.z = pg8::cvtpk(p[base + 4], p[base + 5]); w.w = pg8::cvtpk(p[base + 6], p[base + 7]);
    return __builtin_bit_cast(bf16x8, w);
}
DI void pv_tile(f32x16 (&o)[2], lcptr Vs, const f32x16& p0, const f32x16& p1, int lane, int hi) {
    lcptr vb = Vs + ((lane >> 4) & 1) * 32 + (lane & 3) * 8 + (4 * hi + ((lane & 15) >> 2)) * 64;
    bf16x8 pf[4]; pf[0] = pack8(p0, 0); pf[1] = pack8(p0, 8); pf[2] = pack8(p1, 0); pf[3] = pack8(p1, 8);
#pragma unroll
    for (int dh = 0; dh < 2; ++dh)
#pragma unroll
        for (int ks = 0; ks < 4; ++ks) {
            const s16x4 lo = vtr(vb + dh * 4096 + ks * 1024), hh = vtr(vb + dh * 4096 + ks * 1024 + 512);
            const bf16x8 vf = (bf16x8){lo[0], lo[1], lo[2], lo[3], hh[0], hh[1], hh[2], hh[3]};
            o[dh] = MFMA32(vf, pf[ks], o[dh]);
        }
}
DI float mask_scale(f32x16& p0, f32x16& p1, int klo, int khi, int hi) {
    const bool full = (klo <= 0) && (khi >= 63), none = (khi < klo) || (khi < 0) || (klo > 63);
    float mx;
    if (__all(full || none)) {
        const float bias = full ? 0.f : -INFINITY;
        float a = fmaxf(p0[0], p1[0]);
#pragma unroll
        for (int r = 1; r < 16; ++r) a = fmaxf(a, fmaxf(p0[r], p1[r]));
#pragma unroll
        for (int r = 0; r < 16; ++r) { p0[r] = p0[r] * L2E + bias; p1[r] = p1[r] * L2E + bias; }
        mx = a * L2E + bias;
    } else {
        const int lo2 = klo - 4 * hi, hi2 = khi - 4 * hi;
        float a = -INFINITY;
#pragma unroll
        for (int r = 0; r < 16; ++r) { const int kc = (r & 3) + 8 * (r >> 2);
            p0[r] = (kc >= lo2 && kc <= hi2) ? p0[r] * L2E : -INFINITY; p1[r] = (kc + 32 >= lo2 && kc + 32 <= hi2) ? p1[r] * L2E : -INFINITY; a = fmaxf(a, fmaxf(p0[r], p1[r])); }
        mx = a;
    }
    return fmaxf(mx, xhalf(mx));
}
DI void tile_online(lcptr slot, const bf16x8 (&qr)[4], int klo, int khi, float& m, float& l, f32x16 (&o)[2], int lane, int r32, int hi) {
    { const bool none = (khi < klo) || (khi < 0) || (klo > 63); if (__all(none)) return; }
    f32x16 p0, p1; qk_tile(p0, p1, slot, qr, r32, hi);
    const float mt = mask_scale(p0, p1, klo, khi, hi);
    const float mn = fmaxf(m, mt), alpha = __builtin_amdgcn_exp2f(m - mn); m = mn;
    float s = 0.f;
#pragma unroll
    for (int r = 0; r < 16; ++r) { p0[r] = __builtin_amdgcn_exp2f(p0[r] - mn); p1[r] = __builtin_amdgcn_exp2f(p1[r] - mn); s += p0[r] + p1[r]; }
    l = l * alpha + s;
#pragma unroll
    for (int r = 0; r < 16; ++r) { o[0][r] *= alpha; o[1][r] *= alpha; }
    pv_tile(o, slot + 8192, p0, p1, lane, hi);
}
constexpr float THR = 4.0f;
DI float max3f(float a, float b, float c) { return __builtin_fmaxf(__builtin_fmaxf(a, b), c); }
DI void tile_online2(lcptr slot, const bf16x8 (&qr)[4], int klo, int khi, float& mneg, bool& has, float& l, f32x16 (&o)[2], int lane, int r32, int hi) {
    const bool full = (klo <= 0) && (khi >= 63), none = (khi < klo) || (khi < 0) || (klo > 63);
    if (__all(none)) return;
    f32x16 p0, p1;
    { const float cinit = none ? -INFINITY : mneg;
#pragma unroll
      for (int r = 0; r < 16; ++r) { p0[r] = cinit; p1[r] = cinit; }
      lcptr kb = slot + hi * 1024 + r32 * 16;
#pragma unroll
      for (int d0 = 0; d0 < 4; ++d0) {
          const bf16x8 b0 = *(const LAS bf16x8*)(kb + d0 * 2048), b1 = *(const LAS bf16x8*)(kb + d0 * 2048 + 512);
          p0 = MFMA32(b0, qr[d0], p0); p1 = MFMA32(b1, qr[d0], p1);
      } }
    if (!__all(full || none)) {
        const int lo2 = klo - 4 * hi, hi2 = khi - 4 * hi;
#pragma unroll
        for (int r = 0; r < 16; ++r) { const int kc = (r & 3) + 8 * (r >> 2);
            p0[r] = (kc >= lo2 && kc <= hi2) ? p0[r] : -INFINITY; p1[r] = (kc + 32 >= lo2 && kc + 32 <= hi2) ? p1[r] : -INFINITY; }
    }
    float rm;
    { float a = max3f(p0[0], p0[1], p1[0]), b = max3f(p0[2], p0[3], p1[1]); a = max3f(a, p1[2], p1[3]);
#pragma unroll
      for (int r = 4; r < 16; r += 4) { a = max3f(a, p0[r], p0[r + 1]); b = max3f(b, p0[r + 2], p0[r + 3]); a = max3f(a, p1[r], p1[r + 1]); b = max3f(b, p1[r + 2], p1[r + 3]); }
      rm = fmaxf(a, b); rm = fmaxf(rm, xhalf(rm)); }
    const bool trig = has ? (rm > THR) : (rm > -INFINITY);
    if (__any(trig)) {
        const float dl = trig ? rm : 0.f;
        const float f = has ? __builtin_amdgcn_exp2f(-dl) : 1.0f;
        mneg -= dl; has = has || trig;
#pragma unroll
        for (int r = 0; r < 16; ++r) { p0[r] -= dl; p1[r] -= dl; }
        l *= f;
#pragma unroll
        for (int r = 0; r < 16; ++r) { o[0][r] *= f; o[1][r] *= f; }
    }
    float s0 = 0.f, s1 = 0.f;
#pragma unroll
    for (int r = 0; r < 16; ++r) { p0[r] = __builtin_amdgcn_exp2f(p0[r]); p1[r] = __builtin_amdgcn_exp2f(p1[r]); s0 += p0[r]; s1 += p1[r]; }
    l += s0 + s1;
    pv_tile(o, slot + 8192, p0, p1, lane, hi);
}
DI void tile_stats(lcptr slot, const bf16x8 (&qr)[4], int klo, int khi, float& m, float& l, int r32, int hi) {
    f32x16 p0, p1; qk_tile(p0, p1, slot, qr, r32, hi);
    const float mt = mask_scale(p0, p1, klo, khi, hi);
    const float mn = fmaxf(m, mt), alpha = __builtin_amdgcn_exp2f(m - mn); m = mn;
    float s = 0.f;
#pragma unroll
    for (int r = 0; r < 16; ++r) s += __builtin_amdgcn_exp2f(p0[r] - mn) + __builtin_amdgcn_exp2f(p1[r] - mn);
    l = l * alpha + s;
}
DI void tile_final(lcptr slot, const bf16x8 (&qr)[4], int klo, int khi, float m, float inv, f32x16 (&o)[2], float& carry, LAS float* imp_row  , bool writer, int lane, int r32, int hi) {
    f32x16 p0, p1; qk_tile(p0, p1, slot, qr, r32, hi);
    (void)mask_scale(p0, p1, klo, khi, hi);
#pragma unroll
    for (int r = 0; r < 16; ++r) { p0[r] = __builtin_amdgcn_exp2f(p0[r] - m) * inv; p1[r] = __builtin_amdgcn_exp2f(p1[r] - m) * inv; }
    float y3[8];
#pragma unroll
    for (int x = 0; x < 4; ++x) { y3[x] = xhalf(p0[4 * x + 3]); y3[4 + x] = xhalf(p1[4 * x + 3]); }
#pragma unroll
    for (int x = 0; x < 8; ++x) {
        const float bs = (x < 4) ? (p0[4 * x] + p0[4 * x + 1]) + (p0[4 * x + 2] + p0[4 * x + 3]) : (p1[4 * (x - 4)] + p1[4 * (x - 4) + 1]) + (p1[4 * (x - 4) + 2] + p1[4 * (x - 4) + 3]);
        const float prev = (x == 0) ? carry : y3[x == 0 ? 0 : x - 1];
        float v = bs + (hi ? y3[x] : prev);
        v += __shfl_xor(v, 1); v += __shfl_xor(v, 2);
        if (writer) imp_row[2 * x + hi] = v;
    }
    carry = y3[7];
    pv_tile(o, slot + 8192, p0, p1, lane, hi);
}
struct AP {
    unsigned char* ws;
#define AP_PTR(name, T_, off) DI T_* name() const { return (T_*)(ws + (off)); }
    AP_PTR(QN, const bf16_t, 80ull << 20) AP_PTR(QR, const bf16_t, 112ull << 20) AP_PTR(KCC, const bf16_t, (2ull << 20) + 256 * 1024) AP_PTR(VCC, const bf16_t, (2ull << 20) + 768 * 1024)
    AP_PTR(KS, const bf16_t, 160ull << 20) AP_PTR(VS, const bf16_t, 168ull << 20) AP_PTR(KW, const bf16_t, 176ull << 20) AP_PTR(VW, const bf16_t, 184ull << 20)
    AP_PTR(ZS, const bf16_t, 192ull << 20) AP_PTR(MQ, const bf16_t, 256ull << 20) AP_PTR(MK, const bf16_t, 288ull << 20) AP_PTR(MV, const bf16_t, 320ull << 20)
    AP_PTR(GT, const float, 352ull << 20) AP_PTR(KM, const float, 2ull << 20) AP_PTR(Y, bf16_t, 16ull << 20)
#undef AP_PTR
};
#define TILE_LOOP(NT, KPTR_EXPR, VPTR_EXPR, NEEDV, BOUNDS_STMT, COMPUTE_STMT) \
  { u32x4 kr_ = {0u, 0u, 0u, 0u}, vr_ = {0u, 0u, 0u, 0u}; \
    { const int i = 0; (void)i; stage_load(KPTR_EXPR, VPTR_EXPR, wid, lane, kr_, vr_, NEEDV); } \
    stage_write(lds, wid, lane, kr_, vr_, NEEDV); __syncthreads(); \
    const int nt_ = (NT); \
    for (int i_ = 0; i_ < nt_; ++i_) { \
      const bool more_ = i_ + 1 < nt_; \
      if (more_) { const int i = i_ + 1; (void)i; stage_load(KPTR_EXPR, VPTR_EXPR, wid, lane, kr_, vr_, NEEDV); } \
      { const int i = i_; (void)i; lcptr slot = lds + (i_ & 1) * 16384; int klo, khi; BOUNDS_STMT; COMPUTE_STMT; } \
      if (more_) stage_write(lds + ((i_ + 1) & 1) * 16384, wid, lane, kr_, vr_, NEEDV); \
      __syncthreads(); } }
DI void zero2(f32x16 (&o)[2]) {
#pragma unroll
    for (int r = 0; r < 16; ++r) { o[0][r] = 0.f; o[1][r] = 0.f; }
}
DI void load_q(bf16x8 (&qr)[4], const bf16_t* qrow, int hi) {
#pragma unroll
    for (int d0 = 0; d0 < 4; ++d0) qr[d0] = *(const bf16x8*)(qrow + 16 * d0 + 8 * hi);
}
DI float bf_lo(unsigned w) { return __uint_as_float(w << 16); }
DI float bf_hi(unsigned w) { return __uint_as_float(w & 0xffff0000u); }
DI void write_y(const f32x16 (&o)[2], float scale, const bf16_t* zrow, bf16_t* yrow, int hi) {
#pragma unroll
    for (int dh = 0; dh < 2; ++dh)
#pragma unroll
        for (int gq = 0; gq < 4; ++gq) {
            const int d = 32 * dh + 8 * gq + 4 * hi;
            const u32x2 z = *(const u32x2*)(zrow + d);
            u32x2 w; w.x = pg8::cvtpk(o[dh][4 * gq] * scale * bf_lo(z.x), o[dh][4 * gq + 1] * scale * bf_hi(z.x)); w.y = pg8::cvtpk(o[dh][4 * gq + 2] * scale * bf_lo(z.y), o[dh][4 * gq + 3] * scale * bf_hi(z.y));
            *(u32x2*)(yrow + d) = w;
        }
}
DI void nsa_item(const AP& P, lptr lds, int b, int g, int c, int wid, int lane) {
    const int r32 = lane & 31, hi = lane >> 5, qi = r32 >> 2, hh = r32 & 3, H = 4 * g + hh;
    const int tq = 64 * c + 8 * wid + qi;
    const size_t qoff = ((size_t)(b * 8 + H) * SEQ + tq) * 64;
    const size_t row = (size_t)b * SEQ + tq;
    bf16x8 qr[4]; load_q(qr, P.QN() + qoff, hi);
    const float* gp = P.GT() + row * 32 + H * 3; const float g0 = gp[0], g1 = gp[1], g2 = gp[2];
    f32x16 o[2];
    LAS float* otl = (LAS float*)(lds + 69632) + (wid * 64 + lane);
    const int ntok = (4 * c + 3) < 511 ? (4 * c + 3) : 511, ntc = (ntok + 63) >> 6;
    const bf16_t* kcc = P.KCC() + (size_t)(b * 2 + g) * 512 * 64; const bf16_t* vcc = P.VCC() + (size_t)(b * 2 + g) * 512 * 64;
    int khi_abs = (tq - 31) >> 4; khi_abs = khi_abs < 510 ? khi_abs : 510;
    float m = NEG_INIT, l = 0.f;
    TILE_LOOP(ntc, kcc + i * 4096, vcc + i * 4096, false, { klo = -64 * i; khi = khi_abs - 64 * i; }, tile_stats(slot, qr, klo, khi, m, l, r32, hi));
    l += xhalf(l);
    { const float inv = l > 0.f ? 1.0f / l : 0.f; float carry = 0.f; zero2(o);
      LAS float* imp = (LAS float*)(lds + 32768) + (8 * wid + qi) * 128;
      TILE_LOOP(ntc, kcc + i * 4096, vcc + i * 4096, true, { klo = -64 * i; khi = khi_abs - 64 * i; }, tile_final(slot, qr, klo, khi, m, inv, o, carry, imp + 16 * i, hh == 0, lane, r32, hi));
#pragma unroll
      for (int r = 0; r < 16; ++r) { otl[r * 512] = g0 * o[0][r]; otl[(16 + r) * 512] = g0 * o[1][r]; } }
    LAS unsigned* selb = (LAS unsigned*)(lds + 65536);
    for (int q2 = 0; q2 < 8; ++q2) {
        unsigned long long s0, s1;
        if (c <= 15) { s0 = (2ull << c) - 1ull; s1 = 0ull; }
        else {
            const LAS float* ir = (const LAS float*)(lds + 32768) + (8 * wid + q2) * 128;
            const float v0 = ir[lane], v1 = ir[64 + lane];
            const int nc2 = c - 2;
            const unsigned k0 = (lane >= 1 && lane <= nc2) ? __float_as_uint(v0) + 1u : 0u, k1 = (lane + 64 <= nc2) ? __float_as_uint(v1) + 1u : 0u;
            unsigned lo = 1u, hb = 0x7f800002u; unsigned long long m0 = 0ull, m1 = 0ull; bool exact = false;
            while (hb - lo > 1u) {
                const unsigned mid = lo + ((hb - lo) >> 1);
                m0 = __ballot(k0 >= mid); m1 = __ballot(k1 >= mid);
                const int cnt = __popcll(m0) + __popcll(m1);
                if (cnt == 13) { exact = true; break; }
                if (cnt > 13) lo = mid; else hb = mid;
            }
            if (!exact) {
                const unsigned long long gg0 = __ballot(k0 > lo), gg1 = __ballot(k1 > lo), e0 = __ballot(k0 == lo), e1 = __ballot(k1 == lo);
                const int need = 13 - __popcll(gg0) - __popcll(gg1);
                const unsigned long long lt = (1ull << lane) - 1ull;
                const int r0 = __popcll(e0 & lt), r1 = __popcll(e0) + __popcll(e1 & lt);
                m0 = gg0 | __ballot(k0 == lo && r0 < need); m1 = gg1 | __ballot(k1 == lo && r1 < need);
            }
            s0 = m0 | 1ull; s1 = m1;
            if (c - 1 < 64) s0 |= 1ull << (c - 1); else s1 |= 1ull << (c - 65);
            if (c < 64) s0 |= 1ull << c; else s1 |= 1ull << (c - 64);
        }
        if (lane == 0) { LAS unsigned* sp = selb + (8 * wid + q2) * 4; sp[0] = (unsigned)s0; sp[1] = (unsigned)(s0 >> 32); sp[2] = (unsigned)s1; sp[3] = (unsigned)(s1 >> 32); }
    }
    const unsigned sb0 = selb[(8 * wid + qi) * 4 + 0], sb1 = selb[(8 * wid + qi) * 4 + 1], sb2 = selb[(8 * wid + qi) * 4 + 2], sb3 = selb[(8 * wid + qi) * 4 + 3];
    load_q(qr, P.QR() + qoff, hi);
    const bf16_t* ks = P.KS() + (size_t)(b * 2 + g) * SEQ * 64; const bf16_t* vs = P.VS() + (size_t)(b * 2 + g) * SEQ * 64;
    float mneg = 0.f; bool has = false; l = 0.f; zero2(o);
    TILE_LOOP(c + 1, ks + (size_t)i * 4096, vs + (size_t)i * 4096, true,
              { klo = 0; const unsigned w = i < 32 ? sb0 : i < 64 ? sb1 : i < 96 ? sb2 : sb3; khi = (i == c) ? (tq - 64 * c) : (((w >> (i & 31)) & 1u) ? 63 : -1); },
              tile_online2(slot, qr, klo, khi, mneg, has, l, o, lane, r32, hi));
    l += xhalf(l);
    { const float f = l > 0.f ? g1 / l : 0.f;
#pragma unroll
      for (int r = 0; r < 16; ++r) { otl[r * 512] += f * o[0][r]; otl[(16 + r) * 512] += f * o[1][r]; } }
    const bf16_t* kw = P.KW() + (size_t)(b * 2 + g) * SEQ * 64; const bf16_t* vw = P.VW() + (size_t)(b * 2 + g) * SEQ * 64;
    const int j0 = c > 8 ? c - 8 : 0;
    mneg = 0.f; has = false; l = 0.f; zero2(o);
    TILE_LOOP(c - j0 + 1, kw + (size_t)(j0 + i) * 4096, vw + (size_t)(j0 + i) * 4096, true,
              { const int base = 64 * (j0 + i); klo = tq - 511 - base; khi = tq - base; },
              tile_online2(slot, qr, klo, khi, mneg, has, l, o, lane, r32, hi));
    l += xhalf(l);
    { const float f = l > 0.f ? g2 / l : 0.f;
#pragma unroll
      for (int r = 0; r < 16; ++r) { o[0][r] = otl[r * 512] + f * o[0][r]; o[1][r] = otl[(16 + r) * 512] + f * o[1][r]; } }
    write_y(o, 1.0f, P.ZS() + row * 1024 + H * 64, P.Y() + row * 1024 + H * 64, hi);
}
DI void moba_item(const AP& P, lptr lds, int b, int h, int own, int wid, int lane, int tid) {
    const int r32 = lane & 31, hi = lane >> 5;
    const int tq = 256 * own + 32 * wid + r32;
    const size_t hb = (size_t)(b * 8 + h) * SEQ * 64;
    const size_t row = (size_t)b * SEQ + tq;
    bf16x8 qr[4]; load_q(qr, P.MQ() + hb + (size_t)tq * 64, hi);
    unsigned bits = 0u;
    if (own <= 3) bits = (1u << own) - 1u;
    else {
        { const int j = tid >> 4, d4 = (tid & 15) * 4;
          const f32x4 km = *(const f32x4*)(P.KM() + ((size_t)(b * 8 + h) * 32 + j) * 64 + d4);
          const unsigned h01 = pg8::cvtpk(km[0], km[1]), h23 = pg8::cvtpk(km[2], km[3]);
          const unsigned l01 = pg8::cvtpk(km[0] - bf_lo(h01), km[1] - bf_hi(h01)), l23 = pg8::cvtpk(km[2] - bf_lo(h23), km[3] - bf_hi(h23));
          const int off = (d4 >> 3) * 1024 + j * 16 + (d4 & 7) * 2;
          *(LAS u32x2*)(lds + off) = (u32x2){h01, h23}; *(LAS u32x2*)(lds + 16384 + off) = (u32x2){l01, l23}; }
        __syncthreads();
        f32x16 sg;
#pragma unroll
        for (int r = 0; r < 16; ++r) sg[r] = 0.f;
        { lcptr kb = lds + hi * 1024 + r32 * 16;
#pragma unroll
          for (int d0 = 0; d0 < 4; ++d0) { const bf16x8 a = *(const LAS bf16x8*)(kb + d0 * 2048), a2 = *(const LAS bf16x8*)(kb + 16384 + d0 * 2048); sg = MFMA32(a, qr[d0], sg); sg = MFMA32(a2, qr[d0], sg); } }
#pragma unroll
        for (int r = 0; r < 16; ++r) if (crow(r, hi) >= own) sg[r] = -INFINITY;
#pragma unroll
        for (int rd = 0; rd < 3; ++rd) {
            float best = sg[0]; int bj = crow(0, hi);
#pragma unroll
            for (int r = 1; r < 16; ++r) if (sg[r] > best) { best = sg[r]; bj = crow(r, hi); }
            const float ob = xhalf(best); const int oj = __shfl_xor(bj, 32);
            if (ob > best || (ob == best && oj < bj)) { best = ob; bj = oj; }
            if (best > -INFINITY) bits |= 1u << bj;
#pragma unroll
            for (int r = 0; r < 16; ++r) if (crow(r, hi) == bj) sg[r] = -INFINITY;
        }
        __syncthreads();
    }
    const bf16_t* mk = P.MK() + hb; const bf16_t* mv = P.MV() + hb;
    float mneg = 0.f, l = 0.f; bool has = false; f32x16 o[2]; zero2(o);
    TILE_LOOP(4 * (own + 1), mk + (size_t)i * 4096, mv + (size_t)i * 4096, true,
              { const int j = i >> 2; klo = 0; khi = (j < own) ? (((bits >> j) & 1u) ? 63 : -1) : (tq - 64 * i); },
              tile_online2(slot, qr, klo, khi, mneg, has, l, o, lane, r32, hi));
    l += xhalf(l);
    write_y(o, l > 0.f ? 1.0f / l : 0.f, P.ZS() + row * 1024 + 512 + h * 64, P.Y() + row * 1024 + 512 + h * 64, hi);
}
}
using att::lptr; using att::lcptr;
using pg8::bf16_t; using pg8::bf16x8; using pg8::u32x4; using pg8::f32x4;
constexpr int NWAVES = 8, NTHREADS = 512;
constexpr int BATCH = 4, T = 8192, DM = 1024, M = BATCH * T;
constexpr int NPROJ = 4096;
constexpr float LN_EPS = 1e-5f;
constexpr size_t MiB = 1u << 20;
constexpr size_t WS_CTL = 0;
constexpr size_t WS_ROPE = 1 * MiB;
constexpr size_t WS_B1P = WS_ROPE + 512 * 1024;
constexpr size_t WS_KM = 2 * MiB;
constexpr size_t WS_KCC = WS_KM + 256 * 1024;
constexpr size_t WS_VCC = WS_KCC + 512 * 1024;
constexpr size_t WS_W2T = WS_VCC + 512 * 1024;
constexpr size_t WS_W1T = 4 * MiB;
constexpr size_t WS_WOT = 6 * MiB;
constexpr size_t WS_WT = 8 * MiB;
constexpr size_t WS_XB = 16 * MiB;
constexpr size_t WS_Y = WS_XB;
constexpr size_t WS_QN = 80 * MiB, WS_QR = 112 * MiB;
constexpr size_t WS_KC = 144 * MiB, WS_VC = 152 * MiB, WS_KS = 160 * MiB, WS_VS = 168 * MiB, WS_KW = 176 * MiB, WS_VW = 184 * MiB;
constexpr size_t WS_ZS = 192 * MiB;
constexpr size_t WS_MQ = 256 * MiB, WS_MK = 288 * MiB, WS_MV = 320 * MiB;
constexpr size_t WS_GT = 352 * MiB;
constexpr size_t WS_END = 356 * MiB;
constexpr int LDS_BYTES = 135168;

static_assert(WS_QN == (80ull << 20) && WS_QR == (112ull << 20) && WS_KCC == (2ull << 20) + 256 * 1024 && WS_VCC == (2ull << 20) + 768 * 1024 && WS_KS == (160ull << 20) && WS_VS == (168ull << 20) && WS_KW == (176ull << 20) && WS_VW == (184ull << 20) && WS_ZS == (192ull << 20) && WS_MQ == (256ull << 20) && WS_MK == (288ull << 20) && WS_MV == (320ull << 20) && WS_GT == (352ull << 20) && WS_KM == (2ull << 20) && WS_Y == (16ull << 20) && WS_KC == (144ull << 20) && WS_VC == (152ull << 20) && WS_ROPE == (1ull << 20), "AP / EpiProj offsets");
struct Args { const float* in[13]; float* out; unsigned char* ws; int ph_lo, ph_hi; };

DI unsigned pk2(float lo, float hi) { return pg8::cvtpk(lo, hi); }
template <class Map> DI void transpose_item(const float* W, int ldw, Map srccol, bf16_t* WT, int K, LAS float* scr, int kb, int nb, int lane) {
    const int k0 = 64 * kb, n0 = 32 * nb; const int sc = srccol(n0 + (lane & 31));
#pragma unroll 8
    for (int i = 0; i < 32; ++i) { const int kk = 2 * i + (lane >> 5); scr[kk * 33 + (lane & 31)] = sc >= 0 ? W[(size_t)(k0 + kk) * ldw + sc] : 0.f; }
    asm volatile("s_waitcnt lgkmcnt(0)" ::: "memory");
    const int c = lane & 7;
#pragma unroll
    for (int j = 0; j < 4; ++j) { const int n = (lane >> 3) + 8 * j; const LAS float* s = scr + (8 * c) * 33 + n;
        u32x4 o; o.x = pk2(s[0 * 33], s[1 * 33]); o.y = pk2(s[2 * 33], s[3 * 33]); o.z = pk2(s[4 * 33], s[5 * 33]); o.w = pk2(s[6 * 33], s[7 * 33]);
        *(u32x4*)(WT + (size_t)(n0 + n) * K + k0 + 8 * c) = o; }
    asm volatile("s_waitcnt lgkmcnt(0)" ::: "memory");
}
struct MapIdent { DI int operator()(int n) const { return n; } };
struct MapProj { DI int operator()(int n) const { return n < 1280 ? n : n < 3840 ? n + 24 : n < 3864 ? n - 2560 : -1; } };
DI float wave_sum(float v) {
#pragma unroll
    for (int o = 1; o < 64; o <<= 1) v += __shfl_xor(v, o);
    return v;
}
DI void sincos_d(double a, double& s, double& c) {
    const double q = __builtin_rint(a * 0.63661977236758134308);
    double r = __builtin_fma(-q, 1.57079632679489655800e+00, a); r = __builtin_fma(-q, 6.12323399573676603587e-17, r);
    const double r2 = r * r;
    double ps = -1.0 / 1307674368000.0; ps = ps * r2 + 1.0 / 6227020800.0; ps = ps * r2 - 1.0 / 39916800.0; ps = ps * r2 + 1.0 / 362880.0; ps = ps * r2 - 1.0 / 5040.0; ps = ps * r2 + 1.0 / 120.0; ps = ps * r2 - 1.0 / 6.0; ps = ps * r2 * r + r;
    double pc = 1.0 / 20922789888000.0; pc = pc * r2 - 1.0 / 87178291200.0; pc = pc * r2 + 1.0 / 479001600.0; pc = pc * r2 - 1.0 / 3628800.0; pc = pc * r2 + 1.0 / 40320.0; pc = pc * r2 - 1.0 / 720.0; pc = pc * r2 + 1.0 / 24.0; pc = pc * r2 - 0.5; pc = pc * r2 + 1.0;
    const int qi = (int)((long long)q & 3);
    s = (qi == 0) ? ps : (qi == 1) ? pc : (qi == 2) ? -ps : -pc;
    c = (qi == 0) ? pc : (qi == 1) ? -ps : (qi == 2) ? -pc : ps;
}
struct Frame { lptr lds; int tid, lane, wave, G, bx; };

DI void p0_prep(const Args& a, const Frame& F) {
    unsigned char* ws = a.ws;
    LAS float* scr = (LAS float*)(F.lds + F.wave * 16384);
    const int gw = F.bx * NWAVES + F.wave, NGW = F.G * NWAVES;
    if (F.bx == 0 && F.tid < 64) ((unsigned*)(ws + WS_CTL))[F.tid] = 0u;
    constexpr int I0 = 16 * 128, I1 = 16 * 32, I2 = 32 * 8, I3 = 4 * 2, I4 = 128;
    constexpr int NITEMS = I0 + I1 + 2 * I2 + 2 * I3 + I4;
    for (int it = gw; it < NITEMS; it += NGW) {
        int r = it;
        if (r < I0) { transpose_item(a.in[1], 3864, MapProj(), (bf16_t*)(ws + WS_WT), 1024, scr, r / 128, r % 128, F.lane); continue; } r -= I0;
        if (r < I1) { transpose_item(a.in[10], 1024, MapIdent(), (bf16_t*)(ws + WS_WOT), 1024, scr, r / 32, r % 32, F.lane); continue; } r -= I1;
        if (r < 2 * I2) { const int kv = r / I2; r %= I2; transpose_item(a.in[kv ? 7 : 3], 256, MapIdent(), (bf16_t*)(ws + WS_W1T) + (size_t)kv * 256 * 2048, 2048, scr, r / 8, r % 8, F.lane); continue; } r -= 2 * I2;
        if (r < 2 * I3) { const int kv = r / I3; r %= I3; transpose_item(a.in[kv ? 9 : 5], 64, MapIdent(), (bf16_t*)(ws + WS_W2T) + (size_t)kv * 64 * 256, 256, scr, r / 2, r % 2, F.lane); continue; } r -= 2 * I3;
        {
            float* pp = (float*)(ws + WS_B1P) + (size_t)r * 512;
#pragma unroll
            for (int e = 0; e < 8; ++e) { const int idx = e * 64 + F.lane, kv = idx >> 8, n = idx & 255; const float* pos = a.in[kv ? 6 : 2]; const float* w1 = a.in[kv ? 7 : 3];
                float s = 0.f;
#pragma unroll
                for (int k = 0; k < 16; ++k) s += pos[16 * r + k] * w1[(size_t)(16 * r + k) * 256 + n];
                pp[idx] = s; }
        }
    }
    { const f32x4* x4 = (const f32x4*)a.in[0]; u32x4* xb = (u32x4*)(ws + WS_XB); const size_t n8 = (size_t)M * DM / 8, stride = (size_t)F.G * NTHREADS;
      for (size_t i = (size_t)F.bx * NTHREADS + F.tid; i < n8; i += stride) { const f32x4 v0 = x4[2 * i], v1 = x4[2 * i + 1]; u32x4 o; o.x = pk2(v0[0], v0[1]); o.y = pk2(v0[2], v0[3]); o.z = pk2(v1[0], v1[1]); o.w = pk2(v1[2], v1[3]); xb[i] = o; } }
    { float* rp = (float*)(ws + WS_ROPE);
      for (int i = F.bx * NTHREADS + F.tid; i < T * 8; i += F.G * NTHREADS) { const int t = i >> 3, f = i & 7;
          const float invf = f == 0 ? 1.0f : f == 1 ? 0.19392274f : f == 2 ? 0.03760603f : f == 3 ? 0.0072926646f : f == 4 ? 0.0014142136f : f == 5 ? 0.0002742482f : f == 6 ? 5.318296e-05f : 1.0313386e-05f;
          const float ang = (float)t * invf; double s, c; sincos_d((double)ang, s, c);
          rp[t * 16 + f] = (float)c; rp[t * 16 + 8 + f] = (float)s; } }
}
DI void p2_compress_item(const Args& a, const Frame& F, int item) {
    unsigned char* ws = a.ws;
    const int kv = item >> 6, bg = (item >> 3) & 7, ib = item & 7;
    const bf16_t* src = (const bf16_t*)(ws + (kv ? WS_VC : WS_KC)) + (size_t)bg * T * 64;
    const bf16_t* w1t = (const bf16_t*)(ws + WS_W1T) + (size_t)kv * 256 * 2048;
    const bf16_t* w2t = (const bf16_t*)(ws + WS_W2T) + (size_t)kv * 64 * 256;
    bf16_t* dst = (bf16_t*)(ws + (kv ? WS_VCC : WS_KCC)) + (size_t)bg * 512 * 64;
    LAS float* b1p = (LAS float*)(F.lds);
    LAS float* red = (LAS float*)(F.lds + 1024);
    LAS bf16_t* Hs = (LAS bf16_t*)(F.lds + 4096);
    const int lane = F.lane, wid = F.wave, r32 = lane & 31, hi = lane >> 5;
    { const int n = F.tid & 255, half = F.tid >> 8; const float* pp = (const float*)(ws + WS_B1P) + kv * 256 + n; float s = 0.f;
      for (int j = 0; j < 64; ++j) s += pp[(size_t)(half * 64 + j) * 512];
      red[half * 256 + n] = s; }
    __syncthreads();
    if (F.tid < 256) b1p[F.tid] = red[F.tid] + red[256 + F.tid] + a.in[kv ? 8 : 4][F.tid];
    __syncthreads();
    att::f32x16 acc0, acc1;
#pragma unroll
    for (int r = 0; r < 16; ++r) { acc0[r] = 0.f; acc1[r] = 0.f; }
    { int i0 = 64 * ib + r32, i1 = i0 + 32; i0 = i0 < 510 ? i0 : 510; i1 = i1 < 510 ? i1 : 510;
      const bf16_t* a0p = src + (size_t)i0 * 16 * 64 + 8 * hi; const bf16_t* a1p = src + (size_t)i1 * 16 * 64 + 8 * hi; const bf16_t* bp = w1t + (size_t)(32 * wid + r32) * 2048 + 8 * hi;
#pragma unroll 4
      for (int s = 0; s < 128; ++s) { const bf16x8 fa0 = *(const bf16x8*)(a0p + 16 * s), fa1 = *(const bf16x8*)(a1p + 16 * s), fb = *(const bf16x8*)(bp + 16 * s);
          acc0 = MFMA32(fa0, fb, acc0); acc1 = MFMA32(fa1, fb, acc1); } }
    { const int n = 32 * wid + r32; const float bb = b1p[n];
#pragma unroll
      for (int r = 0; r < 16; ++r) { const int i = att::crow(r, hi);
          Hs[i * 264 + n] = (bf16_t)(pg8::cvtpk(pg8::silu_f(acc0[r] + bb), 0.f) & 0xffffu); Hs[(i + 32) * 264 + n] = (bf16_t)(pg8::cvtpk(pg8::silu_f(acc1[r] + bb), 0.f) & 0xffffu); } }
    __syncthreads();
    if (wid < 4) {
        const int rt = wid >> 1, ct = wid & 1; att::f32x16 acc2;
#pragma unroll
        for (int r = 0; r < 16; ++r) acc2[r] = 0.f;
#pragma unroll
        for (int s = 0; s < 16; ++s) { const bf16x8 fa = *(const LAS bf16x8*)(Hs + (32 * rt + r32) * 264 + 16 * s + 8 * hi), fb = *(const bf16x8*)(w2t + (size_t)(32 * ct + r32) * 256 + 16 * s + 8 * hi);
            acc2 = MFMA32(fa, fb, acc2); }
#pragma unroll
        for (int r = 0; r < 16; ++r) { const int i = 64 * ib + 32 * rt + att::crow(r, hi); dst[(size_t)i * 64 + 32 * ct + r32] = (bf16_t)(pg8::cvtpk(acc2[r], 0.f) & 0xffffu); }
    }
    __syncthreads();
}
DI void p2_kmean_item(const Args& a, const Frame& F, int item) {
    const bf16_t* mk = (const bf16_t*)(a.ws + WS_MK) + (size_t)item * 256 * 64;
    const int c = F.lane & 7, rg = F.lane >> 3; float s[8];
#pragma unroll
    for (int i = 0; i < 8; ++i) s[i] = 0.f;
#pragma unroll 4
    for (int p = 0; p < 32; ++p) { const u32x4 v = *(const u32x4*)(mk + (size_t)(8 * p + rg) * 64 + 8 * c);
        s[0] += att::bf_lo(v.x); s[1] += att::bf_hi(v.x); s[2] += att::bf_lo(v.y); s[3] += att::bf_hi(v.y); s[4] += att::bf_lo(v.z); s[5] += att::bf_hi(v.z); s[6] += att::bf_lo(v.w); s[7] += att::bf_hi(v.w); }
#pragma unroll
    for (int i = 0; i < 8; ++i) { s[i] += __shfl_xor(s[i], 8); s[i] += __shfl_xor(s[i], 16); s[i] += __shfl_xor(s[i], 32); }
    if (rg == 0) { float* o = (float*)(a.ws + WS_KM) + (size_t)item * 64 + 8 * c;
        *(f32x4*)o = (f32x4){s[0], s[1], s[2], s[3]} * (1.0f / 256.0f); *(f32x4*)(o + 4) = (f32x4){s[4], s[5], s[6], s[7]} * (1.0f / 256.0f); }
}
DI void p5_ln(const Args& a, const Frame& F) {
    const int gw = F.bx * NWAVES + F.wave, NGW = F.G * NWAVES;
    const f32x4* gn = (const f32x4*)a.in[11] + F.lane; const f32x4* bs = (const f32x4*)a.in[12] + F.lane;
    for (int r = gw; r < M; r += NGW) {
        f32x4* xr = (f32x4*)(a.out + (size_t)r * DM) + F.lane; f32x4 v[4]; float s = 0.f;
#pragma unroll
        for (int j = 0; j < 4; ++j) { v[j] = xr[64 * j]; s += (v[j][0] + v[j][1]) + (v[j][2] + v[j][3]); }
        const float mean = wave_sum(s) * (1.0f / DM); float s2 = 0.f;
#pragma unroll
        for (int j = 0; j < 4; ++j) { v[j] = v[j] - mean; s2 += (v[j][0] * v[j][0] + v[j][1] * v[j][1]) + (v[j][2] * v[j][2] + v[j][3] * v[j][3]); }
        const float rstd = 1.0f / sqrtf(wave_sum(s2) * (1.0f / DM) + LN_EPS);
#pragma unroll
        for (int j = 0; j < 4; ++j) xr[64 * j] = v[j] * rstd * gn[64 * j] + bs[64 * j];
    }
}
__global__ void __launch_bounds__(NTHREADS, 2) hymba_fwd(Args args) {
    extern __shared__ __attribute__((aligned(16))) unsigned char lds_raw[];
    cg::grid_group grid = cg::this_grid();
    Frame F; F.lds = (lptr)lds_raw; F.tid = threadIdx.x; F.lane = F.tid & 63; F.wave = __builtin_amdgcn_readfirstlane(F.tid >> 6); F.G = gridDim.x; F.bx = blockIdx.x;
    unsigned char* ws = args.ws;
    const int lo = args.ph_lo, hi = args.ph_hi;
#define IN(k) (lo <= (k) && (k) < hi)
#define SEAM(k) do { if (IN(k) && IN((k) + 1)) grid.sync(); } while (0)
#ifndef REPEAT_MASK
#define REPEAT_MASK 0
#endif
#define NREP(k) (((REPEAT_MASK) >> (k)) & 1 ? 2 : 1)
    for (int rep = 0; rep < NREP(0); ++rep) { if (rep) grid.sync();
#ifndef SKIP_P0
    if (IN(0)) { p0_prep(args, F); }
#endif
    }
    SEAM(0);
    for (int rep = 0; rep < NREP(1); ++rep) { if (rep) grid.sync();
#ifndef SKIP_P1
    if (IN(1)) {
        pg8::Gemm g{(const bf16_t*)(ws + WS_XB), (const bf16_t*)(ws + WS_WT), M, NPROJ, DM}; pg8::StaticOrder S; S.init(M, NPROJ, F.G, F.bx);
        pg8::EpiProj E{ws};
        pg8::gemm_phase<pg8::EpiProj, pg8::StaticOrder, true, true>((PG8_LAS unsigned char*)F.lds, g, S, E);
    }
#endif
    }
    SEAM(1);
    for (int rep = 0; rep < NREP(2); ++rep) { if (rep) grid.sync();
#ifndef SKIP_P2
    if (IN(2)) {
        for (int it = F.bx; it < 128; it += F.G) p2_compress_item(args, F, it);
        const int gw = ((F.bx + F.G - 128 % F.G) % F.G) * NWAVES + F.wave;
        for (int it = gw; it < 1024; it += F.G * NWAVES) p2_kmean_item(args, F, it);
    }
#endif
    }
    SEAM(2);
    for (int rep = 0; rep < NREP(3); ++rep) { if (rep) grid.sync();
#ifndef SKIP_P3
    if (IN(3)) {
        att::AP P{ws};
#ifdef PROBE_ZERO_Y
        { u32x4* yb = (u32x4*)(ws + WS_Y); const size_t n8 = (size_t)M * DM / 8; for (size_t i = (size_t)F.bx * NTHREADS + F.tid; i < n8; i += (size_t)F.G * NTHREADS) yb[i] = (u32x4){0u, 0u, 0u, 0u}; }
#else
        unsigned* qctr = (unsigned*)(ws + WS_CTL) + rep;
        LAS unsigned* qw = (LAS unsigned*)(F.lds + 66560);
        for (;;) {
            if (F.tid == 0) *qw = atomicAdd(qctr, 1u);
            __syncthreads();
            const unsigned n = *qw;
            __syncthreads();
            if (n >= 2048u) break;
            const unsigned k = n >> 1;
            if ((n & 1u) == 0u) { const int c = 127 - (int)(k >> 3), bg = (int)(k & 7);
#ifndef SKIP_NSA
 att::nsa_item(P, F.lds, bg >> 1, bg & 1, c, F.wave, F.lane);
#endif
 }
            else { const int own = 31 - (int)(k >> 5), bh = (int)(k & 31);
#ifndef SKIP_MOBA
 att::moba_item(P, F.lds, bh >> 3, bh & 7, own, F.wave, F.lane, F.tid);
#endif
 }
        }
#endif
    }
#endif
    }
    SEAM(3);
    for (int rep = 0; rep < NREP(4); ++rep) { if (rep) grid.sync();
#ifndef SKIP_P4
    if (IN(4)) {
        pg8::Gemm g{(const bf16_t*)(ws + WS_Y), (const bf16_t*)(ws + WS_WOT), M, DM, DM}; pg8::StaticOrder S; S.init(M, DM, F.G, F.bx);
        pg8::EpiOut E{args.in[0], args.out, 1.189207115002721f};
        pg8::gemm_phase<pg8::EpiOut, pg8::StaticOrder, true, true>((PG8_LAS unsigned char*)F.lds, g, S, E);
    }
#endif
    SEAM(4);
    if (IN(5)) p5_ln(args, F);
    }
#undef IN
#undef SEAM
}
#ifndef N_LAUNCHES
#define N_LAUNCHES 1
#endif
extern "C" void kernel_launch(void* const* d_in, const int* in_sizes, int n_in, void* d_out, int out_size, void* d_ws, size_t ws_size, hipStream_t stream) {
    static int grid = 0;
    if (grid == 0) {
        if (n_in != 13 || in_sizes[0] != M * DM || out_size != M * DM || ws_size < WS_END) { fprintf(stderr, "kernel_launch: unexpected shapes (n_in %d, in0 %d, out %d, ws %zu)\n", n_in, n_in > 0 ? in_sizes[0] : -1, out_size, ws_size); grid = -1; return; }
        int dev = 0, cus = 0, per_cu = 0;
        (void)hipGetDevice(&dev); (void)hipDeviceGetAttribute(&cus, hipDeviceAttributeMultiprocessorCount, dev);
        if (hipFuncSetAttribute((const void*)hymba_fwd, hipFuncAttributeMaxDynamicSharedMemorySize, LDS_BYTES) != hipSuccess) { fprintf(stderr, "kernel_launch: hipFuncSetAttribute failed\n"); grid = -1; return; }
        if (hipOccupancyMaxActiveBlocksPerMultiprocessor(&per_cu, (const void*)hymba_fwd, NTHREADS, LDS_BYTES) != hipSuccess || per_cu < 1) { fprintf(stderr, "kernel_launch: occupancy query failed (%d)\n", per_cu); (void)hipGetLastError(); per_cu = 1; }
        grid = cus * (per_cu < 1 ? 1 : 1);
    }
    if (grid < 0) return;
    Args a{};
    for (int i = 0; i < 13; ++i) a.in[i] = (const float*)d_in[i];
    a.out = (float*)d_out; a.ws = (unsigned char*)d_ws;
#if N_LAUNCHES == 1
    a.ph_lo = 0; a.ph_hi = 6;
    void* kargs[] = {&a};
    hipError_t e = hipLaunchCooperativeKernel((const void*)hymba_fwd, dim3(grid), dim3(NTHREADS), kargs, LDS_BYTES, stream);
    if (e != hipSuccess) fprintf(stderr, "cooperative launch failed: %s (grid %d)\n", hipGetErrorString(e), grid);
#else
    for (int p = 0; p < 6; ++p) { a.ph_lo = p; a.ph_hi = p + 1; hipLaunchKernelGGL(hymba_fwd, dim3(grid), dim3(NTHREADS), LDS_BYTES, stream, a); }
#endif
}
```

```cpp
#include <hip/hip_runtime.h>
#include <hip/hip_cooperative_groups.h>
#include <cstdio>
#include <cstdint>
namespace cg = cooperative_groups;
#define DI __device__ __forceinline__
namespace pg8 {
#define PG8_LAS __attribute__((address_space(3)))
typedef unsigned short bf16_t;
typedef short bf16x8 __attribute__((ext_vector_type(8)));
typedef float f32x4 __attribute__((ext_vector_type(4)));
typedef unsigned u32x4 __attribute__((ext_vector_type(4)));
constexpr int BM = 256, BK = 64, HALF = 128, HTB = HALF * BK * 2  , STAGE_BYTES = 8 * HTB, NXCD = 8, WGM = 8;

__host__ __device__ __forceinline__ int lds_byte(int r, int c) { const int st = (r >> 4) * 2 + (c >> 5), rr = r & 15, cc = c & 31, ob = rr * 64 + cc * 2; return st * 1024 + (ob ^ (((ob >> 9) & 1) << 5)); }
__host__ __device__ __forceinline__ void stage_rc(int b, int& R, int& C) { const int st = b / 1024, sb = b % 1024, swz = sb ^ (((sb >> 9) & 1) << 5); R = (st >> 1) * 16 + swz / 64; C = (st & 1) * 32 + (swz % 64) / 2; }
__host__ __device__ __forceinline__ int perm32(int rho) { const int n = rho >> 4, i = rho & 15; return 8 * (i >> 2) + 4 * n + (i & 3); }

struct Unit { int pm, pn; };
struct Gemm { const bf16_t* A; const bf16_t* Bt; int M, N, K; };

struct StaticOrder {
    int nM, nN, nwg, G, c;
    __host__ __device__ void init(int M, int N, int G_, int c_) { nM = M / BM; nN = N / BM; nwg = nM * nN; G = G_; c = c_; }
    __host__ __device__ bool next(int i, Unit& u) const {
        const long L = (long)i * G + c; if (L >= nwg) return false;
        int wgid = (int)L; { const int q = nwg / NXCD, r = nwg % NXCD, xcd = wgid % NXCD, off = wgid / NXCD; wgid = (xcd < r ? xcd * (q + 1) : r * (q + 1) + (xcd - r) * q) + off; }
        const int nig = WGM * nN, gid = wgid / nig, fm = gid * WGM, gsz = (nM - fm) < WGM ? (nM - fm) : WGM;
        u.pm = fm + ((wgid % nig) % gsz); u.pn = (wgid % nig) / gsz; return true;
    }
    __device__ __forceinline__ void a_ready(const Unit&) const {}
    __device__ __forceinline__ void done(const Unit&) const {}
};

typedef float f32x2_t __attribute__((ext_vector_type(2))); typedef __bf16 bf16x2_t __attribute__((ext_vector_type(2)));
DI unsigned cvtpk(float lo, float hi) { f32x2_t v = {lo, hi}; bf16x2_t b = __builtin_convertvector(v, bf16x2_t); return __builtin_bit_cast(unsigned, b); }
DI float silu_f(float v) { return v / (1.0f + __expf(-v)); }
DI float sigm_f(float v) { return 1.0f / (1.0f + __expf(-v)); }
constexpr int SEQ = 8192;
struct EpiProj {
    static constexpr bool PERM = true, AFTER_DRAIN = false;
    unsigned char* ws;
    DI void store8(bf16_t* dst, const float (&v)[8]) const { u32x4 w; w.x = cvtpk(v[0], v[1]); w.y = cvtpk(v[2], v[3]); w.z = cvtpk(v[4], v[5]); w.w = cvtpk(v[6], v[7]); *(u32x4*)dst = w; }
    DI void operator()(const f32x4 (&acc)[2][2][4][2], const Unit& u, int wr, int wc, int fr, int fq) const {
        const int pn = u.pn;
        bf16_t* const QN = (bf16_t*)(ws + (80ull << 20)); bf16_t* const QR = (bf16_t*)(ws + (112ull << 20)); bf16_t* const KC = (bf16_t*)(ws + (144ull << 20)); bf16_t* const VC = (bf16_t*)(ws + (152ull << 20));
        bf16_t* const KS = (bf16_t*)(ws + (160ull << 20)); bf16_t* const VS = (bf16_t*)(ws + (168ull << 20)); bf16_t* const KW = (bf16_t*)(ws + (176ull << 20)); bf16_t* const VW = (bf16_t*)(ws + (184ull << 20));
        bf16_t* const ZS = (bf16_t*)(ws + (192ull << 20)); bf16_t* const MQ = (bf16_t*)(ws + (256ull << 20)); bf16_t* const MK = (bf16_t*)(ws + (288ull << 20)); bf16_t* const MV = (bf16_t*)(ws + (320ull << 20));
        float* const GT = (float*)(ws + (352ull << 20)); const float* const ROPE = (const float*)(ws + (1ull << 20));
#pragma unroll
        for (int ai = 0; ai < 2; ++ai)
#pragma unroll
            for (int m = 0; m < 4; ++m) {
                const int row = u.pm * BM + ai * HALF + wr * 64 + m * 16 + fr; const int b = row >> 13, t = row & (SEQ - 1);
#pragma unroll
                for (int bj = 0; bj < 2; ++bj) {
                    const int col0 = bj * HALF + wc * 32 + 8 * fq; const int hd = col0 >> 6, d0 = col0 & 63;
                    float v[8];
#pragma unroll
                    for (int i = 0; i < 4; ++i) { v[i] = acc[ai][bj][m][0][i]; v[4 + i] = acc[ai][bj][m][1][i]; }
                    int kind = 0; bf16_t* dst = nullptr; bf16_t* dst2 = nullptr; float sc = 1.0f, sc2 = 1.0f;
                    if (pn <= 1)      { kind = 1; sc = 0.125f; sc2 = 1.4426950408889634f; const size_t o = ((size_t)(b * 8 + pn * 4 + hd) * SEQ + t) * 64 + d0; dst = QR + o; dst2 = QN + o; }
                    else if (pn == 2) { const size_t o = ((size_t)(b * 2 + (hd & 1)) * SEQ + t) * 64 + d0; dst = (hd < 2 ? KC : VC) + o; }
                    else if (pn == 3) { const size_t o = ((size_t)(b * 2 + (hd & 1)) * SEQ + t) * 64 + d0; dst = (hd < 2 ? KS : VS) + o; kind = hd < 2 ? 1 : 0; }
                    else if (pn == 4) { const size_t o = ((size_t)(b * 2 + (hd & 1)) * SEQ + t) * 64 + d0; dst = (hd < 2 ? KW : VW) + o; kind = hd < 2 ? 1 : 0; }
                    else if (pn <= 6) { kind = 2; dst = ZS + (size_t)row * 1024 + (pn - 5) * 256 + col0; }
                    else if (pn <= 8) { kind = 1; sc = 0.125f * 1.4426950408889634f; dst = MQ + ((size_t)(b * 8 + (pn - 7) * 4 + hd) * SEQ + t) * 64 + d0; }
                    else if (pn <= 10) { kind = 1; dst = MK + ((size_t)(b * 8 + (pn - 9) * 4 + hd) * SEQ + t) * 64 + d0; }
                    else if (pn <= 12) { dst = MV + ((size_t)(b * 8 + (pn - 11) * 4 + hd) * SEQ + t) * 64 + d0; }
                    else if (pn <= 14) { kind = 2; dst = ZS + (size_t)row * 1024 + 512 + (pn - 13) * 256 + col0; }
                    else kind = 3;
                    if (kind == 3) {
                        if (col0 < 24) {
#pragma unroll
                            for (int i = 0; i < 8; ++i) v[i] = sigm_f(v[i]);
                            float* gp = GT + (size_t)row * 32 + col0; *(f32x4*)gp = (f32x4){v[0], v[1], v[2], v[3]}; *(f32x4*)(gp + 4) = (f32x4){v[4], v[5], v[6], v[7]};
                        }
                        continue;
                    }
                    if (kind == 2) {
#pragma unroll
                        for (int i = 0; i < 8; ++i) v[i] = silu_f(v[i]);
                        store8(dst, v); continue;
                    }
                    if (sc != 1.0f) {
#pragma unroll
                        for (int i = 0; i < 8; ++i) v[i] *= sc;
                    }
                    if (kind == 1) {
                        if (dst2) { store8(dst2, v);
#pragma unroll
                            for (int i = 0; i < 8; ++i) v[i] *= sc2; }
                        if ((wc & 1) == 0) {
                            float pr[8];
#pragma unroll
                            for (int i = 0; i < 8; ++i) pr[i] = __shfl_xor(v[i], 16);
                            if (fq < 2) {
                                const f32x4 c0 = *(const f32x4*)(ROPE + (size_t)t * 16), c1 = *(const f32x4*)(ROPE + (size_t)t * 16 + 4), s0 = *(const f32x4*)(ROPE + (size_t)t * 16 + 8), s1 = *(const f32x4*)(ROPE + (size_t)t * 16 + 12);
                                const float sg = fq == 0 ? -1.0f : 1.0f;
#pragma unroll
                                for (int i = 0; i < 4; ++i) { v[i] = v[i] * c0[i] + sg * pr[i] * s0[i]; v[4 + i] = v[4 + i] * c1[i] + sg * pr[4 + i] * s1[i]; }
                            }
                        }
                    }
                    store8(dst, v);
                }
            }
    }
};
struct EpiOut {
    static constexpr bool PERM = false, AFTER_DRAIN = false;
    const float* Xin; float* O; float alpha;
    DI void operator()(const f32x4 (&acc)[2][2][4][2], const Unit& u, int wr, int wc, int fr, int fq) const {
#pragma unroll
        for (int ai = 0; ai < 2; ++ai)
#pragma unroll
            for (int m = 0; m < 4; ++m) {
                const size_t row = (size_t)(u.pm * BM + ai * HALF + wr * 64 + m * 16 + fr);
#pragma unroll
                for (int bj = 0; bj < 2; ++bj)
#pragma unroll
                    for (int n = 0; n < 2; ++n) { const size_t off = row * 1024 + u.pn * BM + bj * HALF + wc * 32 + n * 16 + 4 * fq; const f32x4 xv = *(const f32x4*)(Xin + off); *(f32x4*)(O + off) = xv * alpha + acc[ai][bj][m][n]; }
            }
    }
};
template <class Epi, class Sched, bool ALIGN_EPI = false, bool SP2 = false>
__device__ __forceinline__ void gemm_phase(PG8_LAS unsigned char* lds, const Gemm g, const Sched& S, const Epi& E) {
    const int tid = threadIdx.x, wid = __builtin_amdgcn_readfirstlane(tid >> 6), lane = tid & 63, wr = wid >> 2, wc = wid & 3, fr = lane & 15, fq = lane >> 4;
    const int K = g.K, nt = K / BK;
    unsigned voffA[2], voffB[2];
#pragma unroll
    for (int i = 0; i < 2; ++i) { int R, C; stage_rc(tid * 16 + i * 8192, R, C); const int Rb = Epi::PERM ? ((R & ~31) + perm32(R & 31)) : R;
        voffA[i] = (unsigned)(R * K + C) * 2u; voffB[i] = (unsigned)(Rb * K + C) * 2u; }
    const size_t kstep = (size_t)(BK * 2);
    const size_t hstep = (size_t)HALF * K * 2;
    const size_t tstep = 2 * hstep;
    const unsigned ldsw = (unsigned)wid * 1024u;
    const int aoff = lds_byte(wr * 64 + fr, fq * 8), boff = lds_byte(wc * 32 + fr, fq * 8);
#define PG8_SA(b, h) (((b) * 2 + (h)) * HTB)
#define PG8_SB(b, h) ((4 + (b) * 2 + (h)) * HTB)
#define PG8_STAGE(bufoff, gbase, voff) do { _Pragma("unroll") for (int _i = 0; _i < 2; ++_i) \
        __builtin_amdgcn_global_load_lds((const unsigned*)((const char*)(gbase) + (voff)[_i]), (PG8_LAS unsigned*)(lds + (bufoff) + ldsw + _i * 8192), 16, 0, 0); } while (0)
#define PG8_LDA(dst, b, h) do { _Pragma("unroll") for (int m = 0; m < 4; ++m) _Pragma("unroll") for (int k = 0; k < 2; ++k) dst[m][k] = *(const PG8_LAS bf16x8*)(lds + PG8_SA(b, h) + aoff + m * 2048 + k * 1024); } while (0)
#define PG8_LDB(dst, b, h) do { _Pragma("unroll") for (int n = 0; n < 2; ++n) _Pragma("unroll") for (int k = 0; k < 2; ++k) dst[n][k] = *(const PG8_LAS bf16x8*)(lds + PG8_SB(b, h) + boff + n * 2048 + k * 1024); } while (0)
#define PG8_MMA(ai, bj, At, Bt) do { __builtin_amdgcn_s_setprio(1); _Pragma("unroll") for (int m = 0; m < 4; ++m) _Pragma("unroll") for (int n = 0; n < 2; ++n) _Pragma("unroll") for (int k = 0; k < 2; ++k) \
        acc[ai][bj][m][n] = __builtin_amdgcn_mfma_f32_16x16x32_bf16(Bt[n][k], At[m][k], acc[ai][bj][m][n], 0, 0, 0); __builtin_amdgcn_s_setprio(0); } while (0)
#define PG8_WAIT_V(n) asm volatile("s_waitcnt vmcnt(" #n ")" ::: "memory")
#define PG8_WAIT_L(n) asm volatile("s_waitcnt lgkmcnt(" #n ")" ::: "memory")
#define PG8_BAR __builtin_amdgcn_s_barrier()
#define PG8_SCHED __builtin_amdgcn_sched_barrier(0)
    Unit cur, nxt; int ui = 0;
    if (!S.next(0, cur)) return;
    f32x4 acc[2][2][4][2];
#pragma unroll
    for (int a = 0; a < 2; ++a)
#pragma unroll
        for (int b = 0; b < 2; ++b)
#pragma unroll
            for (int m = 0; m < 4; ++m)
#pragma unroll
                for (int n = 0; n < 2; ++n) acc[a][b][m][n] = (f32x4){0.f, 0.f, 0.f, 0.f};
    bf16x8 At[4][2], B0[2][2], B1[2][2];
    const char* cA = (const char*)g.A + (size_t)cur.pm * tstep; const char* cB = (const char*)g.Bt + (size_t)cur.pn * tstep;
    S.a_ready(cur);
    if constexpr (SP2) {
        PG8_STAGE(PG8_SB(0, 0), cB, voffB); PG8_STAGE(PG8_SB(0, 1), cB + hstep, voffB); PG8_STAGE(PG8_SA(0, 0), cA, voffA); PG8_STAGE(PG8_SA(0, 1), cA + hstep, voffA);
        if (wr == 1) PG8_BAR;
        PG8_WAIT_V(2); PG8_BAR;
        PG8_STAGE(PG8_SB(1, 0), cB + kstep, voffB); PG8_STAGE(PG8_SA(1, 0), cA + kstep, voffA); PG8_STAGE(PG8_SB(1, 1), cB + hstep + kstep, voffB);
        PG8_WAIT_V(6); PG8_BAR;
    } else {
        PG8_STAGE(PG8_SB(0, 0), cB, voffB); PG8_STAGE(PG8_SA(0, 0), cA, voffA); PG8_STAGE(PG8_SB(0, 1), cB + hstep, voffB); PG8_STAGE(PG8_SA(0, 1), cA + hstep, voffA);
        if (wr == 1) PG8_BAR;
        PG8_WAIT_V(4); PG8_BAR;
        PG8_STAGE(PG8_SB(1, 0), cB + kstep, voffB); PG8_STAGE(PG8_SA(1, 0), cA + kstep, voffA); PG8_STAGE(PG8_SB(1, 1), cB + hstep + kstep, voffB);
        PG8_WAIT_V(6); PG8_BAR;
    }
    for (;;) {
        const bool has_next = S.next(ui + 1, nxt);
        const char* nA = has_next ? (const char*)g.A + (size_t)nxt.pm * tstep : cA; const char* nB = has_next ? (const char*)g.Bt + (size_t)nxt.pn * tstep : cB;
        for (int t = 0; t < nt; t += 2) {
            const bool last = (t == nt - 2);
            const char* a1 = cA + (size_t)(t + 1) * kstep;
            const char* a2 = last ? nA : cA + (size_t)(t + 2) * kstep; const char* b2 = last ? nB : cB + (size_t)(t + 2) * kstep;
            const char* a3 = a2 + kstep; const char* b3 = b2 + kstep;
            if (last && has_next) S.a_ready(nxt);
            if constexpr (SP2) {
            PG8_LDB(B0, 0, 0); PG8_LDB(B1, 0, 1); PG8_SCHED; PG8_LDA(At, 0, 0); PG8_STAGE(PG8_SA(1, 1), a1 + hstep, voffA);
            PG8_WAIT_V(8); PG8_WAIT_L(0); PG8_BAR; PG8_MMA(0, 0, At, B0); PG8_MMA(0, 1, At, B1); PG8_BAR; PG8_SCHED;
            PG8_LDA(At, 0, 1); PG8_STAGE(PG8_SB(0, 0), b2, voffB); PG8_STAGE(PG8_SB(0, 1), b2 + hstep, voffB); PG8_STAGE(PG8_SA(0, 0), a2, voffA);
            PG8_WAIT_V(8); PG8_WAIT_L(0); PG8_BAR; PG8_MMA(1, 0, At, B0); PG8_MMA(1, 1, At, B1); PG8_BAR; PG8_SCHED;
            PG8_LDB(B0, 1, 0); PG8_LDB(B1, 1, 1); PG8_SCHED; PG8_LDA(At, 1, 0); PG8_STAGE(PG8_SA(0, 1), a2 + hstep, voffA);
            PG8_WAIT_V(8); PG8_WAIT_L(0); PG8_BAR; PG8_MMA(0, 0, At, B0); PG8_MMA(0, 1, At, B1); PG8_BAR; PG8_SCHED;
            PG8_LDA(At, 1, 1); PG8_STAGE(PG8_SB(1, 0), b3, voffB); PG8_STAGE(PG8_SB(1, 1), b3 + hstep, voffB); PG8_STAGE(PG8_SA(1, 0), a3, voffA);
            PG8_WAIT_V(8); PG8_WAIT_L(0); PG8_BAR; PG8_MMA(1, 0, At, B0); PG8_MMA(1, 1, At, B1); PG8_BAR; PG8_SCHED;
            } else {
            PG8_LDB(B0, 0, 0); PG8_SCHED; PG8_LDA(At, 0, 0); PG8_STAGE(PG8_SA(1, 1), a1 + hstep, voffA);
            PG8_WAIT_L(8); PG8_BAR; PG8_WAIT_L(0); PG8_MMA(0, 0, At, B0); PG8_BAR; PG8_SCHED;
            PG8_LDB(B1, 0, 1); PG8_STAGE(PG8_SB(0, 0), b2, voffB);
            PG8_BAR; PG8_WAIT_L(0); PG8_MMA(0, 1, At, B1); PG8_BAR;
            PG8_LDA(At, 0, 1); PG8_STAGE(PG8_SA(0, 0), a2, voffA);
            PG8_BAR; PG8_WAIT_L(0); PG8_MMA(1, 0, At, B0); PG8_BAR; PG8_SCHED;
            PG8_STAGE(PG8_SB(0, 1), b2 + hstep, voffB);
            PG8_WAIT_V(6); PG8_BAR; PG8_MMA(1, 1, At, B1); PG8_BAR;
            PG8_LDB(B0, 1, 0); PG8_SCHED; PG8_LDA(At, 1, 0); PG8_STAGE(PG8_SA(0, 1), a2 + hstep, voffA);
            PG8_WAIT_L(8); PG8_BAR; PG8_WAIT_L(0); PG8_MMA(0, 0, At, B0); PG8_BAR; PG8_SCHED;
            PG8_LDB(B1, 1, 1); PG8_STAGE(PG8_SB(1, 0), b3, voffB);
            PG8_BAR; PG8_WAIT_L(0); PG8_MMA(0, 1, At, B1); PG8_BAR;
            PG8_LDA(At, 1, 1); PG8_STAGE(PG8_SA(1, 0), a3, voffA);
            PG8_BAR; PG8_WAIT_L(0); PG8_MMA(1, 0, At, B0); PG8_BAR; PG8_SCHED;
            PG8_STAGE(PG8_SB(1, 1), b3 + hstep, voffB);
            PG8_WAIT_V(6); PG8_BAR; PG8_MMA(1, 1, At, B1); PG8_BAR;
            }
        }
        if constexpr (ALIGN_EPI) { if (wr == 0) PG8_BAR; }
        if constexpr (!Epi::AFTER_DRAIN) { E(acc, cur, wr, wc, fr, fq); S.done(cur); }
        if (!has_next) break;
#pragma unroll
        for (int a = 0; a < 2; ++a)
#pragma unroll
            for (int b = 0; b < 2; ++b)
#pragma unroll
                for (int m = 0; m < 4; ++m)
#pragma unroll
                    for (int n = 0; n < 2; ++n) acc[a][b][m][n] = (f32x4){0.f, 0.f, 0.f, 0.f};
        cur = nxt; cA = nA; cB = nB; ++ui;
        if constexpr (ALIGN_EPI) { if (wr == 1) PG8_BAR; }
    }
    PG8_WAIT_V(0);
    if constexpr (!ALIGN_EPI) { if (wr == 0) PG8_BAR; }
    PG8_BAR;
    if constexpr (Epi::AFTER_DRAIN) { E.fused(acc, cur, wr, wc, fr, fq, lds, wid, lane); S.done(cur); }
#undef PG8_SA
#undef PG8_SB
#undef PG8_STAGE
#undef PG8_LDA
#undef PG8_LDB
#undef PG8_MMA
#undef PG8_WAIT_V
#undef PG8_WAIT_L
#undef PG8_BAR
#undef PG8_SCHED
}
}

namespace att {
using pg8::bf16_t; using pg8::bf16x8; using pg8::u32x4; using pg8::f32x4;
typedef float f32x16 __attribute__((ext_vector_type(16)));
typedef short s16x4 __attribute__((ext_vector_type(4)));
typedef short v4i16_t __attribute__((ext_vector_type(4)));
typedef unsigned u32x2 __attribute__((ext_vector_type(2)));
#define LAS __attribute__((address_space(3)))
typedef LAS char* lptr; typedef const LAS char* lcptr;
constexpr float L2E = 1.4426950408889634f;
constexpr float NEG_INIT = -1e30f;
constexpr int SEQ = 8192;
#define MFMA32(a, b, c) __builtin_amdgcn_mfma_f32_32x32x16_bf16((a), (b), (c), 0, 0, 0)
DI int crow(int r, int hi) { return (r & 3) + 8 * (r >> 2) + 4 * hi; }
DI s16x4 vtr(lcptr p) { return __builtin_bit_cast(s16x4, __builtin_amdgcn_ds_read_tr16_b64_v4i16((LAS v4i16_t*)p)); }
DI float xhalf(float v) { return __shfl_xor(v, 32); }
DI void stage_load(const bf16_t* Kt, const bf16_t* Vt, int wid, int lane, u32x4& kr, u32x4& vr, bool needV) {
    kr = *(const u32x4*)(Kt + lane * 64 + wid * 8);
    if (needV) vr = *(const u32x4*)(Vt + (16 * (wid & 3) + (lane >> 2)) * 64 + (wid >> 2) * 32 + (lane & 3) * 8);
}
DI void stage_write(lptr slot, int wid, int lane, const u32x4& kr, const u32x4& vr, bool needV) {
    *(LAS u32x4*)(slot + wid * 1024 + lane * 16) = kr;
    if (needV) *(LAS u32x4*)(slot + 8192 + wid * 1024 + lane * 16) = vr;
}
DI void qk_tile(f32x16& p0, f32x16& p1, lcptr Ks, const bf16x8 (&qr)[4], int r32, int hi) {
    lcptr kb = Ks + hi * 1024 + r32 * 16;
    f32x16 z;
#pragma unroll
    for (int i = 0; i < 16; ++i) z[i] = 0.f;
    p0 = z; p1 = z;
#pragma unroll
    for (int d0 = 0; d0 < 4; ++d0) {
        const bf16x8 b0 = *(const LAS bf16x8*)(kb + d0 * 2048), b1 = *(const LAS bf16x8*)(kb + d0 * 2048 + 512);
        p0 = MFMA32(b0, qr[d0], p0); p1 = MFMA32(b1, qr[d0], p1);
    }
}
DI bf16x8 pack8(const f32x16& p, int base) {
    u32x4 w; w.x = pg8::cvtpk(p[base], p[base + 1]); w.y = pg8::cvtpk(p[base + 2], p[base + 3]); w.z = pg8::cvtpk(p[base + 4], p[base + 5]); w.w = pg8::cvtpk(p[base + 6], p[base + 7]);
    return __builtin_bit_cast(bf16x8, w);
}
DI void pv_tile(f32x16 (&o)[2], lcptr Vs, const f32x16& p0, const f32x16& p1, int lane, int hi) {
    lcptr vb = Vs + ((lane >> 4) & 1) * 32 + (lane & 3) * 8 + (4 * hi + ((lane & 15) >> 2)) * 64;
    bf16x8 pf[4]; pf[0] = pack8(p0, 0); pf[1] = pack8(p0, 8); pf[2] = pack8(p1, 0); pf[3] = pack8(p1, 8);
#pragma unroll
    for (int dh = 0; dh < 2; ++dh)
#pragma unroll
        for (int ks = 0; ks < 4; ++ks) {
            const s16x4 lo = vtr(vb + dh * 4096 + ks * 1024), hh = vtr(vb + dh * 4096 + ks * 1024 + 512);
            const bf16x8 vf = (bf16x8){lo[0], lo[1], lo[2], lo[3], hh[0], hh[1], hh[2], hh[3]};
            o[dh] = MFMA32(vf, pf[ks], o[dh]);
        }
}
DI float mask_scale(f32x16& p0, f32x16& p1, int klo, int khi, int hi) {
    const bool full = (klo <= 0) && (khi >= 63), none = (khi < klo) || (khi < 0) || (klo > 63);
    float mx;
    if (__all(full || none)) {
        const float bias = full ? 0.f : -INFINITY;
        float a = fmaxf(p0[0], p1[0]);
#pragma unroll
        for (int r = 1; r < 16; ++r) a = fmaxf(a, fmaxf(p0[r], p1[r]));
#pragma unroll
        for (int r = 0; r < 16; ++r) { p0[r] = p0[r] * L2E + bias; p1[r] = p1[r] * L2E + bias; }
        mx = a * L2E + bias;
    } else {
        const int lo2 = klo - 4 * hi, hi2 = khi - 4 * hi;
        float a = -INFINITY;
#pragma unroll
        for (int r = 0; r < 16; ++r) { const int kc = (r & 3) + 8 * (r >> 2);
            p0[r] = (kc >= lo2 && kc <= hi2) ? p0[r] * L2E : -INFINITY; p1[r] = (kc + 32 >= lo2 && kc + 32 <= hi2) ? p1[r] * L2E : -INFINITY; a = fmaxf(a, fmaxf(p0[r], p1[r])); }
        mx = a;
    }
    return fmaxf(mx, xhalf(mx));
}
DI void tile_online(lcptr slot, const bf16x8 (&qr)[4], int klo, int khi, float& m, float& l, f32x16 (&o)[2], int lane, int r32, int hi) {
    { const bool none = (khi < klo) || (khi < 0) || (klo > 63); if (__all(none)) return; }
    f32x16 p0, p1; qk_tile(p0, p1, slot, qr, r32, hi);
    const float mt = mask_scale(p0, p1, klo, khi, hi);
    const float mn = fmaxf(m, mt), alpha = __builtin_amdgcn_exp2f(m - mn); m = mn;
    float s = 0.f;
#pragma unroll
    for (int r = 0; r < 16; ++r) { p0[r] = __builtin_amdgcn_exp2f(p0[r] - mn); p1[r] = __builtin_amdgcn_exp2f(p1[r] - mn); s += p0[r] + p1[r]; }
    l = l * alpha + s;
#pragma unroll
    for (int r = 0; r < 16; ++r) { o[0][r] *= alpha; o[1][r] *= alpha; }
    pv_tile(o, slot + 8192, p0, p1, lane, hi);
}
constexpr float THR = 4.0f;
DI float max3f(float a, float b, float c) { return __builtin_fmaxf(__builtin_fmaxf(a, b), c); }
DI void tile_online2(lcptr slot, const bf16x8 (&qr)[4], int klo, int khi, float& mneg, bool& has, float& l, f32x16 (&o)[2], int lane, int r32, int hi) {
    const bool full = (klo <= 0) && (khi >= 63), none = (khi < klo) || (khi < 0) || (klo > 63);
    if (__all(none)) return;
    f32x16 p0, p1;
    { const float cinit = none ? -INFINITY : mneg;
#pragma unroll
      for (int r = 0; r < 16; ++r) { p0[r] = cinit; p1[r] = cinit; }
      lcptr kb = slot + hi * 1024 + r32 * 16;
#pragma unroll
      for (int d0 = 0; d0 < 4; ++d0) {
          const bf16x8 b0 = *(const LAS bf16x8*)(kb + d0 * 2048), b1 = *(const LAS bf16x8*)(kb + d0 * 2048 + 512);
          p0 = MFMA32(b0, qr[d0], p0); p1 = MFMA32(b1, qr[d0], p1);
      } }
    if (!__all(full || none)) {
        const int lo2 = klo - 4 * hi, hi2 = khi - 4 * hi;
#pragma unroll
        for (int r = 0; r < 16; ++r) { const int kc = (r & 3) + 8 * (r >> 2);
            p0[r] = (kc >= lo2 && kc <= hi2) ? p0[r] : -INFINITY; p1[r] = (kc + 32 >= lo2 && kc + 32 <= hi2) ? p1[r] : -INFINITY; }
    }
    float rm;
    { float a = max3f(p0[0], p0[1], p1[0]), b = max3f(p0[2], p0[3], p1[1]); a = max3f(a, p1[2], p1[3]);
#pragma unroll
      for (int r = 4; r < 16; r += 4) { a = max3f(a, p0[r], p0[r + 1]); b = max3f(b, p0[r + 2], p0[r + 3]); a = max3f(a, p1[r], p1[r + 1]); b = max3f(b, p1[r + 2], p1[r + 3]); }
      rm = fmaxf(a, b); rm = fmaxf(rm, xhalf(rm)); }
    const bool trig = has ? (rm > THR) : (rm > -INFINITY);
    if (__any(trig)) {
        const float dl = trig ? rm : 0.f;
        const float f = has ? __builtin_amdgcn_exp2f(-dl) : 1.0f;
        mneg -= dl; has = has || trig;
#pragma unroll
        for (int r = 0; r < 16; ++r) { p0[r] -= dl; p1[r] -= dl; }
        l *= f;
#pragma unroll
        for (int r = 0; r < 16; ++r) { o[0][r] *= f; o[1][r] *= f; }
    }
    float s0 = 0.f, s1 = 0.f;
#pragma unroll
    for (int r = 0; r < 16; ++r) { p0[r] = __builtin_amdgcn_exp2f(p0[r]); p1[r] = __builtin_amdgcn_exp2f(p1[r]); s0 += p0[r]; s1 += p1[r]; }
    l += s0 + s1;
    pv_tile(o, slot + 8192, p0, p1, lane, hi);
}
DI void tile_stats(lcptr slot, const bf16x8 (&qr)[4], int klo, int khi, float& m, float& l, int r32, int hi) {
    f32x16 p0, p1; qk_tile(p0, p1, slot, qr, r32, hi);
    const float mt = mask_scale(p0, p1, klo, khi, hi);
    const float mn = fmaxf(m, mt), alpha = __builtin_amdgcn_exp2f(m - mn); m = mn;
    float s = 0.f;
#pragma unroll
    for (int r = 0; r < 16; ++r) s += __builtin_amdgcn_exp2f(p0[r] - mn) + __builtin_amdgcn_exp2f(p1[r] - mn);
    l = l * alpha + s;
}
DI void tile_final(lcptr slot, const bf16x8 (&qr)[4], int klo, int khi, float m, float inv, f32x16 (&o)[2], float& carry, LAS float* imp_row  , bool writer, int lane, int r32, int hi) {
    f32x16 p0, p1; qk_tile(p0, p1, slot, qr, r32, hi);
    (void)mask_scale(p0, p1, klo, khi, hi);
#pragma unroll
    for (int r = 0; r < 16; ++r) { p0[r] = __builtin_amdgcn_exp2f(p0[r] - m) * inv; p1[r] = __builtin_amdgcn_exp2f(p1[r] - m) * inv; }
    float y3[8];
#pragma unroll
    for (int x = 0; x < 4; ++x) { y3[x] = xhalf(p0[4 * x + 3]); y3[4 + x] = xhalf(p1[4 * x + 3]); }
#pragma unroll
    for (int x = 0; x < 8; ++x) {
        const float bs = (x < 4) ? (p0[4 * x] + p0[4 * x + 1]) + (p0[4 * x + 2] + p0[4 * x + 3]) : (p1[4 * (x - 4)] + p1[4 * (x - 4) + 1]) + (p1[4 * (x - 4) + 2] + p1[4 * (x - 4) + 3]);
        const float prev = (x == 0) ? carry : y3[x == 0 ? 0 : x - 1];
        float v = bs + (hi ? y3[x] : prev);
        v += __shfl_xor(v, 1); v += __shfl_xor(v, 2);
        if (writer) imp_row[2 * x + hi] = v;
    }
    carry = y3[7];
    pv_tile(o, slot + 8192, p0, p1, lane, hi);
}
struct AP {
    unsigned char* ws;
#define AP_PTR(name, T_, off) DI T_* name() const { return (T_*)(ws + (off)); }
    AP_PTR(QN, const bf16_t, 80ull << 20) AP_PTR(QR, const bf16_t, 112ull << 20) AP_PTR(KCC, const bf16_t, (2ull << 20) + 256 * 1024) AP_PTR(VCC, const bf16_t, (2ull << 20) + 768 * 1024)
    AP_PTR(KS, const bf16_t, 160ull << 20) AP_PTR(VS, const bf16_t, 168ull << 20) AP_PTR(KW, const bf16_t, 176ull << 20) AP_PTR(VW, const bf16_t, 184ull << 20)
    AP_PTR(ZS, const bf16_t, 192ull << 20) AP_PTR(MQ, const bf16_t, 256ull << 20) AP_PTR(MK, const bf16_t, 288ull << 20) AP_PTR(MV, const bf16_t, 320ull << 20)
    AP_PTR(GT, const float, 352ull << 20) AP_PTR(KM, const float, 2ull << 20) AP_PTR(Y, bf16_t, 16ull << 20)
#undef AP_PTR
};
#define TILE_LOOP(NT, KPTR_EXPR, VPTR_EXPR, NEEDV, BOUNDS_STMT, COMPUTE_STMT) \
  { u32x4 kr_ = {0u, 0u, 0u, 0u}, vr_ = {0u, 0u, 0u, 0u}; \
    { const int i = 0; (void)i; stage_load(KPTR_EXPR, VPTR_EXPR, wid, lane, kr_, vr_, NEEDV); } \
    stage_write(lds, wid, lane, kr_, vr_, NEEDV); __syncthreads(); \
    const int nt_ = (NT); \
    for (int i_ = 0; i_ < nt_; ++i_) { \
      const bool more_ = i_ + 1 < nt_; \
      if (more_) { const int i = i_ + 1; (void)i; stage_load(KPTR_EXPR, VPTR_EXPR, wid, lane, kr_, vr_, NEEDV); } \
      { const int i = i_; (void)i; lcptr slot = lds + (i_ & 1) * 16384; int klo, khi; BOUNDS_STMT; COMPUTE_STMT; } \
      if (more_) stage_write(lds + ((i_ + 1) & 1) * 16384, wid, lane, kr_, vr_, NEEDV); \
      __syncthreads(); } }
DI void zero2(f32x16 (&o)[2]) {
#pragma unroll
    for (int r = 0; r < 16; ++r) { o[0][r] = 0.f; o[1][r] = 0.f; }
}
DI void load_q(bf16x8 (&qr)[4], const bf16_t* qrow, int hi) {
#pragma unroll
    for (int d0 = 0; d0 < 4; ++d0) qr[d0] = *(const bf16x8*)(qrow + 16 * d0 + 8 * hi);
}
DI float bf_lo(unsigned w) { return __uint_as_float(w << 16); }
DI float bf_hi(unsigned w) { return __uint_as_float(w & 0xffff0000u); }
DI void write_y(const f32x16 (&o)[2], float scale, const bf16_t* zrow, bf16_t* yrow, int hi) {
#pragma unroll
    for (int dh = 0; dh < 2; ++dh)
#pragma unroll
        for (int gq = 0; gq < 4; ++gq) {
            const int d = 32 * dh + 8 * gq + 4 * hi;
            const u32x2 z = *(const u32x2*)(zrow + d);
            u32x2 w; w.x = pg8::cvtpk(o[dh][4 * gq] * scale * bf_lo(z.x), o[dh][4 * gq + 1] * scale * bf_hi(z.x)); w.y = pg8::cvtpk(o[dh][4 * gq + 2] * scale * bf_lo(z.y), o[dh][4 * gq + 3] * scale * bf_hi(z.y));
            *(u32x2*)(yrow + d) = w;
        }
}
DI void nsa_item(const AP& P, lptr lds, int b, int g, int c, int wid, int lane) {
    const int r32 = lane & 31, hi = lane >> 5, qi = r32 >> 2, hh = r32 & 3, H = 4 * g + hh;
    const int tq = 64 * c + 8 * wid + qi;
    const size_t qoff = ((size_t)(b * 8 + H) * SEQ + tq) * 64;
    const size_t row = (size_t)b * SEQ + tq;
    bf16x8 qr[4]; load_q(qr, P.QN() + qoff, hi);
    const float* gp = P.GT() + row * 32 + H * 3; const float g0 = gp[0], g1 = gp[1], g2 = gp[2];
    f32x16 o[2];
    LAS float* otl = (LAS float*)(lds + 69632) + (wid * 64 + lane);
    const int ntok = (4 * c + 3) < 511 ? (4 * c + 3) : 511, ntc = (ntok + 63) >> 6;
    const bf16_t* kcc = P.KCC() + (size_t)(b * 2 + g) * 512 * 64; const bf16_t* vcc = P.VCC() + (size_t)(b * 2 + g) * 512 * 64;
    int khi_abs = (tq - 31) >> 4; khi_abs = khi_abs < 510 ? khi_abs : 510;
    float m = NEG_INIT, l = 0.f;
    TILE_LOOP(ntc, kcc + i * 4096, vcc + i * 4096, false, { klo = -64 * i; khi = khi_abs - 64 * i; }, tile_stats(slot, qr, klo, khi, m, l, r32, hi));
    l += xhalf(l);
    { const float inv = l > 0.f ? 1.0f / l : 0.f; float carry = 0.f; zero2(o);
      LAS float* imp = (LAS float*)(lds + 32768) + (8 * wid + qi) * 128;
      TILE_LOOP(ntc, kcc + i * 4096, vcc + i * 4096, true, { klo = -64 * i; khi = khi_abs - 64 * i; }, tile_final(slot, qr, klo, khi, m, inv, o, carry, imp + 16 * i, hh == 0, lane, r32, hi));
#pragma unroll
      for (int r = 0; r < 16; ++r) { otl[r * 512] = g0 * o[0][r]; otl[(16 + r) * 512] = g0 * o[1][r]; } }
    LAS unsigned* selb = (LAS unsigned*)(lds + 65536);
    for (int q2 = 0; q2 < 8; ++q2) {
        unsigned long long s0, s1;
        if (c <= 15) { s0 = (2ull << c) - 1ull; s1 = 0ull; }
        else {
            const LAS float* ir = (const LAS float*)(lds + 32768) + (8 * wid + q2) * 128;
            const float v0 = ir[lane], v1 = ir[64 + lane];
            const int nc2 = c - 2;
            const unsigned k0 = (lane >= 1 && lane <= nc2) ? __float_as_uint(v0) + 1u : 0u, k1 = (lane + 64 <= nc2) ? __float_as_uint(v1) + 1u : 0u;
            unsigned lo = 1u, hb = 0x7f800002u; unsigned long long m0 = 0ull, m1 = 0ull; bool exact = false;
            while (hb - lo > 1u) {
                const unsigned mid = lo + ((hb - lo) >> 1);
                m0 = __ballot(k0 >= mid); m1 = __ballot(k1 >= mid);
                const int cnt = __popcll(m0) + __popcll(m1);
                if (cnt == 13) { exact = true; break; }
                if (cnt > 13) lo = mid; else hb = mid;
            }
            if (!exact) {
                const unsigned long long gg0 = __ballot(k0 > lo), gg1 = __ballot(k1 > lo), e0 = __ballot(k0 == lo), e1 = __ballot(k1 == lo);
                const int need = 13 - __popcll(gg0) - __popcll(gg1);
                const unsigned long long lt = (1ull << lane) - 1ull;
                const int r0 = __popcll(e0 & lt), r1 = __popcll(e0) + __popcll(e1 & lt);
                m0 = gg0 | __ballot(k0 == lo && r0 < need); m1 = gg1 | __ballot(k1 == lo && r1 < need);
            }
            s0 = m0 | 1ull; s1 = m1;
            if (c - 1 < 64) s0 |= 1ull << (c - 1); else s1 |= 1ull << (c - 65);
            if (c < 64) s0 |= 1ull << c; else s1 |= 1ull << (c - 64);
        }
        if (lane == 0) { LAS unsigned* sp = selb + (8 * wid + q2) * 4; sp[0] = (unsigned)s0; sp[1] = (unsigned)(s0 >> 32); sp[2] = (unsigned)s1; sp[3] = (unsigned)(s1 >> 32); }
    }
    const unsigned sb0 = selb[(8 * wid + qi) * 4 + 0], sb1 = selb[(8 * wid + qi) * 4 + 1], sb2 = selb[(8 * wid + qi) * 4 + 2], sb3 = selb[(8 * wid + qi) * 4 + 3];
    load_q(qr, P.QR() + qoff, hi);
    const bf16_t* ks = P.KS() + (size_t)(b * 2 + g) * SEQ * 64; const bf16_t* vs = P.VS() + (size_t)(b * 2 + g) * SEQ * 64;
    float mneg = 0.f; bool has = false; l = 0.f; zero2(o);
    TILE_LOOP(c + 1, ks + (size_t)i * 4096, vs + (size_t)i * 4096, true,
              { klo = 0; const unsigned w = i < 32 ? sb0 : i < 64 ? sb1 : i < 96 ? sb2 : sb3; khi = (i == c) ? (tq - 64 * c) : (((w >> (i & 31)) & 1u) ? 63 : -1); },
              tile_online2(slot, qr, klo, khi, mneg, has, l, o, lane, r32, hi));
    l += xhalf(l);
    { const float f = l > 0.f ? g1 / l : 0.f;
#pragma unroll
      for (int r = 0; r < 16; ++r) { otl[r * 512] += f * o[0][r]; otl[(16 + r) * 512] += f * o[1][r]; } }
    const bf16_t* kw = P.KW() + (size_t)(b * 2 + g) * SEQ * 64; const bf16_t* vw = P.VW() + (size_t)(b * 2 + g) * SEQ * 64;
    const int j0 = c > 8 ? c - 8 : 0;
    mneg = 0.f; has = false; l = 0.f; zero2(o);
    TILE_LOOP(c - j0 + 1, kw + (size_t)(j0 + i) * 4096, vw + (size_t)(j0 + i) * 4096, true,
              { const int base = 64 * (j0 + i); klo = tq - 511 - base; khi = tq - base; },
              tile_online2(slot, qr, klo, khi, mneg, has, l, o, lane, r32, hi));
    l += xhalf(l);
    { const float f = l > 0.f ? g2 / l : 0.f;
#pragma unroll
      for (int r = 0; r < 16; ++r) { o[0][r] = otl[r * 512] + f * o[0][r]; o[1][r] = otl[(16 + r) * 512] + f * o[1][r]; } }
    write_y(o, 1.0f, P.ZS() + row * 1024 + H * 64, P.Y() + row * 1024 + H * 64, hi);
}
DI void moba_item(const AP& P, lptr lds, int b, int h, int own, int wid, int lane, int tid) {
    const int r32 = lane & 31, hi = lane >> 5;
    const int tq = 256 * own + 32 * wid + r32;
    const size_t hb = (size_t)(b * 8 + h) * SEQ * 64;
    const size_t row = (size_t)b * SEQ + tq;
    bf16x8 qr[4]; load_q(qr, P.MQ() + hb + (size_t)tq * 64, hi);
    unsigned bits = 0u;
    if (own <= 3) bits = (1u << own) - 1u;
    else {
        { const int j = tid >> 4, d4 = (tid & 15) * 4;
          const f32x4 km = *(const f32x4*)(P.KM() + ((size_t)(b * 8 + h) * 32 + j) * 64 + d4);
          const unsigned h01 = pg8::cvtpk(km[0], km[1]), h23 = pg8::cvtpk(km[2], km[3]);
          const unsigned l01 = pg8::cvtpk(km[0] - bf_lo(h01), km[1] - bf_hi(h01)), l23 = pg8::cvtpk(km[2] - bf_lo(h23), km[3] - bf_hi(h23));
          const int off = (d4 >> 3) * 1024 + j * 16 + (d4 & 7) * 2;
          *(LAS u32x2*)(lds + off) = (u32x2){h01, h23}; *(LAS u32x2*)(lds + 16384 + off) = (u32x2){l01, l23}; }
        __syncthreads();
        f32x16 sg;
#pragma unroll
        for (int r = 0; r < 16; ++r) sg[r] = 0.f;
        { lcptr kb = lds + hi * 1024 + r32 * 16;
#pragma unroll
          for (int d0 = 0; d0 < 4; ++d0) { const bf16x8 a = *(const LAS bf16x8*)(kb + d0 * 2048), a2 = *(const LAS bf16x8*)(kb + 16384 + d0 * 2048); sg = MFMA32(a, qr[d0], sg); sg = MFMA32(a2, qr[d0], sg); } }
#pragma unroll
        for (int r = 0; r < 16; ++r) if (crow(r, hi) >= own) sg[r] = -INFINITY;
#pragma unroll
        for (int rd = 0; rd < 3; ++rd) {
            float best = sg[0]; int bj = crow(0, hi);
#pragma unroll
            for (int r = 1; r < 16; ++r) if (sg[r] > best) { best = sg[r]; bj = crow(r, hi); }
            const float ob = xhalf(best); const int oj = __shfl_xor(bj, 32);
            if (ob > best || (ob == best && oj < bj)) { best = ob; bj = oj; }
            if (best > -INFINITY) bits |= 1u << bj;
#pragma unroll
            for (int r = 0; r < 16; ++r) if (crow(r, hi) == bj) sg[r] = -INFINITY;
        }
        __syncthreads();
    }
    const bf16_t* mk = P.MK() + hb; const bf16_t* mv = P.MV() + hb;
    float mneg = 0.f, l = 0.f; bool has = false; f32x16 o[2]; zero2(o);
    TILE_LOOP(4 * (own + 1), mk + (size_t)i * 4096, mv + (size_t)i * 4096, true,
              { const int j = i >> 2; klo = 0; khi = (j < own) ? (((bits >> j) & 1u) ? 63 : -1) : (tq - 64 * i); },
              tile_online2(slot, qr, klo, khi, mneg, has, l, o, lane, r32, hi));
    l += xhalf(l);
    write_y(o, l > 0.f ? 1.0f / l : 0.f, P.ZS() + row * 1024 + 512 + h * 64, P.Y() + row * 1024 + 512 + h * 64, hi);
}
}
using att::lptr; using att::lcptr;
using pg8::bf16_t; using pg8::bf16x8; using pg8::u32x4; using pg8::f32x4;
constexpr int NWAVES = 8, NTHREADS = 512;
constexpr int BATCH = 4, T = 8192, DM = 1024, M = BATCH * T;
constexpr int NPROJ = 4096;
constexpr float LN_EPS = 1e-5f;
constexpr size_t MiB = 1u << 20;
constexpr size_t WS_CTL = 0;
constexpr size_t WS_ROPE = 1 * MiB;
constexpr size_t WS_B1P = WS_ROPE + 512 * 1024;
constexpr size_t WS_KM = 2 * MiB;
constexpr size_t WS_KCC = WS_KM + 256 * 1024;
constexpr size_t WS_VCC = WS_KCC + 512 * 1024;
constexpr size_t WS_W2T = WS_VCC + 512 * 1024;
constexpr size_t WS_W1T = 4 * MiB;
constexpr size_t WS_WOT = 6 * MiB;
constexpr size_t WS_WT = 8 * MiB;
constexpr size_t WS_XB = 16 * MiB;
constexpr size_t WS_Y = WS_XB;
constexpr size_t WS_QN = 80 * MiB, WS_QR = 112 * MiB;
constexpr size_t WS_KC = 144 * MiB, WS_VC = 152 * MiB, WS_KS = 160 * MiB, WS_VS = 168 * MiB, WS_KW = 176 * MiB, WS_VW = 184 * MiB;
constexpr size_t WS_ZS = 192 * MiB;
constexpr size_t WS_MQ = 256 * MiB, WS_MK = 288 * MiB, WS_MV = 320 * MiB;
constexpr size_t WS_GT = 352 * MiB;
constexpr size_t WS_END = 356 * MiB;
constexpr int LDS_BYTES = 136192;
constexpr int LDS_MISC = 135168;
constexpr int CW_BAR = 1024;

static_assert(WS_QN == (80ull << 20) && WS_QR == (112ull << 20) && WS_KCC == (2ull << 20) + 256 * 1024 && WS_VCC == (2ull << 20) + 768 * 1024 && WS_KS == (160ull << 20) && WS_VS == (168ull << 20) && WS_KW == (176ull << 20) && WS_VW == (184ull << 20) && WS_ZS == (192ull << 20) && WS_MQ == (256ull << 20) && WS_MK == (288ull << 20) && WS_MV == (320ull << 20) && WS_GT == (352ull << 20) && WS_KM == (2ull << 20) && WS_Y == (16ull << 20) && WS_KC == (144ull << 20) && WS_VC == (152ull << 20) && WS_ROPE == (1ull << 20), "AP / EpiProj offsets");
struct Args { const float* in[13]; float* out; unsigned char* ws; int ph_lo, ph_hi; };

DI unsigned pk2(float lo, float hi) { return pg8::cvtpk(lo, hi); }
template <class Map> DI void transpose_item(const float* W, int ldw, Map srccol, bf16_t* WT, int K, LAS float* scr, int kb, int nb, int lane) {
    const int k0 = 64 * kb, n0 = 32 * nb; const int sc = srccol(n0 + (lane & 31));
#pragma unroll 8
    for (int i = 0; i < 32; ++i) { const int kk = 2 * i + (lane >> 5); scr[kk * 33 + (lane & 31)] = sc >= 0 ? W[(size_t)(k0 + kk) * ldw + sc] : 0.f; }
    asm volatile("s_waitcnt lgkmcnt(0)" ::: "memory");
    const int c = lane & 7;
#pragma unroll
    for (int j = 0; j < 4; ++j) { const int n = (lane >> 3) + 8 * j; const LAS float* s = scr + (8 * c) * 33 + n;
        u32x4 o; o.x = pk2(s[0 * 33], s[1 * 33]); o.y = pk2(s[2 * 33], s[3 * 33]); o.z = pk2(s[4 * 33], s[5 * 33]); o.w = pk2(s[6 * 33], s[7 * 33]);
        *(u32x4*)(WT + (size_t)(n0 + n) * K + k0 + 8 * c) = o; }
    asm volatile("s_waitcnt lgkmcnt(0)" ::: "memory");
}
struct MapIdent { DI int operator()(int n) const { return n; } };
struct MapProj { DI int operator()(int n) const { return n < 1280 ? n : n < 3840 ? n + 24 : n < 3864 ? n - 2560 : -1; } };
DI float wave_sum(float v) {
#pragma unroll
    for (int o = 1; o < 64; o <<= 1) v += __shfl_xor(v, o);
    return v;
}
DI void sincos_d(double a, double& s, double& c) {
    const double q = __builtin_rint(a * 0.63661977236758134308);
    double r = __builtin_fma(-q, 1.57079632679489655800e+00, a); r = __builtin_fma(-q, 6.12323399573676603587e-17, r);
    const double r2 = r * r;
    double ps = -1.0 / 1307674368000.0; ps = ps * r2 + 1.0 / 6227020800.0; ps = ps * r2 - 1.0 / 39916800.0; ps = ps * r2 + 1.0 / 362880.0; ps = ps * r2 - 1.0 / 5040.0; ps = ps * r2 + 1.0 / 120.0; ps = ps * r2 - 1.0 / 6.0; ps = ps * r2 * r + r;
    double pc = 1.0 / 20922789888000.0; pc = pc * r2 - 1.0 / 87178291200.0; pc = pc * r2 + 1.0 / 479001600.0; pc = pc * r2 - 1.0 / 3628800.0; pc = pc * r2 + 1.0 / 40320.0; pc = pc * r2 - 1.0 / 720.0; pc = pc * r2 + 1.0 / 24.0; pc = pc * r2 - 0.5; pc = pc * r2 + 1.0;
    const int qi = (int)((long long)q & 3);
    s = (qi == 0) ? ps : (qi == 1) ? pc : (qi == 2) ? -ps : -pc;
    c = (qi == 0) ? pc : (qi == 1) ? -ps : (qi == 2) ? -pc : ps;
}
#define XB_TMO      128
#define XB_XCNT(j)  (256  + 64 * (j))
#define XB_XSUB(j)  (1280 + 64 * (j))
#define XB_XGEN(j)  (2304 + 64 * (j))
#define XB_TOP      3328
#define XB_TOPGEN   3392
#define XCD_BAR_WORDS 3456
#define XB_SPIN_CAP (1u << 18)

__device__ __forceinline__ unsigned xb_ld(unsigned* p)              { return __hip_atomic_load(p, __ATOMIC_RELAXED, __HIP_MEMORY_SCOPE_AGENT); }
__device__ __forceinline__ unsigned xb_add(unsigned* p, unsigned v) { return __hip_atomic_fetch_add(p, v, __ATOMIC_RELAXED, __HIP_MEMORY_SCOPE_AGENT); }
__device__ __forceinline__ unsigned xb_xcc_id() { return (unsigned)__builtin_amdgcn_s_getreg((3 << 11) | 20) & 0xFu; }
#define XB_SPIN(cond, bar) do { unsigned _sp = 0; while (cond) { __builtin_amdgcn_s_sleep(1); \
    if ((++_sp & 255u) == 0u) { if (xb_ld(&(bar)[XB_TMO])) break; if (_sp > XB_SPIN_CAP) { atomicAdd(&(bar)[XB_TMO], 1u); break; } } } } while (0)

struct XcdBarrier {
    unsigned* bar; unsigned x;
    volatile LAS unsigned* st;
};

__device__ __forceinline__ XcdBarrier xcd_barrier_post(unsigned* bar, volatile LAS unsigned* st) {
    XcdBarrier b; b.bar = bar; b.x = xb_xcc_id(); b.st = st;
    if (threadIdx.x == 0) (void)xb_add(&bar[XB_XCNT(b.x)], 1u);
    return b;
}
__device__ __forceinline__ void xcd_barrier_complete(unsigned* bar, unsigned x, unsigned& nloc, unsigned& nx) {
    const unsigned G = gridDim.x * gridDim.y * gridDim.z;
    unsigned sum, cnt, mine, sp = 0u;
    for (;;) {
        sum = 0u; cnt = 0u; mine = 0u;
#pragma unroll
        for (unsigned j = 0; j < 16; ++j) { const unsigned c = xb_ld(&bar[XB_XCNT(j)]); sum += c; cnt += (c > 0u) ? 1u : 0u; mine = (j == x) ? c : mine; }
        if (sum == G) break;
        __builtin_amdgcn_s_sleep(1);
        if ((++sp & 255u) == 0u) { if (xb_ld(&bar[XB_TMO])) break; if (sp > XB_SPIN_CAP) { atomicAdd(&bar[XB_TMO], 1u); break; } }
    }
    nloc = mine > 0u ? mine : 1u; nx = cnt > 0u ? cnt : 1u;
}

__device__ __forceinline__ void xcd_barrier(const XcdBarrier& b) {
    asm volatile("s_waitcnt vmcnt(0)" ::: "memory");
    __syncthreads();
    if (threadIdx.x == 0) {
        unsigned* bar = b.bar;
        __builtin_amdgcn_s_waitcnt(0);
        unsigned nloc = b.st[0], nx = b.st[1];
        if (nloc == 0u) { xcd_barrier_complete(bar, b.x, nloc, nx); b.st[0] = nloc; b.st[1] = nx; }
        const unsigned old = xb_add(&bar[XB_XSUB(b.x)], 1u);
        const unsigned gen = old / nloc;
        if (old + 1u == (gen + 1u) * nloc) {
            __builtin_amdgcn_fence(__ATOMIC_RELEASE, "agent");
            asm volatile("s_waitcnt vmcnt(0)" ::: "memory");
            const unsigned og = xb_add(&bar[XB_TOP], 1u);
            const unsigned tg = og / nx;
            if (og + 1u == (tg + 1u) * nx) xb_add(&bar[XB_TOPGEN], 1u);
            else XB_SPIN(xb_ld(&bar[XB_TOPGEN]) == tg, bar);
            __builtin_amdgcn_fence(__ATOMIC_ACQUIRE, "agent");
            xb_add(&bar[XB_XGEN(b.x)], 1u);
            asm volatile("s_waitcnt vmcnt(0)" ::: "memory");
        } else {
            XB_SPIN(xb_ld(&bar[XB_XGEN(b.x)]) == gen, bar);
            __builtin_amdgcn_fence(__ATOMIC_ACQUIRE, "agent");
            asm volatile("s_waitcnt vmcnt(0)" ::: "memory");
        }
    }
    __syncthreads();
}

struct Frame { lptr lds; int tid, lane, wave, G, bx; };

DI void p0_prep(const Args& a, const Frame& F) {
    unsigned char* ws = a.ws;
    LAS float* scr = (LAS float*)(F.lds + F.wave * 16384);
    const int gw = F.bx * NWAVES + F.wave, NGW = F.G * NWAVES;
    if (F.bx == 0) { for (int i = F.tid; i < CW_BAR + XCD_BAR_WORDS; i += NTHREADS) ((unsigned*)(ws + WS_CTL))[i] = 0u; }
    constexpr int I0 = 16 * 128, I1 = 16 * 32, I2 = 32 * 8, I3 = 4 * 2, I4 = 128;
    constexpr int NITEMS = I0 + I1 + 2 * I2 + 2 * I3 + I4;
    for (int it = gw; it < NITEMS; it += NGW) {
        int r = it;
        if (r < I0) { transpose_item(a.in[1], 3864, MapProj(), (bf16_t*)(ws + WS_WT), 1024, scr, r / 128, r % 128, F.lane); continue; } r -= I0;
        if (r < I1) { transpose_item(a.in[10], 1024, MapIdent(), (bf16_t*)(ws + WS_WOT), 1024, scr, r / 32, r % 32, F.lane); continue; } r -= I1;
        if (r < 2 * I2) { const int kv = r / I2; r %= I2; transpose_item(a.in[kv ? 7 : 3], 256, MapIdent(), (bf16_t*)(ws + WS_W1T) + (size_t)kv * 256 * 2048, 2048, scr, r / 8, r % 8, F.lane); continue; } r -= 2 * I2;
        if (r < 2 * I3) { const int kv = r / I3; r %= I3; transpose_item(a.in[kv ? 9 : 5], 64, MapIdent(), (bf16_t*)(ws + WS_W2T) + (size_t)kv * 64 * 256, 256, scr, r / 2, r % 2, F.lane); continue; } r -= 2 * I3;
        {
            float* pp = (float*)(ws + WS_B1P) + (size_t)r * 512;
#pragma unroll
            for (int e = 0; e < 8; ++e) { const int idx = e * 64 + F.lane, kv = idx >> 8, n = idx & 255; const float* pos = a.in[kv ? 6 : 2]; const float* w1 = a.in[kv ? 7 : 3];
                float s = 0.f;
#pragma unroll
                for (int k = 0; k < 16; ++k) s += pos[16 * r + k] * w1[(size_t)(16 * r + k) * 256 + n];
                pp[idx] = s; }
        }
    }
    { const f32x4* x4 = (const f32x4*)a.in[0]; u32x4* xb = (u32x4*)(ws + WS_XB); const size_t n8 = (size_t)M * DM / 8, stride = (size_t)F.G * NTHREADS;
      for (size_t i = (size_t)F.bx * NTHREADS + F.tid; i < n8; i += stride) { const f32x4 v0 = x4[2 * i], v1 = x4[2 * i + 1]; u32x4 o; o.x = pk2(v0[0], v0[1]); o.y = pk2(v0[2], v0[3]); o.z = pk2(v1[0], v1[1]); o.w = pk2(v1[2], v1[3]); xb[i] = o; } }
    { float* rp = (float*)(ws + WS_ROPE);
      for (int i = F.bx * NTHREADS + F.tid; i < T * 8; i += F.G * NTHREADS) { const int t = i >> 3, f = i & 7;
          const float invf = f == 0 ? 1.0f : f == 1 ? 0.19392274f : f == 2 ? 0.03760603f : f == 3 ? 0.0072926646f : f == 4 ? 0.0014142136f : f == 5 ? 0.0002742482f : f == 6 ? 5.318296e-05f : 1.0313386e-05f;
          const float ang = (float)t * invf; double s, c; sincos_d((double)ang, s, c);
          rp[t * 16 + f] = (float)c; rp[t * 16 + 8 + f] = (float)s; } }
}
DI void p2_compress_item(const Args& a, const Frame& F, int item) {
    unsigned char* ws = a.ws;
    const int kv = item >> 6, bg = (item >> 3) & 7, ib = item & 7;
    const bf16_t* src = (const bf16_t*)(ws + (kv ? WS_VC : WS_KC)) + (size_t)bg * T * 64;
    const bf16_t* w1t = (const bf16_t*)(ws + WS_W1T) + (size_t)kv * 256 * 2048;
    const bf16_t* w2t = (const bf16_t*)(ws + WS_W2T) + (size_t)kv * 64 * 256;
    bf16_t* dst = (bf16_t*)(ws + (kv ? WS_VCC : WS_KCC)) + (size_t)bg * 512 * 64;
    LAS float* b1p = (LAS float*)(F.lds);
    LAS float* red = (LAS float*)(F.lds + 1024);
    LAS bf16_t* Hs = (LAS bf16_t*)(F.lds + 4096);
    const int lane = F.lane, wid = F.wave, r32 = lane & 31, hi = lane >> 5;
    { const int n = F.tid & 255, half = F.tid >> 8; const float* pp = (const float*)(ws + WS_B1P) + kv * 256 + n; float s = 0.f;
      for (int j = 0; j < 64; ++j) s += pp[(size_t)(half * 64 + j) * 512];
      red[half * 256 + n] = s; }
    __syncthreads();
    if (F.tid < 256) b1p[F.tid] = red[F.tid] + red[256 + F.tid] + a.in[kv ? 8 : 4][F.tid];
    __syncthreads();
    att::f32x16 acc0, acc1;
#pragma unroll
    for (int r = 0; r < 16; ++r) { acc0[r] = 0.f; acc1[r] = 0.f; }
    { int i0 = 64 * ib + r32, i1 = i0 + 32; i0 = i0 < 510 ? i0 : 510; i1 = i1 < 510 ? i1 : 510;
      const bf16_t* a0p = src + (size_t)i0 * 16 * 64 + 8 * hi; const bf16_t* a1p = src + (size_t)i1 * 16 * 64 + 8 * hi; const bf16_t* bp = w1t + (size_t)(32 * wid + r32) * 2048 + 8 * hi;
#pragma unroll 4
      for (int s = 0; s < 128; ++s) { const bf16x8 fa0 = *(const bf16x8*)(a0p + 16 * s), fa1 = *(const bf16x8*)(a1p + 16 * s), fb = *(const bf16x8*)(bp + 16 * s);
          acc0 = MFMA32(fa0, fb, acc0); acc1 = MFMA32(fa1, fb, acc1); } }
    { const int n = 32 * wid + r32; const float bb = b1p[n];
#pragma unroll
      for (int r = 0; r < 16; ++r) { const int i = att::crow(r, hi);
          Hs[i * 264 + n] = (bf16_t)(pg8::cvtpk(pg8::silu_f(acc0[r] + bb), 0.f) & 0xffffu); Hs[(i + 32) * 264 + n] = (bf16_t)(pg8::cvtpk(pg8::silu_f(acc1[r] + bb), 0.f) & 0xffffu); } }
    __syncthreads();
    if (wid < 4) {
        const int rt = wid >> 1, ct = wid & 1; att::f32x16 acc2;
#pragma unroll
        for (int r = 0; r < 16; ++r) acc2[r] = 0.f;
#pragma unroll
        for (int s = 0; s < 16; ++s) { const bf16x8 fa = *(const LAS bf16x8*)(Hs + (32 * rt + r32) * 264 + 16 * s + 8 * hi), fb = *(const bf16x8*)(w2t + (size_t)(32 * ct + r32) * 256 + 16 * s + 8 * hi);
            acc2 = MFMA32(fa, fb, acc2); }
#pragma unroll
        for (int r = 0; r < 16; ++r) { const int i = 64 * ib + 32 * rt + att::crow(r, hi); dst[(size_t)i * 64 + 32 * ct + r32] = (bf16_t)(pg8::cvtpk(acc2[r], 0.f) & 0xffffu); }
    }
    __syncthreads();
}
DI void p2_kmean_item(const Args& a, const Frame& F, int item) {
    const bf16_t* mk = (const bf16_t*)(a.ws + WS_MK) + (size_t)item * 256 * 64;
    const int c = F.lane & 7, rg = F.lane >> 3; float s[8];
#pragma unroll
    for (int i = 0; i < 8; ++i) s[i] = 0.f;
#pragma unroll 4
    for (int p = 0; p < 32; ++p) { const u32x4 v = *(const u32x4*)(mk + (size_t)(8 * p + rg) * 64 + 8 * c);
        s[0] += att::bf_lo(v.x); s[1] += att::bf_hi(v.x); s[2] += att::bf_lo(v.y); s[3] += att::bf_hi(v.y); s[4] += att::bf_lo(v.z); s[5] += att::bf_hi(v.z); s[6] += att::bf_lo(v.w); s[7] += att::bf_hi(v.w); }
#pragma unroll
    for (int i = 0; i < 8; ++i) { s[i] += __shfl_xor(s[i], 8); s[i] += __shfl_xor(s[i], 16); s[i] += __shfl_xor(s[i], 32); }
    if (rg == 0) { float* o = (float*)(a.ws + WS_KM) + (size_t)item * 64 + 8 * c;
        *(f32x4*)o = (f32x4){s[0], s[1], s[2], s[3]} * (1.0f / 256.0f); *(f32x4*)(o + 4) = (f32x4){s[4], s[5], s[6], s[7]} * (1.0f / 256.0f); }
}
DI void p5_ln(const Args& a, const Frame& F) {
    const int gw = F.bx * NWAVES + F.wave, NGW = F.G * NWAVES;
    const f32x4* gn = (const f32x4*)a.in[11] + F.lane; const f32x4* bs = (const f32x4*)a.in[12] + F.lane;
    for (int r = gw; r < M; r += NGW) {
        f32x4* xr = (f32x4*)(a.out + (size_t)r * DM) + F.lane; f32x4 v[4]; float s = 0.f;
#pragma unroll
        for (int j = 0; j < 4; ++j) { v[j] = xr[64 * j]; s += (v[j][0] + v[j][1]) + (v[j][2] + v[j][3]); }
        const float mean = wave_sum(s) * (1.0f / DM); float s2 = 0.f;
#pragma unroll
        for (int j = 0; j < 4; ++j) { v[j] = v[j] - mean; s2 += (v[j][0] * v[j][0] + v[j][1] * v[j][1]) + (v[j][2] * v[j][2] + v[j][3] * v[j][3]); }
        const float rstd = 1.0f / sqrtf(wave_sum(s2) * (1.0f / DM) + LN_EPS);
#pragma unroll
        for (int j = 0; j < 4; ++j) xr[64 * j] = v[j] * rstd * gn[64 * j] + bs[64 * j];
    }
}
__global__ void __launch_bounds__(NTHREADS, 2) hymba_fwd(Args args) {
    extern __shared__ __attribute__((aligned(16))) unsigned char lds_raw[];
    cg::grid_group grid = cg::this_grid();
    Frame F; F.lds = (lptr)lds_raw; F.tid = threadIdx.x; F.lane = F.tid & 63; F.wave = __builtin_amdgcn_readfirstlane(F.tid >> 6); F.G = gridDim.x; F.bx = blockIdx.x;
    unsigned char* ws = args.ws;
    const int lo = args.ph_lo, hi = args.ph_hi;
    if (F.tid < 2) ((LAS unsigned*)(F.lds + LDS_MISC))[F.tid] = 0u;
    __syncthreads();
    XcdBarrier xbar; xbar.bar = nullptr; xbar.x = 0; xbar.st = nullptr;
#define IN(k) (lo <= (k) && (k) < hi)
#define SEAM(k) do { if (IN(k) && IN((k) + 1)) { if ((k) == 0 || !USE_XCD_BARRIER) grid.sync(); else xcd_barrier(xbar); } } while (0)
#ifndef USE_XCD_BARRIER
#define USE_XCD_BARRIER 1
#endif
#ifndef REPEAT_MASK
#define REPEAT_MASK 0
#endif
#define NREP(k) (((REPEAT_MASK) >> (k)) & 1 ? 2 : 1)
    for (int rep = 0; rep < NREP(0); ++rep) { if (rep) { if (USE_XCD_BARRIER) xcd_barrier(xbar); else grid.sync(); }
#ifndef SKIP_P0
    if (IN(0)) { p0_prep(args, F); }
#endif
    }
    SEAM(0);
    if (USE_XCD_BARRIER && IN(0) && IN(1)) xbar = xcd_barrier_post((unsigned*)(ws + WS_CTL) + CW_BAR, (volatile LAS unsigned*)(F.lds + LDS_MISC));
    for (int rep = 0; rep < NREP(1); ++rep) { if (rep) { if (USE_XCD_BARRIER) xcd_barrier(xbar); else grid.sync(); }
#ifndef SKIP_P1
    if (IN(1)) {
        pg8::Gemm g{(const bf16_t*)(ws + WS_XB), (const bf16_t*)(ws + WS_WT), M, NPROJ, DM}; pg8::StaticOrder S; S.init(M, NPROJ, F.G, F.bx);
        pg8::EpiProj E{ws};
        pg8::gemm_phase<pg8::EpiProj, pg8::StaticOrder, true, true>((PG8_LAS unsigned char*)F.lds, g, S, E);
    }
#endif
    }
    SEAM(1);
    for (int rep = 0; rep < NREP(2); ++rep) { if (rep) { if (USE_XCD_BARRIER) xcd_barrier(xbar); else grid.sync(); }
#ifndef SKIP_P2
    if (IN(2)) {
        for (int it = F.bx; it < 128; it += F.G) p2_compress_item(args, F, it);
        const int gw = ((F.bx + F.G - 128 % F.G) % F.G) * NWAVES + F.wave;
        for (int it = gw; it < 1024; it += F.G * NWAVES) p2_kmean_item(args, F, it);
    }
#endif
    }
    SEAM(2);
    for (int rep = 0; rep < NREP(3); ++rep) { if (rep) { if (USE_XCD_BARRIER) xcd_barrier(xbar); else grid.sync(); }
#ifndef SKIP_P3
    if (IN(3)) {
        att::AP P{ws};
#ifdef PROBE_ZERO_Y
        { u32x4* yb = (u32x4*)(ws + WS_Y); const size_t n8 = (size_t)M * DM / 8; for (size_t i = (size_t)F.bx * NTHREADS + F.tid; i < n8; i += (size_t)F.G * NTHREADS) yb[i] = (u32x4){0u, 0u, 0u, 0u}; }
#else
        unsigned* qctr = (unsigned*)(ws + WS_CTL) + rep;
        LAS unsigned* qw = (LAS unsigned*)(F.lds + 66560);
        for (;;) {
            if (F.tid == 0) *qw = atomicAdd(qctr, 1u);
            __syncthreads();
            const unsigned n = *qw;
            __syncthreads();
            if (n >= 2048u) break;
            const unsigned k = n >> 1;
            if ((n & 1u) == 0u) { const int c = 127 - (int)(k >> 3), bg = (int)(k & 7);
#ifndef SKIP_NSA
 att::nsa_item(P, F.lds, bg >> 1, bg & 1, c, F.wave, F.lane);
#endif
 }
            else { const int own = 31 - (int)(k >> 5), bh = (int)(k & 31);
#ifndef SKIP_MOBA
 att::moba_item(P, F.lds, bh >> 3, bh & 7, own, F.wave, F.lane, F.tid);
#endif
 }
        }
#endif
    }
#endif
    }
    SEAM(3);
    for (int rep = 0; rep < NREP(4); ++rep) { if (rep) { if (USE_XCD_BARRIER) xcd_barrier(xbar); else grid.sync(); }
#ifndef SKIP_P4
    if (IN(4)) {
        pg8::Gemm g{(const bf16_t*)(ws + WS_Y), (const bf16_t*)(ws + WS_WOT), M, DM, DM}; pg8::StaticOrder S; S.init(M, DM, F.G, F.bx);
        pg8::EpiOut E{args.in[0], args.out, 1.189207115002721f};
        pg8::gemm_phase<pg8::EpiOut, pg8::StaticOrder, true, true>((PG8_LAS unsigned char*)F.lds, g, S, E);
    }
#endif
    SEAM(4);
    if (IN(5)) p5_ln(args, F);
    }
#undef IN
#undef SEAM
}
#ifndef N_LAUNCHES
#define N_LAUNCHES 1
#endif
extern "C" void kernel_launch(void* const* d_in, const int* in_sizes, int n_in, void* d_out, int out_size, void* d_ws, size_t ws_size, hipStream_t stream) {
    static int grid = 0;
    if (grid == 0) {
        if (n_in != 13 || in_sizes[0] != M * DM || out_size != M * DM || ws_size < WS_END) { fprintf(stderr, "kernel_launch: unexpected shapes (n_in %d, in0 %d, out %d, ws %zu)\n", n_in, n_in > 0 ? in_sizes[0] : -1, out_size, ws_size); grid = -1; return; }
        int dev = 0, cus = 0, per_cu = 0;
        (void)hipGetDevice(&dev); (void)hipDeviceGetAttribute(&cus, hipDeviceAttributeMultiprocessorCount, dev);
        if (hipFuncSetAttribute((const void*)hymba_fwd, hipFuncAttributeMaxDynamicSharedMemorySize, LDS_BYTES) != hipSuccess) { fprintf(stderr, "kernel_launch: hipFuncSetAttribute failed\n"); grid = -1; return; }
        if (hipOccupancyMaxActiveBlocksPerMultiprocessor(&per_cu, (const void*)hymba_fwd, NTHREADS, LDS_BYTES) != hipSuccess || per_cu < 1) { fprintf(stderr, "kernel_launch: occupancy query failed (%d)\n", per_cu); (void)hipGetLastError(); per_cu = 1; }
        grid = cus * (per_cu < 1 ? 1 : 1);
    }
    if (grid < 0) return;
    Args a{};
    for (int i = 0; i < 13; ++i) a.in[i] = (const float*)d_in[i];
    a.out = (float*)d_out; a.ws = (unsigned char*)d_ws;
#if N_LAUNCHES == 1
    a.ph_lo = 0; a.ph_hi = 6;
    void* kargs[] = {&a};
    hipError_t e = hipLaunchCooperativeKernel((const void*)hymba_fwd, dim3(grid), dim3(NTHREADS), kargs, LDS_BYTES, stream);
    if (e != hipSuccess) fprintf(stderr, "cooperative launch failed: %s (grid %d)\n", hipGetErrorString(e), grid);
#else
    for (int p = 0; p < 6; ++p) { a.ph_lo = p; a.ph_hi = p + 1; hipLaunchKernelGGL(hymba_fwd, dim3(grid), dim3(NTHREADS), LDS_BYTES, stream, a); }
#endif
}
```

```cpp
#include <hip/hip_runtime.h>
#include <hip/hip_cooperative_groups.h>
#include <cstdio>
#include <cstdint>
namespace cg = cooperative_groups;
#define DI __device__ __forceinline__
namespace pg8 {
#define PG8_LAS __attribute__((address_space(3)))
typedef unsigned short bf16_t;
typedef short bf16x8 __attribute__((ext_vector_type(8)));
typedef float f32x4 __attribute__((ext_vector_type(4)));
typedef unsigned u32x4 __attribute__((ext_vector_type(4)));
constexpr int BM = 256, BK = 64, HALF = 128, HTB = HALF * BK * 2  , STAGE_BYTES = 8 * HTB, NXCD = 8, WGM = 8;

__host__ __device__ __forceinline__ int lds_byte(int r, int c) { const int st = (r >> 4) * 2 + (c >> 5), rr = r & 15, cc = c & 31, ob = rr * 64 + cc * 2; return st * 1024 + (ob ^ (((ob >> 9) & 1) << 5)); }
__host__ __device__ __forceinline__ void stage_rc(int b, int& R, int& C) { const int st = b / 1024, sb = b % 1024, swz = sb ^ (((sb >> 9) & 1) << 5); R = (st >> 1) * 16 + swz / 64; C = (st & 1) * 32 + (swz % 64) / 2; }
__host__ __device__ __forceinline__ int perm32(int rho) { const int n = rho >> 4, i = rho & 15; return 8 * (i >> 2) + 4 * n + (i & 3); }

struct Unit { int pm, pn; };
struct Gemm { const bf16_t* A; const bf16_t* Bt; int M, N, K; };

struct StaticOrder {
    int nM, nN, nwg, G, c;
    __host__ __device__ void init(int M, int N, int G_, int c_) { nM = M / BM; nN = N / BM; nwg = nM * nN; G = G_; c = c_; }
    __host__ __device__ bool next(int i, Unit& u) const {
        const long L = (long)i * G + c; if (L >= nwg) return false;
        int wgid = (int)L; { const int q = nwg / NXCD, r = nwg % NXCD, xcd = wgid % NXCD, off = wgid / NXCD; wgid = (xcd < r ? xcd * (q + 1) : r * (q + 1) + (xcd - r) * q) + off; }
        const int nig = WGM * nN, gid = wgid / nig, fm = gid * WGM, gsz = (nM - fm) < WGM ? (nM - fm) : WGM;
        u.pm = fm + ((wgid % nig) % gsz); u.pn = (wgid % nig) / gsz; return true;
    }
    __device__ __forceinline__ void a_ready(const Unit&) const {}
    __device__ __forceinline__ void done(const Unit&) const {}
};

typedef float f32x2_t __attribute__((ext_vector_type(2))); typedef __bf16 bf16x2_t __attribute__((ext_vector_type(2)));
DI unsigned cvtpk(float lo, float hi) { f32x2_t v = {lo, hi}; bf16x2_t b = __builtin_convertvector(v, bf16x2_t); return __builtin_bit_cast(unsigned, b); }
DI float silu_f(float v) { return v / (1.0f + __expf(-v)); }
DI float sigm_f(float v) { return 1.0f / (1.0f + __expf(-v)); }
constexpr int SEQ = 8192;
struct EpiProj {
    static constexpr bool PERM = true, AFTER_DRAIN = false;
    unsigned char* ws;
    DI void store8(bf16_t* dst, const float (&v)[8]) const { u32x4 w; w.x = cvtpk(v[0], v[1]); w.y = cvtpk(v[2], v[3]); w.z = cvtpk(v[4], v[5]); w.w = cvtpk(v[6], v[7]); *(u32x4*)dst = w; }
    DI void operator()(const f32x4 (&acc)[2][2][4][2], const Unit& u, int wr, int wc, int fr, int fq) const {
        const int pn = u.pn;
        bf16_t* const QN = (bf16_t*)(ws + (80ull << 20)); bf16_t* const QR = (bf16_t*)(ws + (112ull << 20)); bf16_t* const KC = (bf16_t*)(ws + (144ull << 20)); bf16_t* const VC = (bf16_t*)(ws + (152ull << 20));
        bf16_t* const KS = (bf16_t*)(ws + (160ull << 20)); bf16_t* const VS = (bf16_t*)(ws + (168ull << 20)); bf16_t* const KW = (bf16_t*)(ws + (176ull << 20)); bf16_t* const VW = (bf16_t*)(ws + (184ull << 20));
        bf16_t* const ZS = (bf16_t*)(ws + (192ull << 20)); bf16_t* const MQ = (bf16_t*)(ws + (256ull << 20)); bf16_t* const MK = (bf16_t*)(ws + (288ull << 20)); bf16_t* const MV = (bf16_t*)(ws + (320ull << 20));
        float* const GT = (float*)(ws + (352ull << 20)); const float* const ROPE = (const float*)(ws + (1ull << 20));
#pragma unroll
        for (int ai = 0; ai < 2; ++ai)
#pragma unroll
            for (int m = 0; m < 4; ++m) {
                const int row = u.pm * BM + ai * HALF + wr * 64 + m * 16 + fr; const int b = row >> 13, t = row & (SEQ - 1);
#pragma unroll
                for (int bj = 0; bj < 2; ++bj) {
                    const int col0 = bj * HALF + wc * 32 + 8 * fq; const int hd = col0 >> 6, d0 = col0 & 63;
                    float v[8];
#pragma unroll
                    for (int i = 0; i < 4; ++i) { v[i] = acc[ai][bj][m][0][i]; v[4 + i] = acc[ai][bj][m][1][i]; }
                    int kind = 0; bf16_t* dst = nullptr; bf16_t* dst2 = nullptr; float sc = 1.0f, sc2 = 1.0f;
                    if (pn <= 1)      { kind = 1; sc = 0.125f; sc2 = 1.4426950408889634f; const size_t o = ((size_t)(b * 8 + pn * 4 + hd) * SEQ + t) * 64 + d0; dst = QR + o; dst2 = QN + o; }
                    else if (pn == 2) { const size_t o = ((size_t)(b * 2 + (hd & 1)) * SEQ + t) * 64 + d0; dst = (hd < 2 ? KC : VC) + o; }
                    else if (pn == 3) { const size_t o = ((size_t)(b * 2 + (hd & 1)) * SEQ + t) * 64 + d0; dst = (hd < 2 ? KS : VS) + o; kind = hd < 2 ? 1 : 0; }
                    else if (pn == 4) { const size_t o = ((size_t)(b * 2 + (hd & 1)) * SEQ + t) * 64 + d0; dst = (hd < 2 ? KW : VW) + o; kind = hd < 2 ? 1 : 0; }
                    else if (pn <= 6) { kind = 2; dst = ZS + (size_t)row * 1024 + (pn - 5) * 256 + col0; }
                    else if (pn <= 8) { kind = 1; sc = 0.125f * 1.4426950408889634f; dst = MQ + ((size_t)(b * 8 + (pn - 7) * 4 + hd) * SEQ + t) * 64 + d0; }
                    else if (pn <= 10) { kind = 1; dst = MK + ((size_t)(b * 8 + (pn - 9) * 4 + hd) * SEQ + t) * 64 + d0; }
                    else if (pn <= 12) { dst = MV + ((size_t)(b * 8 + (pn - 11) * 4 + hd) * SEQ + t) * 64 + d0; }
                    else if (pn <= 14) { kind = 2; dst = ZS + (size_t)row * 1024 + 512 + (pn - 13) * 256 + col0; }
                    else kind = 3;
                    if (kind == 3) {
                        if (col0 < 24) {
#pragma unroll
                            for (int i = 0; i < 8; ++i) v[i] = sigm_f(v[i]);
                            float* gp = GT + (size_t)row * 32 + col0; *(f32x4*)gp = (f32x4){v[0], v[1], v[2], v[3]}; *(f32x4*)(gp + 4) = (f32x4){v[4], v[5], v[6], v[7]};
                        }
                        continue;
                    }
                    if (kind == 2) {
#pragma unroll
                        for (int i = 0; i < 8; ++i) v[i] = silu_f(v[i]);
                        store8(dst, v); continue;
                    }
                    if (sc != 1.0f) {
#pragma unroll
                        for (int i = 0; i < 8; ++i) v[i] *= sc;
                    }
                    if (kind == 1) {
                        if (dst2) { store8(dst2, v);
#pragma unroll
                            for (int i = 0; i < 8; ++i) v[i] *= sc2; }
                        if ((wc & 1) == 0) {
                            float pr[8];
#pragma unroll
                            for (int i = 0; i < 8; ++i) pr[i] = __shfl_xor(v[i], 16);
                            if (fq < 2) {
                                const f32x4 c0 = *(const f32x4*)(ROPE + (size_t)t * 16), c1 = *(const f32x4*)(ROPE + (size_t)t * 16 + 4), s0 = *(const f32x4*)(ROPE + (size_t)t * 16 + 8), s1 = *(const f32x4*)(ROPE + (size_t)t * 16 + 12);
                                const float sg = fq == 0 ? -1.0f : 1.0f;
#pragma unroll
                                for (int i = 0; i < 4; ++i) { v[i] = v[i] * c0[i] + sg * pr[i] * s0[i]; v[4 + i] = v[4 + i] * c1[i] + sg * pr[4 + i] * s1[i]; }
                            }
                        }
                    }
                    store8(dst, v);
                }
            }
    }
};
struct EpiOut {
    static constexpr bool PERM = false, AFTER_DRAIN = false;
    const float* Xin; float* O; float alpha;
    DI void operator()(const f32x4 (&acc)[2][2][4][2], const Unit& u, int wr, int wc, int fr, int fq) const {
#pragma unroll
        for (int ai = 0; ai < 2; ++ai)
#pragma unroll
            for (int m = 0; m < 4; ++m) {
                const size_t row = (size_t)(u.pm * BM + ai * HALF + wr * 64 + m * 16 + fr);
#pragma unroll
                for (int bj = 0; bj < 2; ++bj)
#pragma unroll
                    for (int n = 0; n < 2; ++n) { const size_t off = row * 1024 + u.pn * BM + bj * HALF + wc * 32 + n * 16 + 4 * fq; const f32x4 xv = *(const f32x4*)(Xin + off); *(f32x4*)(O + off) = xv * alpha + acc[ai][bj][m][n]; }
            }
    }
};
template <class Epi, class Sched, bool ALIGN_EPI = false, bool SP2 = false>
__device__ __forceinline__ void gemm_phase(PG8_LAS unsigned char* lds, const Gemm g, const Sched& S, const Epi& E) {
    const int tid = threadIdx.x, wid = __builtin_amdgcn_readfirstlane(tid >> 6), lane = tid & 63, wr = wid >> 2, wc = wid & 3, fr = lane & 15, fq = lane >> 4;
    const int K = g.K, nt = K / BK;
    unsigned voffA[2], voffB[2];
#pragma unroll
    for (int i = 0; i < 2; ++i) { int R, C; stage_rc(tid * 16 + i * 8192, R, C); const int Rb = Epi::PERM ? ((R & ~31) + perm32(R & 31)) : R;
        voffA[i] = (unsigned)(R * K + C) * 2u; voffB[i] = (unsigned)(Rb * K + C) * 2u; }
    const size_t kstep = (size_t)(BK * 2);
    const size_t hstep = (size_t)HALF * K * 2;
    const size_t tstep = 2 * hstep;
    const unsigned ldsw = (unsigned)wid * 1024u;
    const int aoff = lds_byte(wr * 64 + fr, fq * 8), boff = lds_byte(wc * 32 + fr, fq * 8);
#define PG8_SA(b, h) (((b) * 2 + (h)) * HTB)
#define PG8_SB(b, h) ((4 + (b) * 2 + (h)) * HTB)
#define PG8_STAGE(bufoff, gbase, voff) do { _Pragma("unroll") for (int _i = 0; _i < 2; ++_i) \
        __builtin_amdgcn_global_load_lds((const unsigned*)((const char*)(gbase) + (voff)[_i]), (PG8_LAS unsigned*)(lds + (bufoff) + ldsw + _i * 8192), 16, 0, 0); } while (0)
#define PG8_LDA(dst, b, h) do { _Pragma("unroll") for (int m = 0; m < 4; ++m) _Pragma("unroll") for (int k = 0; k < 2; ++k) dst[m][k] = *(const PG8_LAS bf16x8*)(lds + PG8_SA(b, h) + aoff + m * 2048 + k * 1024); } while (0)
#define PG8_LDB(dst, b, h) do { _Pragma("unroll") for (int n = 0; n < 2; ++n) _Pragma("unroll") for (int k = 0; k < 2; ++k) dst[n][k] = *(const PG8_LAS bf16x8*)(lds + PG8_SB(b, h) + boff + n * 2048 + k * 1024); } while (0)
#define PG8_MMA(ai, bj, At, Bt) do { __builtin_amdgcn_s_setprio(1); _Pragma("unroll") for (int m = 0; m < 4; ++m) _Pragma("unroll") for (int n = 0; n < 2; ++n) _Pragma("unroll") for (int k = 0; k < 2; ++k) \
        acc[ai][bj][m][n] = __builtin_amdgcn_mfma_f32_16x16x32_bf16(Bt[n][k], At[m][k], acc[ai][bj][m][n], 0, 0, 0); __builtin_amdgcn_s_setprio(0); } while (0)
#define PG8_WAIT_V(n) asm volatile("s_waitcnt vmcnt(" #n ")" ::: "memory")
#define PG8_WAIT_L(n) asm volatile("s_waitcnt lgkmcnt(" #n ")" ::: "memory")
#define PG8_BAR __builtin_amdgcn_s_barrier()
#define PG8_SCHED __builtin_amdgcn_sched_barrier(0)
    Unit cur, nxt; int ui = 0;
    if (!S.next(0, cur)) return;
    f32x4 acc[2][2][4][2];
#pragma unroll
    for (int a = 0; a < 2; ++a)
#pragma unroll
        for (int b = 0; b < 2; ++b)
#pragma unroll
            for (int m = 0; m < 4; ++m)
#pragma unroll
                for (int n = 0; n < 2; ++n) acc[a][b][m][n] = (f32x4){0.f, 0.f, 0.f, 0.f};
    bf16x8 At[4][2], B0[2][2], B1[2][2];
    const char* cA = (const char*)g.A + (size_t)cur.pm * tstep; const char* cB = (const char*)g.Bt + (size_t)cur.pn * tstep;
    S.a_ready(cur);
    if constexpr (SP2) {
        PG8_STAGE(PG8_SB(0, 0), cB, voffB); PG8_STAGE(PG8_SB(0, 1), cB + hstep, voffB); PG8_STAGE(PG8_SA(0, 0), cA, voffA); PG8_STAGE(PG8_SA(0, 1), cA + hstep, voffA);
        if (wr == 1) PG8_BAR;
        PG8_WAIT_V(2); PG8_BAR;
        PG8_STAGE(PG8_SB(1, 0), cB + kstep, voffB); PG8_STAGE(PG8_SA(1, 0), cA + kstep, voffA); PG8_STAGE(PG8_SB(1, 1), cB + hstep + kstep, voffB);
        PG8_WAIT_V(6); PG8_BAR;
    } else {
        PG8_STAGE(PG8_SB(0, 0), cB, voffB); PG8_STAGE(PG8_SA(0, 0), cA, voffA); PG8_STAGE(PG8_SB(0, 1), cB + hstep, voffB); PG8_STAGE(PG8_SA(0, 1), cA + hstep, voffA);
        if (wr == 1) PG8_BAR;
        PG8_WAIT_V(4); PG8_BAR;
        PG8_STAGE(PG8_SB(1, 0), cB + kstep, voffB); PG8_STAGE(PG8_SA(1, 0), cA + kstep, voffA); PG8_STAGE(PG8_SB(1, 1), cB + hstep + kstep, voffB);
        PG8_WAIT_V(6); PG8_BAR;
    }
    for (;;) {
        const bool has_next = S.next(ui + 1, nxt);
        const char* nA = has_next ? (const char*)g.A + (size_t)nxt.pm * tstep : cA; const char* nB = has_next ? (const char*)g.Bt + (size_t)nxt.pn * tstep : cB;
        for (int t = 0; t < nt; t += 2) {
            const bool last = (t == nt - 2);
            const char* a1 = cA + (size_t)(t + 1) * kstep;
            const char* a2 = last ? nA : cA + (size_t)(t + 2) * kstep; const char* b2 = last ? nB : cB + (size_t)(t + 2) * kstep;
            const char* a3 = a2 + kstep; const char* b3 = b2 + kstep;
            if (last && has_next) S.a_ready(nxt);
            if constexpr (SP2) {
            PG8_LDB(B0, 0, 0); PG8_LDB(B1, 0, 1); PG8_SCHED; PG8_LDA(At, 0, 0); PG8_STAGE(PG8_SA(1, 1), a1 + hstep, voffA);
            PG8_WAIT_V(8); PG8_WAIT_L(0); PG8_BAR; PG8_MMA(0, 0, At, B0); PG8_MMA(0, 1, At, B1); PG8_BAR; PG8_SCHED;
            PG8_LDA(At, 0, 1); PG8_STAGE(PG8_SB(0, 0), b2, voffB); PG8_STAGE(PG8_SB(0, 1), b2 + hstep, voffB); PG8_STAGE(PG8_SA(0, 0), a2, voffA);
            PG8_WAIT_V(8); PG8_WAIT_L(0); PG8_BAR; PG8_MMA(1, 0, At, B0); PG8_MMA(1, 1, At, B1); PG8_BAR; PG8_SCHED;
            PG8_LDB(B0, 1, 0); PG8_LDB(B1, 1, 1); PG8_SCHED; PG8_LDA(At, 1, 0); PG8_STAGE(PG8_SA(0, 1), a2 + hstep, voffA);
            PG8_WAIT_V(8); PG8_WAIT_L(0); PG8_BAR; PG8_MMA(0, 0, At, B0); PG8_MMA(0, 1, At, B1); PG8_BAR; PG8_SCHED;
            PG8_LDA(At, 1, 1); PG8_STAGE(PG8_SB(1, 0), b3, voffB); PG8_STAGE(PG8_SB(1, 1), b3 + hstep, voffB); PG8_STAGE(PG8_SA(1, 0), a3, voffA);
            PG8_WAIT_V(8); PG8_WAIT_L(0); PG8_BAR; PG8_MMA(1, 0, At, B0); PG8_MMA(1, 1, At, B1); PG8_BAR; PG8_SCHED;
            } else {
            PG8_LDB(B0, 0, 0); PG8_SCHED; PG8_LDA(At, 0, 0); PG8_STAGE(PG8_SA(1, 1), a1 + hstep, voffA);
            PG8_WAIT_L(8); PG8_BAR; PG8_WAIT_L(0); PG8_MMA(0, 0, At, B0); PG8_BAR; PG8_SCHED;
            PG8_LDB(B1, 0, 1); PG8_STAGE(PG8_SB(0, 0), b2, voffB);
            PG8_BAR; PG8_WAIT_L(0); PG8_MMA(0, 1, At, B1); PG8_BAR;
            PG8_LDA(At, 0, 1); PG8_STAGE(PG8_SA(0, 0), a2, voffA);
            PG8_BAR; PG8_WAIT_L(0); PG8_MMA(1, 0, At, B0); PG8_BAR; PG8_SCHED;
            PG8_STAGE(PG8_SB(0, 1), b2 + hstep, voffB);
            PG8_WAIT_V(6); PG8_BAR; PG8_MMA(1, 1, At, B1); PG8_BAR;
            PG8_LDB(B0, 1, 0); PG8_SCHED; PG8_LDA(At, 1, 0); PG8_STAGE(PG8_SA(0, 1), a2 + hstep, voffA);
            PG8_WAIT_L(8); PG8_BAR; PG8_WAIT_L(0); PG8_MMA(0, 0, At, B0); PG8_BAR; PG8_SCHED;
            PG8_LDB(B1, 1, 1); PG8_STAGE(PG8_SB(1, 0), b3, voffB);
            PG8_BAR; PG8_WAIT_L(0); PG8_MMA(0, 1, At, B1); PG8_BAR;
            PG8_LDA(At, 1, 1); PG8_STAGE(PG8_SA(1, 0), a3, voffA);
            PG8_BAR; PG8_WAIT_L(0); PG8_MMA(1, 0, At, B0); PG8_BAR; PG8_SCHED;
            PG8_STAGE(PG8_SB(1, 1), b3 + hstep, voffB);
            PG8_WAIT_V(6); PG8_BAR; PG8_MMA(1, 1, At, B1); PG8_BAR;
            }
        }
        if constexpr (ALIGN_EPI) { if (wr == 0) PG8_BAR; }
        if constexpr (!Epi::AFTER_DRAIN) { E(acc, cur, wr, wc, fr, fq); S.done(cur); }
        if (!has_next) break;
#pragma unroll
        for (int a = 0; a < 2; ++a)
#pragma unroll
            for (int b = 0; b < 2; ++b)
#pragma unroll
                for (int m = 0; m < 4; ++m)
#pragma unroll
                    for (int n = 0; n < 2; ++n) acc[a][b][m][n] = (f32x4){0.f, 0.f, 0.f, 0.f};
        cur = nxt; cA = nA; cB = nB; ++ui;
        if constexpr (ALIGN_EPI) { if (wr == 1) PG8_BAR; }
    }
    PG8_WAIT_V(0);
    if constexpr (!ALIGN_EPI) { if (wr == 0) PG8_BAR; }
    PG8_BAR;
    if constexpr (Epi::AFTER_DRAIN) { E.fused(acc, cur, wr, wc, fr, fq, lds, wid, lane); S.done(cur); }
#undef PG8_SA
#undef PG8_SB
#undef PG8_STAGE
#undef PG8_LDA
#undef PG8_LDB
#undef PG8_MMA
#undef PG8_WAIT_V
#undef PG8_WAIT_L
#undef PG8_BAR
#undef PG8_SCHED
}
}

namespace att {
using pg8::bf16_t; using pg8::bf16x8; using pg8::u32x4; using pg8::f32x4;
typedef float f32x16 __attribute__((ext_vector_type(16)));
typedef short s16x4 __attribute__((ext_vector_type(4)));
typedef short v4i16_t __attribute__((ext_vector_type(4)));
typedef unsigned u32x2 __attribute__((ext_vector_type(2)));
#define LAS __attribute__((address_space(3)))
typedef LAS char* lptr; typedef const LAS char* lcptr;
constexpr float L2E = 1.4426950408889634f;
constexpr float NEG_INIT = -1e30f;
constexpr int SEQ = 8192;
#define MFMA32(a, b, c) __builtin_amdgcn_mfma_f32_32x32x16_bf16((a), (b), (c), 0, 0, 0)
DI int crow(int r, int hi) { return (r & 3) + 8 * (r >> 2) + 4 * hi; }
DI s16x4 vtr(lcptr p) { return __builtin_bit_cast(s16x4, __builtin_amdgcn_ds_read_tr16_b64_v4i16((LAS v4i16_t*)p)); }
DI float xhalf(float v) { return __shfl_xor(v, 32); }
DI void stage_load(const bf16_t* Kt, const bf16_t* Vt, int wid, int lane, u32x4& kr, u32x4& vr, bool needV) {
    kr = *(const u32x4*)(Kt + lane * 64 + wid * 8);
    if (needV) vr = *(const u32x4*)(Vt + (16 * (wid & 3) + (lane >> 2)) * 64 + (wid >> 2) * 32 + (lane & 3) * 8);
}
DI void stage_write(lptr slot, int wid, int lane, const u32x4& kr, const u32x4& vr, bool needV) {
    *(LAS u32x4*)(slot + wid * 1024 + lane * 16) = kr;
    if (needV) *(LAS u32x4*)(slot + 8192 + wid * 1024 + lane * 16) = vr;
}
DI void qk_tile(f32x16& p0, f32x16& p1, lcptr Ks, const bf16x8 (&qr)[4], int r32, int hi) {
    lcptr kb = Ks + hi * 1024 + r32 * 16;
    f32x16 z;
#pragma unroll
    for (int i = 0; i < 16; ++i) z[i] = 0.f;
    p0 = z; p1 = z;
#pragma unroll
    for (int d0 = 0; d0 < 4; ++d0) {
        const bf16x8 b0 = *(const LAS bf16x8*)(kb + d0 * 2048), b1 = *(const LAS bf16x8*)(kb + d0 * 2048 + 512);
        p0 = MFMA32(b0, qr[d0], p0); p1 = MFMA32(b1, qr[d0], p1);
    }
}
DI bf16x8 pack8(const f32x16& p, int base) {
    u32x4 w; w.x = pg8::cvtpk(p[base], p[base + 1]); w.y = pg8::cvtpk(p[base + 2], p[base + 3]); w.z = pg8::cvtpk(p[base + 4], p[base + 5]); w.w = pg8::cvtpk(p[base + 6], p[base + 7]);
    return __builtin_bit_cast(bf16x8, w);
}
DI void pv_tile(f32x16 (&o)[2], lcptr Vs, const f32x16& p0, const f32x16& p1, int lane, int hi) {
    lcptr vb = Vs + ((lane >> 4) & 1) * 32 + (lane & 3) * 8 + (4 * hi + ((lane & 15) >> 2)) * 64;
    bf16x8 pf[4]; pf[0] = pack8(p0, 0); pf[1] = pack8(p0, 8); pf[2] = pack8(p1, 0); pf[3] = pack8(p1, 8);
#pragma unroll
    for (int dh = 0; dh < 2; ++dh)
#pragma unroll
        for (int ks = 0; ks < 4; ++ks) {
            const s16x4 lo = vtr(vb + dh * 4096 + ks * 1024), hh = vtr(vb + dh * 4096 + ks * 1024 + 512);
            const bf16x8 vf = (bf16x8){lo[0], lo[1], lo[2], lo[3], hh[0], hh[1], hh[2], hh[3]};
            o[dh] = MFMA32(vf, pf[ks], o[dh]);
        }
}
DI float mask_scale(f32x16& p0, f32x16& p1, int klo, int khi, int hi) {
    const bool full = (klo <= 0) && (khi >= 63), none = (khi < klo) || (khi < 0) || (klo > 63);
    float mx;
    if (__all(full || none)) {
        const float bias = full ? 0.f : -INFINITY;
        float a = fmaxf(p0[0], p1[0]);
#pragma unroll
        for (int r = 1; r < 16; ++r) a = fmaxf(a, fmaxf(p0[r], p1[r]));
#pragma unroll
        for (int r = 0; r < 16; ++r) { p0[r] = p0[r] * L2E + bias; p1[r] = p1[r] * L2E + bias; }
        mx = a * L2E + bias;
    } else {
        const int lo2 = klo - 4 * hi, hi2 = khi - 4 * hi;
        float a = -INFINITY;
#pragma unroll
        for (int r = 0; r < 16; ++r) { const int kc = (r & 3) + 8 * (r >> 2);
            p0[r] = (kc >= lo2 && kc <= hi2) ? p0[r] * L2E : -INFINITY; p1[r] = (kc + 32 >= lo2 && kc + 32 <= hi2) ? p1[r] * L2E : -INFINITY; a = fmaxf(a, fmaxf(p0[r], p1[r])); }
        mx = a;
    }
    return fmaxf(mx, xhalf(mx));
}
DI void tile_online(lcptr slot, const bf16x8 (&qr)[4], int klo, int khi, float& m, float& l, f32x16 (&o)[2], int lane, int r32, int hi) {
    { const bool none = (khi < klo) || (khi < 0) || (klo > 63); if (__all(none)) return; }
    f32x16 p0, p1; qk_tile(p0, p1, slot, qr, r32, hi);
    const float mt = mask_scale(p0, p1, klo, khi, hi);
    const float mn = fmaxf(m, mt), alpha = __builtin_amdgcn_exp2f(m - mn); m = mn;
    float s = 0.f;
#pragma unroll
    for (int r = 0; r < 16; ++r) { p0[r] = __builtin_amdgcn_exp2f(p0[r] - mn); p1[r] = __builtin_amdgcn_exp2f(p1[r] - mn); s += p0[r] + p1[r]; }
    l = l * alpha + s;
#pragma unroll
    for (int r = 0; r < 16; ++r) { o[0][r] *= alpha; o[1][r] *= alpha; }
    pv_tile(o, slot + 8192, p0, p1, lane, hi);
}
constexpr float THR = 4.0f;
DI float max3f(float a, float b, float c) { return __builtin_fmaxf(__builtin_fmaxf(a, b), c); }
DI void tile_online2(lcptr slot, const bf16x8 (&qr)[4], int klo, int khi, float& mneg, bool& has, float& l, f32x16 (&o)[2], int lane, int r32, int hi) {
    const bool full = (klo <= 0) && (khi >= 63), none = (khi < klo) || (khi < 0) || (klo > 63);
    if (__all(none)) return;
    f32x16 p0, p1;
    { const float cinit = none ? -INFINITY : mneg;
#pragma unroll
      for (int r = 0; r < 16; ++r) { p0[r] = cinit; p1[r] = cinit; }
      lcptr kb = slot + hi * 1024 + r32 * 16;
#pragma unroll
      for (int d0 = 0; d0 < 4; ++d0) {
          const bf16x8 b0 = *(const LAS bf16x8*)(kb + d0 * 2048), b1 = *(const LAS bf16x8*)(kb + d0 * 2048 + 512);
          p0 = MFMA32(b0, qr[d0], p0); p1 = MFMA32(b1, qr[d0], p1);
      } }
    if (!__all(full || none)) {
        const int lo2 = klo - 4 * hi, hi2 = khi - 4 * hi;
#pragma unroll
        for (int r = 0; r < 16; ++r) { const int kc = (r & 3) + 8 * (r >> 2);
            p0[r] = (kc >= lo2 && kc <= hi2) ? p0[r] : -INFINITY; p1[r] = (kc + 32 >= lo2 && kc + 32 <= hi2) ? p1[r] : -INFINITY; }
    }
    float rm;
    { float a = max3f(p0[0], p0[1], p1[0]), b = max3f(p0[2], p0[3], p1[1]); a = max3f(a, p1[2], p1[3]);
#pragma unroll
      for (int r = 4; r < 16; r += 4) { a = max3f(a, p0[r], p0[r + 1]); b = max3f(b, p0[r + 2], p0[r + 3]); a = max3f(a, p1[r], p1[r + 1]); b = max3f(b, p1[r + 2], p1[r + 3]); }
      rm = fmaxf(a, b); rm = fmaxf(rm, xhalf(rm)); }
    const bool trig = has ? (rm > THR) : (rm > -INFINITY);
    if (__any(trig)) {
        const float dl = trig ? rm : 0.f;
        const float f = has ? __builtin_amdgcn_exp2f(-dl) : 1.0f;
        mneg -= dl; has = has || trig;
#pragma unroll
        for (int r = 0; r < 16; ++r) { p0[r] -= dl; p1[r] -= dl; }
        l *= f;
#pragma unroll
        for (int r = 0; r < 16; ++r) { o[0][r] *= f; o[1][r] *= f; }
    }
    float s0 = 0.f, s1 = 0.f;
#pragma unroll
    for (int r = 0; r < 16; ++r) { p0[r] = __builtin_amdgcn_exp2f(p0[r]); p1[r] = __builtin_amdgcn_exp2f(p1[r]); s0 += p0[r]; s1 += p1[r]; }
    l += s0 + s1;
    pv_tile(o, slot + 8192, p0, p1, lane, hi);
}
DI void tile_stats(lcptr slot, const bf16x8 (&qr)[4], int klo, int khi, float& m, float& l, int r32, int hi) {
    f32x16 p0, p1; qk_tile(p0, p1, slot, qr, r32, hi);
    const float mt = mask_scale(p0, p1, klo, khi, hi);
    const float mn = fmaxf(m, mt), alpha = __builtin_amdgcn_exp2f(m - mn); m = mn;
    float s = 0.f;
#pragma unroll
    for (int r = 0; r < 16; ++r) s += __builtin_amdgcn_exp2f(p0[r] - mn) + __builtin_amdgcn_exp2f(p1[r] - mn);
    l = l * alpha + s;
}
DI void tile_final(lcptr slot, const bf16x8 (&qr)[4], int klo, int khi, float m, float inv, f32x16 (&o)[2], float& carry, LAS float* imp_row  , bool writer, int lane, int r32, int hi) {
    f32x16 p0, p1; qk_tile(p0, p1, slot, qr, r32, hi);
    (void)mask_scale(p0, p1, klo, khi, hi);
#pragma unroll
    for (int r = 0; r < 16; ++r) { p0[r] = __builtin_amdgcn_exp2f(p0[r] - m) * inv; p1[r] = __builtin_amdgcn_exp2f(p1[r] - m) * inv; }
    float y3[8];
#pragma unroll
    for (int x = 0; x < 4; ++x) { y3[x] = xhalf(p0[4 * x + 3]); y3[4 + x] = xhalf(p1[4 * x + 3]); }
#pragma unroll
    for (int x = 0; x < 8; ++x) {
        const float bs = (x < 4) ? (p0[4 * x] + p0[4 * x + 1]) + (p0[4 * x + 2] + p0[4 * x + 3]) : (p1[4 * (x - 4)] + p1[4 * (x - 4) + 1]) + (p1[4 * (x - 4) + 2] + p1[4 * (x - 4) + 3]);
        const float prev = (x == 0) ? carry : y3[x == 0 ? 0 : x - 1];
        float v = bs + (hi ? y3[x] : prev);
        v += __shfl_xor(v, 1); v += __shfl_xor(v, 2);
        if (writer) imp_row[2 * x + hi] = v;
    }
    carry = y3[7];
    pv_tile(o, slot + 8192, p0, p1, lane, hi);
}
struct AP {
    unsigned char* ws;
#define AP_PTR(name, T_, off) DI T_* name() const { return (T_*)(ws + (off)); }
    AP_PTR(QN, const bf16_t, 80ull << 20) AP_PTR(QR, const bf16_t, 112ull << 20) AP_PTR(KCC, const bf16_t, (2ull << 20) + 256 * 1024) AP_PTR(VCC, const bf16_t, (2ull << 20) + 768 * 1024)
    AP_PTR(KS, const bf16_t, 160ull << 20) AP_PTR(VS, const bf16_t, 168ull << 20) AP_PTR(KW, const bf16_t, 176ull << 20) AP_PTR(VW, const bf16_t, 184ull << 20)
    AP_PTR(ZS, const bf16_t, 192ull << 20) AP_PTR(MQ, const bf16_t, 256ull << 20) AP_PTR(MK, const bf16_t, 288ull << 20) AP_PTR(MV, const bf16_t, 320ull << 20)
    AP_PTR(GT, const float, 352ull << 20) AP_PTR(KM, const float, 2ull << 20) AP_PTR(Y, bf16_t, 16ull << 20)
    AP_PTR(CNT, unsigned, 32768) AP_PTR(LIST, unsigned, 356ull << 20) AP_PTR(PO, bf16_t, 388ull << 20) AP_PTR(PML, float, 484ull << 20)
#undef AP_PTR
};
#define TILE_LOOP(NT, KPTR_EXPR, VPTR_EXPR, NEEDV, BOUNDS_STMT, COMPUTE_STMT) \
  { u32x4 kr_ = {0u, 0u, 0u, 0u}, vr_ = {0u, 0u, 0u, 0u}; \
    { const int i = 0; (void)i; stage_load(KPTR_EXPR, VPTR_EXPR, wid, lane, kr_, vr_, NEEDV); } \
    stage_write(lds, wid, lane, kr_, vr_, NEEDV); __syncthreads(); \
    const int nt_ = (NT); \
    for (int i_ = 0; i_ < nt_; ++i_) { \
      const bool more_ = i_ + 1 < nt_; \
      if (more_) { const int i = i_ + 1; (void)i; stage_load(KPTR_EXPR, VPTR_EXPR, wid, lane, kr_, vr_, NEEDV); } \
      { const int i = i_; (void)i; lcptr slot = lds + (i_ & 1) * 16384; int klo, khi; BOUNDS_STMT; COMPUTE_STMT; } \
      if (more_) stage_write(lds + ((i_ + 1) & 1) * 16384, wid, lane, kr_, vr_, NEEDV); \
      __syncthreads(); } }
DI void zero2(f32x16 (&o)[2]) {
#pragma unroll
    for (int r = 0; r < 16; ++r) { o[0][r] = 0.f; o[1][r] = 0.f; }
}
DI void load_q(bf16x8 (&qr)[4], const bf16_t* qrow, int hi) {
#pragma unroll
    for (int d0 = 0; d0 < 4; ++d0) qr[d0] = *(const bf16x8*)(qrow + 16 * d0 + 8 * hi);
}
DI float bf_lo(unsigned w) { return __uint_as_float(w << 16); }
DI float bf_hi(unsigned w) { return __uint_as_float(w & 0xffff0000u); }
DI void write_y(const f32x16 (&o)[2], float scale, const bf16_t* zrow, bf16_t* yrow, int hi) {
#pragma unroll
    for (int dh = 0; dh < 2; ++dh)
#pragma unroll
        for (int gq = 0; gq < 4; ++gq) {
            const int d = 32 * dh + 8 * gq + 4 * hi;
            const u32x2 z = *(const u32x2*)(zrow + d);
            u32x2 w; w.x = pg8::cvtpk(o[dh][4 * gq] * scale * bf_lo(z.x), o[dh][4 * gq + 1] * scale * bf_hi(z.x)); w.y = pg8::cvtpk(o[dh][4 * gq + 2] * scale * bf_lo(z.y), o[dh][4 * gq + 3] * scale * bf_hi(z.y));
            *(u32x2*)(yrow + d) = w;
        }
}
DI void nsa_item(const AP& P, lptr lds, int b, int g, int c, int wid, int lane) {
    const int r32 = lane & 31, hi = lane >> 5, qi = r32 >> 2, hh = r32 & 3, H = 4 * g + hh;
    const int tq = 64 * c + 8 * wid + qi;
    const size_t qoff = ((size_t)(b * 8 + H) * SEQ + tq) * 64;
    const size_t row = (size_t)b * SEQ + tq;
    bf16x8 qr[4]; load_q(qr, P.QN() + qoff, hi);
    const float* gp = P.GT() + row * 32 + H * 3; const float g0 = gp[0], g1 = gp[1], g2 = gp[2];
    f32x16 o[2];
    LAS float* otl = (LAS float*)(lds + 69632) + (wid * 64 + lane);
    const int ntok = (4 * c + 3) < 511 ? (4 * c + 3) : 511, ntc = (ntok + 63) >> 6;
    const bf16_t* kcc = P.KCC() + (size_t)(b * 2 + g) * 512 * 64; const bf16_t* vcc = P.VCC() + (size_t)(b * 2 + g) * 512 * 64;
    int khi_abs = (tq - 31) >> 4; khi_abs = khi_abs < 510 ? khi_abs : 510;
    float m = NEG_INIT, l = 0.f;
    TILE_LOOP(ntc, kcc + i * 4096, vcc + i * 4096, false, { klo = -64 * i; khi = khi_abs - 64 * i; }, tile_stats(slot, qr, klo, khi, m, l, r32, hi));
    l += xhalf(l);
    { const float inv = l > 0.f ? 1.0f / l : 0.f; float carry = 0.f; zero2(o);
      LAS float* imp = (LAS float*)(lds + 32768) + (8 * wid + qi) * 128;
      TILE_LOOP(ntc, kcc + i * 4096, vcc + i * 4096, true, { klo = -64 * i; khi = khi_abs - 64 * i; }, tile_final(slot, qr, klo, khi, m, inv, o, carry, imp + 16 * i, hh == 0, lane, r32, hi));
#pragma unroll
      for (int r = 0; r < 16; ++r) { otl[r * 512] = g0 * o[0][r]; otl[(16 + r) * 512] = g0 * o[1][r]; } }
    LAS unsigned* selb = (LAS unsigned*)(lds + 65536);
    for (int q2 = 0; q2 < 8; ++q2) {
        unsigned long long s0, s1;
        if (c <= 15) { s0 = (2ull << c) - 1ull; s1 = 0ull; }
        else {
            const LAS float* ir = (const LAS float*)(lds + 32768) + (8 * wid + q2) * 128;
            const float v0 = ir[lane], v1 = ir[64 + lane];
            const int nc2 = c - 2;
            const unsigned k0 = (lane >= 1 && lane <= nc2) ? __float_as_uint(v0) + 1u : 0u, k1 = (lane + 64 <= nc2) ? __float_as_uint(v1) + 1u : 0u;
            unsigned lo = 1u, hb = 0x7f800002u; unsigned long long m0 = 0ull, m1 = 0ull; bool exact = false;
            while (hb - lo > 1u) {
                const unsigned mid = lo + ((hb - lo) >> 1);
                m0 = __ballot(k0 >= mid); m1 = __ballot(k1 >= mid);
                const int cnt = __popcll(m0) + __popcll(m1);
                if (cnt == 13) { exact = true; break; }
                if (cnt > 13) lo = mid; else hb = mid;
            }
            if (!exact) {
                const unsigned long long gg0 = __ballot(k0 > lo), gg1 = __ballot(k1 > lo), e0 = __ballot(k0 == lo), e1 = __ballot(k1 == lo);
                const int need = 13 - __popcll(gg0) - __popcll(gg1);
                const unsigned long long lt = (1ull << lane) - 1ull;
                const int r0 = __popcll(e0 & lt), r1 = __popcll(e0) + __popcll(e1 & lt);
                m0 = gg0 | __ballot(k0 == lo && r0 < need); m1 = gg1 | __ballot(k1 == lo && r1 < need);
            }
            s0 = m0 | 1ull; s1 = m1;
            if (c - 1 < 64) s0 |= 1ull << (c - 1); else s1 |= 1ull << (c - 65);
            if (c < 64) s0 |= 1ull << c; else s1 |= 1ull << (c - 64);
        }
        if (lane == 0) { LAS unsigned* sp = selb + (8 * wid + q2) * 4; sp[0] = (unsigned)s0; sp[1] = (unsigned)(s0 >> 32); sp[2] = (unsigned)s1; sp[3] = (unsigned)(s1 >> 32); }
    }
    const unsigned sb0 = selb[(8 * wid + qi) * 4 + 0], sb1 = selb[(8 * wid + qi) * 4 + 1], sb2 = selb[(8 * wid + qi) * 4 + 2], sb3 = selb[(8 * wid + qi) * 4 + 3];
    load_q(qr, P.QR() + qoff, hi);
    const bf16_t* ks = P.KS() + (size_t)(b * 2 + g) * SEQ * 64; const bf16_t* vs = P.VS() + (size_t)(b * 2 + g) * SEQ * 64;
    float mneg = 0.f; bool has = false; l = 0.f; zero2(o);
    TILE_LOOP(c + 1, ks + (size_t)i * 4096, vs + (size_t)i * 4096, true,
              { klo = 0; const unsigned w = i < 32 ? sb0 : i < 64 ? sb1 : i < 96 ? sb2 : sb3; khi = (i == c) ? (tq - 64 * c) : (((w >> (i & 31)) & 1u) ? 63 : -1); },
              tile_online2(slot, qr, klo, khi, mneg, has, l, o, lane, r32, hi));
    l += xhalf(l);
    { const float f = l > 0.f ? g1 / l : 0.f;
#pragma unroll
      for (int r = 0; r < 16; ++r) { otl[r * 512] += f * o[0][r]; otl[(16 + r) * 512] += f * o[1][r]; } }
    const bf16_t* kw = P.KW() + (size_t)(b * 2 + g) * SEQ * 64; const bf16_t* vw = P.VW() + (size_t)(b * 2 + g) * SEQ * 64;
    const int j0 = c > 8 ? c - 8 : 0;
    mneg = 0.f; has = false; l = 0.f; zero2(o);
    TILE_LOOP(c - j0 + 1, kw + (size_t)(j0 + i) * 4096, vw + (size_t)(j0 + i) * 4096, true,
              { const int base = 64 * (j0 + i); klo = tq - 511 - base; khi = tq - base; },
              tile_online2(slot, qr, klo, khi, mneg, has, l, o, lane, r32, hi));
    l += xhalf(l);
    { const float f = l > 0.f ? g2 / l : 0.f;
#pragma unroll
      for (int r = 0; r < 16; ++r) { o[0][r] = otl[r * 512] + f * o[0][r]; o[1][r] = otl[(16 + r) * 512] + f * o[1][r]; } }
    write_y(o, 1.0f, P.ZS() + row * 1024 + H * 64, P.Y() + row * 1024 + H * 64, hi);
}
constexpr int LCAP = 8192;
DI void moba_select_item(const AP& P, lptr lds, int b, int h, int own, int wid, int lane, int tid) {
    const int r32 = lane & 31, hi = lane >> 5;
    const int tq = 256 * own + 32 * wid + r32, bh = b * 8 + h;
    unsigned bits = 0u;
    if (own <= 3) bits = (1u << own) - 1u;
    else {
        bf16x8 qr[4]; load_q(qr, P.MQ() + ((size_t)bh * SEQ + tq) * 64, hi);
        { const int j = tid >> 4, d4 = (tid & 15) * 4;
          const f32x4 km = *(const f32x4*)(P.KM() + ((size_t)bh * 32 + j) * 64 + d4);
          const unsigned h01 = pg8::cvtpk(km[0], km[1]), h23 = pg8::cvtpk(km[2], km[3]);
          const unsigned l01 = pg8::cvtpk(km[0] - bf_lo(h01), km[1] - bf_hi(h01)), l23 = pg8::cvtpk(km[2] - bf_lo(h23), km[3] - bf_hi(h23));
          const int off = (d4 >> 3) * 1024 + j * 16 + (d4 & 7) * 2;
          *(LAS u32x2*)(lds + off) = (u32x2){h01, h23}; *(LAS u32x2*)(lds + 16384 + off) = (u32x2){l01, l23}; }
        __syncthreads();
        f32x16 sg;
#pragma unroll
        for (int r = 0; r < 16; ++r) sg[r] = 0.f;
        { lcptr kb = lds + hi * 1024 + r32 * 16;
#pragma unroll
          for (int d0 = 0; d0 < 4; ++d0) { const bf16x8 a = *(const LAS bf16x8*)(kb + d0 * 2048), a2 = *(const LAS bf16x8*)(kb + 16384 + d0 * 2048); sg = MFMA32(a, qr[d0], sg); sg = MFMA32(a2, qr[d0], sg); } }
#pragma unroll
        for (int r = 0; r < 16; ++r) if (crow(r, hi) >= own) sg[r] = -INFINITY;
#pragma unroll
        for (int rd = 0; rd < 3; ++rd) {
            float best = sg[0]; int bj = crow(0, hi);
#pragma unroll
            for (int r = 1; r < 16; ++r) if (sg[r] > best) { best = sg[r]; bj = crow(r, hi); }
            const float ob = xhalf(best); const int oj = __shfl_xor(bj, 32);
            if (ob > best || (ob == best && oj < bj)) { best = ob; bj = oj; }
            if (best > -INFINITY) bits |= 1u << bj;
#pragma unroll
            for (int r = 0; r < 16; ++r) if (crow(r, hi) == bj) sg[r] = -INFINITY;
        }
        __syncthreads();
    }
    unsigned* cnt = P.CNT() + bh * 32; unsigned* list = P.LIST() + (size_t)bh * 32 * LCAP;
    for (int j = 0; j < own; ++j) {
        const bool sel = (hi == 0) && ((bits >> j) & 1u);
        const unsigned long long mask = __ballot(sel);
        if (mask) {
            const int first = __ffsll((long long)mask) - 1;
            unsigned base = 0u;
            if (lane == first) base = atomicAdd(cnt + j, (unsigned)__popcll(mask));
            base = __shfl(base, first);
            if (sel) list[(size_t)j * LCAP + base + __popcll(mask & ((1ull << lane) - 1ull))] = ((unsigned)tq << 2) | (unsigned)__popc(bits & ((1u << j) - 1u));
        }
    }
}
DI void moba_past_item(const AP& P, lptr lds, int bhj, int g, int wid, int lane) {
    const int r32 = lane & 31, hi = lane >> 5, bh = bhj >> 5, j = bhj & 31;
    const unsigned cnt = P.CNT()[bhj], idx = 256u * g + 32u * wid + r32;
    const bool valid = idx < cnt;
    const unsigned e = P.LIST()[(size_t)bhj * LCAP + (valid ? idx : 256u * g)];
    const int tq = (int)(e >> 2), slot = (int)(e & 3u);
    bf16x8 qr[4]; load_q(qr, P.MQ() + ((size_t)bh * SEQ + tq) * 64, hi);
    const bf16_t* mk = P.MK() + ((size_t)bh * SEQ + 256 * j) * 64; const bf16_t* mv = P.MV() + ((size_t)bh * SEQ + 256 * j) * 64;
    float mneg = 0.f, l = 0.f; bool has = false; f32x16 o[2]; zero2(o);
    TILE_LOOP(4, mk + (size_t)i * 4096, mv + (size_t)i * 4096, true, { klo = 0; khi = valid ? 63 : -1; }, tile_online2(slot, qr, klo, khi, mneg, has, l, o, lane, r32, hi));
    l += xhalf(l);
    if (valid) {
        const size_t prow = ((size_t)bh * SEQ + tq) * 3 + slot;
        bf16_t* po = P.PO() + prow * 64;
#pragma unroll
        for (int dh = 0; dh < 2; ++dh)
#pragma unroll
            for (int gq = 0; gq < 4; ++gq) { u32x2 w; w.x = pg8::cvtpk(o[dh][4 * gq], o[dh][4 * gq + 1]); w.y = pg8::cvtpk(o[dh][4 * gq + 2], o[dh][4 * gq + 3]); *(u32x2*)(po + 32 * dh + 8 * gq + 4 * hi) = w; }
        if (hi == 0) { float* pm = (float*)P.PML() + prow * 2; pm[0] = -mneg; pm[1] = l; }
    }
}
DI void moba_own_item(const AP& P, lptr lds, int b, int h, int own, int wid, int lane) {
    const int r32 = lane & 31, hi = lane >> 5;
    const int tq = 256 * own + 32 * wid + r32, bh = b * 8 + h;
    const size_t hb = (size_t)bh * SEQ * 64;
    const size_t row = (size_t)b * SEQ + tq;
    bf16x8 qr[4]; load_q(qr, P.MQ() + hb + (size_t)tq * 64, hi);
    float mneg = 0.f, l = 0.f; bool has = false; f32x16 o[2]; zero2(o);
    const int np = own < 3 ? own : 3;
    if (np > 0) {
        const size_t prow = ((size_t)bh * SEQ + tq) * 3;
        const float* pm = P.PML() + prow * 2;
        float mm[3], ll[3];
#pragma unroll
        for (int s = 0; s < 3; ++s) { mm[s] = s < np ? pm[2 * s] : -INFINITY; ll[s] = s < np ? pm[2 * s + 1] : 0.f; }
        const float mx = fmaxf(fmaxf(mm[0], mm[1]), mm[2]);
        mneg = -mx; has = true;
#pragma unroll
        for (int s = 0; s < 3; ++s) if (s < np) {
            const float w = __builtin_amdgcn_exp2f(mm[s] - mx);
            if (hi == 0) l += ll[s] * w;
            const bf16_t* po = P.PO() + (prow + s) * 64;
#pragma unroll
            for (int dh = 0; dh < 2; ++dh)
#pragma unroll
                for (int gq = 0; gq < 4; ++gq) { const u32x2 z = *(const u32x2*)(po + 32 * dh + 8 * gq + 4 * hi);
                    o[dh][4 * gq] += w * bf_lo(z.x); o[dh][4 * gq + 1] += w * bf_hi(z.x); o[dh][4 * gq + 2] += w * bf_lo(z.y); o[dh][4 * gq + 3] += w * bf_hi(z.y); }
        }
    }
    const bf16_t* mk = P.MK() + hb + (size_t)own * 256 * 64; const bf16_t* mv = P.MV() + hb + (size_t)own * 256 * 64;
    TILE_LOOP(4, mk + (size_t)i * 4096, mv + (size_t)i * 4096, true, { klo = 0; khi = 32 * wid + r32 - 64 * i; }, tile_online2(slot, qr, klo, khi, mneg, has, l, o, lane, r32, hi));
    l += xhalf(l);
    write_y(o, l > 0.f ? 1.0f / l : 0.f, P.ZS() + row * 1024 + 512 + h * 64, P.Y() + row * 1024 + 512 + h * 64, hi);
}
}
using att::lptr; using att::lcptr;
using pg8::bf16_t; using pg8::bf16x8; using pg8::u32x4; using pg8::f32x4;
constexpr int NWAVES = 8, NTHREADS = 512;
constexpr int BATCH = 4, T = 8192, DM = 1024, M = BATCH * T;
constexpr int NPROJ = 4096;
constexpr float LN_EPS = 1e-5f;
constexpr size_t MiB = 1u << 20;
constexpr size_t WS_CTL = 0;
constexpr size_t WS_ROPE = 1 * MiB;
constexpr size_t WS_B1P = WS_ROPE + 512 * 1024;
constexpr size_t WS_KM = 2 * MiB;
constexpr size_t WS_KCC = WS_KM + 256 * 1024;
constexpr size_t WS_VCC = WS_KCC + 512 * 1024;
constexpr size_t WS_W2T = WS_VCC + 512 * 1024;
constexpr size_t WS_W1T = 4 * MiB;
constexpr size_t WS_WOT = 6 * MiB;
constexpr size_t WS_WT = 8 * MiB;
constexpr size_t WS_XB = 16 * MiB;
constexpr size_t WS_Y = WS_XB;
constexpr size_t WS_QN = 80 * MiB, WS_QR = 112 * MiB;
constexpr size_t WS_KC = 144 * MiB, WS_VC = 152 * MiB, WS_KS = 160 * MiB, WS_VS = 168 * MiB, WS_KW = 176 * MiB, WS_VW = 184 * MiB;
constexpr size_t WS_ZS = 192 * MiB;
constexpr size_t WS_MQ = 256 * MiB, WS_MK = 288 * MiB, WS_MV = 320 * MiB;
constexpr size_t WS_GT = 352 * MiB;
constexpr size_t WS_LIST = 356 * MiB;
constexpr size_t WS_PO = 388 * MiB;
constexpr size_t WS_PML = 484 * MiB;
constexpr size_t WS_END = 490 * MiB;
constexpr int CW_CNT = 8192;
constexpr int LDS_BYTES = 136192;
constexpr int LDS_MISC = 135168;
constexpr int CW_BAR = 1024; static_assert(1024 + 3456 <= 8192, "barrier words below the list counters");

static_assert(WS_QN == (80ull << 20) && WS_QR == (112ull << 20) && WS_KCC == (2ull << 20) + 256 * 1024 && WS_VCC == (2ull << 20) + 768 * 1024 && WS_KS == (160ull << 20) && WS_VS == (168ull << 20) && WS_KW == (176ull << 20) && WS_VW == (184ull << 20) && WS_ZS == (192ull << 20) && WS_MQ == (256ull << 20) && WS_MK == (288ull << 20) && WS_MV == (320ull << 20) && WS_GT == (352ull << 20) && WS_KM == (2ull << 20) && WS_Y == (16ull << 20) && WS_KC == (144ull << 20) && WS_VC == (152ull << 20) && WS_ROPE == (1ull << 20) && WS_CTL + CW_CNT * 4 == 32768 && WS_LIST == (356ull << 20) && WS_PO == (388ull << 20) && WS_PML == (484ull << 20), "AP / EpiProj offsets");
struct Args { const float* in[13]; float* out; unsigned char* ws; int ph_lo, ph_hi; };

DI unsigned pk2(float lo, float hi) { return pg8::cvtpk(lo, hi); }
template <class Map> DI void transpose_item(const float* W, int ldw, Map srccol, bf16_t* WT, int K, LAS float* scr, int kb, int nb, int lane) {
    const int k0 = 64 * kb, n0 = 32 * nb; const int sc = srccol(n0 + (lane & 31));
#pragma unroll 8
    for (int i = 0; i < 32; ++i) { const int kk = 2 * i + (lane >> 5); scr[kk * 33 + (lane & 31)] = sc >= 0 ? W[(size_t)(k0 + kk) * ldw + sc] : 0.f; }
    asm volatile("s_waitcnt lgkmcnt(0)" ::: "memory");
    const int c = lane & 7;
#pragma unroll
    for (int j = 0; j < 4; ++j) { const int n = (lane >> 3) + 8 * j; const LAS float* s = scr + (8 * c) * 33 + n;
        u32x4 o; o.x = pk2(s[0 * 33], s[1 * 33]); o.y = pk2(s[2 * 33], s[3 * 33]); o.z = pk2(s[4 * 33], s[5 * 33]); o.w = pk2(s[6 * 33], s[7 * 33]);
        *(u32x4*)(WT + (size_t)(n0 + n) * K + k0 + 8 * c) = o; }
    asm volatile("s_waitcnt lgkmcnt(0)" ::: "memory");
}
struct MapIdent { DI int operator()(int n) const { return n; } };
struct MapProj { DI int operator()(int n) const { return n < 1280 ? n : n < 3840 ? n + 24 : n < 3864 ? n - 2560 : -1; } };
DI float wave_sum(float v) {
#pragma unroll
    for (int o = 1; o < 64; o <<= 1) v += __shfl_xor(v, o);
    return v;
}
DI void sincos_d(double a, double& s, double& c) {
    const double q = __builtin_rint(a * 0.63661977236758134308);
    double r = __builtin_fma(-q, 1.57079632679489655800e+00, a); r = __builtin_fma(-q, 6.12323399573676603587e-17, r);
    const double r2 = r * r;
    double ps = -1.0 / 1307674368000.0; ps = ps * r2 + 1.0 / 6227020800.0; ps = ps * r2 - 1.0 / 39916800.0; ps = ps * r2 + 1.0 / 362880.0; ps = ps * r2 - 1.0 / 5040.0; ps = ps * r2 + 1.0 / 120.0; ps = ps * r2 - 1.0 / 6.0; ps = ps * r2 * r + r;
    double pc = 1.0 / 20922789888000.0; pc = pc * r2 - 1.0 / 87178291200.0; pc = pc * r2 + 1.0 / 479001600.0; pc = pc * r2 - 1.0 / 3628800.0; pc = pc * r2 + 1.0 / 40320.0; pc = pc * r2 - 1.0 / 720.0; pc = pc * r2 + 1.0 / 24.0; pc = pc * r2 - 0.5; pc = pc * r2 + 1.0;
    const int qi = (int)((long long)q & 3);
    s = (qi == 0) ? ps : (qi == 1) ? pc : (qi == 2) ? -ps : -pc;
    c = (qi == 0) ? pc : (qi == 1) ? -ps : (qi == 2) ? -pc : ps;
}
#define XB_TMO      128
#define XB_XCNT(j)  (256  + 64 * (j))
#define XB_XSUB(j)  (1280 + 64 * (j))
#define XB_XGEN(j)  (2304 + 64 * (j))
#define XB_TOP      3328
#define XB_TOPGEN   3392
#define XCD_BAR_WORDS 3456
#define XB_SPIN_CAP (1u << 18)

__device__ __forceinline__ unsigned xb_ld(unsigned* p)              { return __hip_atomic_load(p, __ATOMIC_RELAXED, __HIP_MEMORY_SCOPE_AGENT); }
__device__ __forceinline__ unsigned xb_add(unsigned* p, unsigned v) { return __hip_atomic_fetch_add(p, v, __ATOMIC_RELAXED, __HIP_MEMORY_SCOPE_AGENT); }
__device__ __forceinline__ unsigned xb_xcc_id() { return (unsigned)__builtin_amdgcn_s_getreg((3 << 11) | 20) & 0xFu; }
#define XB_SPIN(cond, bar) do { unsigned _sp = 0; while (cond) { __builtin_amdgcn_s_sleep(1); \
    if ((++_sp & 255u) == 0u) { if (xb_ld(&(bar)[XB_TMO])) break; if (_sp > XB_SPIN_CAP) { atomicAdd(&(bar)[XB_TMO], 1u); break; } } } } while (0)

struct XcdBarrier {
    unsigned* bar; unsigned x;
    volatile LAS unsigned* st;
};

__device__ __forceinline__ XcdBarrier xcd_barrier_post(unsigned* bar, volatile LAS unsigned* st) {
    XcdBarrier b; b.bar = bar; b.x = xb_xcc_id(); b.st = st;
    if (threadIdx.x == 0) (void)xb_add(&bar[XB_XCNT(b.x)], 1u);
    return b;
}
__device__ __forceinline__ void xcd_barrier_complete(unsigned* bar, unsigned x, unsigned& nloc, unsigned& nx) {
    const unsigned G = gridDim.x * gridDim.y * gridDim.z;
    unsigned sum, cnt, mine, sp = 0u;
    for (;;) {
        sum = 0u; cnt = 0u; mine = 0u;
#pragma unroll
        for (unsigned j = 0; j < 16; ++j) { const unsigned c = xb_ld(&bar[XB_XCNT(j)]); sum += c; cnt += (c > 0u) ? 1u : 0u; mine = (j == x) ? c : mine; }
        if (sum == G) break;
        __builtin_amdgcn_s_sleep(1);
        if ((++sp & 255u) == 0u) { if (xb_ld(&bar[XB_TMO])) break; if (sp > XB_SPIN_CAP) { atomicAdd(&bar[XB_TMO], 1u); break; } }
    }
    nloc = mine > 0u ? mine : 1u; nx = cnt > 0u ? cnt : 1u;
}

__device__ __forceinline__ void xcd_barrier(const XcdBarrier& b) {
    asm volatile("s_waitcnt vmcnt(0)" ::: "memory");
    __syncthreads();
    if (threadIdx.x == 0) {
        unsigned* bar = b.bar;
        __builtin_amdgcn_s_waitcnt(0);
        unsigned nloc = b.st[0], nx = b.st[1];
        if (nloc == 0u) { xcd_barrier_complete(bar, b.x, nloc, nx); b.st[0] = nloc; b.st[1] = nx; }
        const unsigned old = xb_add(&bar[XB_XSUB(b.x)], 1u);
        const unsigned gen = old / nloc;
        if (old + 1u == (gen + 1u) * nloc) {
            __builtin_amdgcn_fence(__ATOMIC_RELEASE, "agent");
            asm volatile("s_waitcnt vmcnt(0)" ::: "memory");
            const unsigned og = xb_add(&bar[XB_TOP], 1u);
            const unsigned tg = og / nx;
            if (og + 1u == (tg + 1u) * nx) xb_add(&bar[XB_TOPGEN], 1u);
            else XB_SPIN(xb_ld(&bar[XB_TOPGEN]) == tg, bar);
            __builtin_amdgcn_fence(__ATOMIC_ACQUIRE, "agent");
            xb_add(&bar[XB_XGEN(b.x)], 1u);
            asm volatile("s_waitcnt vmcnt(0)" ::: "memory");
        } else {
            XB_SPIN(xb_ld(&bar[XB_XGEN(b.x)]) == gen, bar);
            __builtin_amdgcn_fence(__ATOMIC_ACQUIRE, "agent");
            asm volatile("s_waitcnt vmcnt(0)" ::: "memory");
        }
    }
    __syncthreads();
}

struct Frame { lptr lds; int tid, lane, wave, G, bx; };

DI void p0_prep(const Args& a, const Frame& F) {
    unsigned char* ws = a.ws;
    LAS float* scr = (LAS float*)(F.lds + F.wave * 16384);
    const int gw = F.bx * NWAVES + F.wave, NGW = F.G * NWAVES;
    if (F.bx == 0) { for (int i = F.tid; i < CW_CNT + 1024; i += NTHREADS) ((unsigned*)(ws + WS_CTL))[i] = 0u; }
    constexpr int I0 = 16 * 128, I1 = 16 * 32, I2 = 32 * 8, I3 = 4 * 2, I4 = 128;
    constexpr int NITEMS = I0 + I1 + 2 * I2 + 2 * I3 + I4;
    for (int it = gw; it < NITEMS; it += NGW) {
        int r = it;
        if (r < I0) { transpose_item(a.in[1], 3864, MapProj(), (bf16_t*)(ws + WS_WT), 1024, scr, r / 128, r % 128, F.lane); continue; } r -= I0;
        if (r < I1) { transpose_item(a.in[10], 1024, MapIdent(), (bf16_t*)(ws + WS_WOT), 1024, scr, r / 32, r % 32, F.lane); continue; } r -= I1;
        if (r < 2 * I2) { const int kv = r / I2; r %= I2; transpose_item(a.in[kv ? 7 : 3], 256, MapIdent(), (bf16_t*)(ws + WS_W1T) + (size_t)kv * 256 * 2048, 2048, scr, r / 8, r % 8, F.lane); continue; } r -= 2 * I2;
        if (r < 2 * I3) { const int kv = r / I3; r %= I3; transpose_item(a.in[kv ? 9 : 5], 64, MapIdent(), (bf16_t*)(ws + WS_W2T) + (size_t)kv * 64 * 256, 256, scr, r / 2, r % 2, F.lane); continue; } r -= 2 * I3;
        {
            float* pp = (float*)(ws + WS_B1P) + (size_t)r * 512;
#pragma unroll
            for (int e = 0; e < 8; ++e) { const int idx = e * 64 + F.lane, kv = idx >> 8, n = idx & 255; const float* pos = a.in[kv ? 6 : 2]; const float* w1 = a.in[kv ? 7 : 3];
                float s = 0.f;
#pragma unroll
                for (int k = 0; k < 16; ++k) s += pos[16 * r + k] * w1[(size_t)(16 * r + k) * 256 + n];
                pp[idx] = s; }
        }
    }
    { const f32x4* x4 = (const f32x4*)a.in[0]; u32x4* xb = (u32x4*)(ws + WS_XB); const size_t n8 = (size_t)M * DM / 8, stride = (size_t)F.G * NTHREADS;
      for (size_t i = (size_t)F.bx * NTHREADS + F.tid; i < n8; i += stride) { const f32x4 v0 = x4[2 * i], v1 = x4[2 * i + 1]; u32x4 o; o.x = pk2(v0[0], v0[1]); o.y = pk2(v0[2], v0[3]); o.z = pk2(v1[0], v1[1]); o.w = pk2(v1[2], v1[3]); xb[i] = o; } }
    { float* rp = (float*)(ws + WS_ROPE);
      for (int i = F.bx * NTHREADS + F.tid; i < T * 8; i += F.G * NTHREADS) { const int t = i >> 3, f = i & 7;
          const float invf = f == 0 ? 1.0f : f == 1 ? 0.19392274f : f == 2 ? 0.03760603f : f == 3 ? 0.0072926646f : f == 4 ? 0.0014142136f : f == 5 ? 0.0002742482f : f == 6 ? 5.318296e-05f : 1.0313386e-05f;
          const float ang = (float)t * invf; double s, c; sincos_d((double)ang, s, c);
          rp[t * 16 + f] = (float)c; rp[t * 16 + 8 + f] = (float)s; } }
}
DI void p2_compress_item(const Args& a, const Frame& F, int item) {
    unsigned char* ws = a.ws;
    const int kv = item >> 6, bg = (item >> 3) & 7, ib = item & 7;
    const bf16_t* src = (const bf16_t*)(ws + (kv ? WS_VC : WS_KC)) + (size_t)bg * T * 64;
    const bf16_t* w1t = (const bf16_t*)(ws + WS_W1T) + (size_t)kv * 256 * 2048;
    const bf16_t* w2t = (const bf16_t*)(ws + WS_W2T) + (size_t)kv * 64 * 256;
    bf16_t* dst = (bf16_t*)(ws + (kv ? WS_VCC : WS_KCC)) + (size_t)bg * 512 * 64;
    LAS float* b1p = (LAS float*)(F.lds);
    LAS float* red = (LAS float*)(F.lds + 1024);
    LAS bf16_t* Hs = (LAS bf16_t*)(F.lds + 4096);
    const int lane = F.lane, wid = F.wave, r32 = lane & 31, hi = lane >> 5;
    { const int n = F.tid & 255, half = F.tid >> 8; const float* pp = (const float*)(ws + WS_B1P) + kv * 256 + n; float s = 0.f;
      for (int j = 0; j < 64; ++j) s += pp[(size_t)(half * 64 + j) * 512];
      red[half * 256 + n] = s; }
    __syncthreads();
    if (F.tid < 256) b1p[F.tid] = red[F.tid] + red[256 + F.tid] + a.in[kv ? 8 : 4][F.tid];
    __syncthreads();
    att::f32x16 acc0, acc1;
#pragma unroll
    for (int r = 0; r < 16; ++r) { acc0[r] = 0.f; acc1[r] = 0.f; }
    { int i0 = 64 * ib + r32, i1 = i0 + 32; i0 = i0 < 510 ? i0 : 510; i1 = i1 < 510 ? i1 : 510;
      const bf16_t* a0p = src + (size_t)i0 * 16 * 64 + 8 * hi; const bf16_t* a1p = src + (size_t)i1 * 16 * 64 + 8 * hi; const bf16_t* bp = w1t + (size_t)(32 * wid + r32) * 2048 + 8 * hi;
#pragma unroll 4
      for (int s = 0; s < 128; ++s) { const bf16x8 fa0 = *(const bf16x8*)(a0p + 16 * s), fa1 = *(const bf16x8*)(a1p + 16 * s), fb = *(const bf16x8*)(bp + 16 * s);
          acc0 = MFMA32(fa0, fb, acc0); acc1 = MFMA32(fa1, fb, acc1); } }
    { const int n = 32 * wid + r32; const float bb = b1p[n];
#pragma unroll
      for (int r = 0; r < 16; ++r) { const int i = att::crow(r, hi);
          Hs[i * 264 + n] = (bf16_t)(pg8::cvtpk(pg8::silu_f(acc0[r] + bb), 0.f) & 0xffffu); Hs[(i + 32) * 264 + n] = (bf16_t)(pg8::cvtpk(pg8::silu_f(acc1[r] + bb), 0.f) & 0xffffu); } }
    __syncthreads();
    if (wid < 4) {
        const int rt = wid >> 1, ct = wid & 1; att::f32x16 acc2;
#pragma unroll
        for (int r = 0; r < 16; ++r) acc2[r] = 0.f;
#pragma unroll
        for (int s = 0; s < 16; ++s) { const bf16x8 fa = *(const LAS bf16x8*)(Hs + (32 * rt + r32) * 264 + 16 * s + 8 * hi), fb = *(const bf16x8*)(w2t + (size_t)(32 * ct + r32) * 256 + 16 * s + 8 * hi);
            acc2 = MFMA32(fa, fb, acc2); }
#pragma unroll
        for (int r = 0; r < 16; ++r) { const int i = 64 * ib + 32 * rt + att::crow(r, hi); dst[(size_t)i * 64 + 32 * ct + r32] = (bf16_t)(pg8::cvtpk(acc2[r], 0.f) & 0xffffu); }
    }
    __syncthreads();
}
DI void p2_kmean_item(const Args& a, const Frame& F, int item) {
    const bf16_t* mk = (const bf16_t*)(a.ws + WS_MK) + (size_t)item * 256 * 64;
    const int c = F.lane & 7, rg = F.lane >> 3; float s[8];
#pragma unroll
    for (int i = 0; i < 8; ++i) s[i] = 0.f;
#pragma unroll 4
    for (int p = 0; p < 32; ++p) { const u32x4 v = *(const u32x4*)(mk + (size_t)(8 * p + rg) * 64 + 8 * c);
        s[0] += att::bf_lo(v.x); s[1] += att::bf_hi(v.x); s[2] += att::bf_lo(v.y); s[3] += att::bf_hi(v.y); s[4] += att::bf_lo(v.z); s[5] += att::bf_hi(v.z); s[6] += att::bf_lo(v.w); s[7] += att::bf_hi(v.w); }
#pragma unroll
    for (int i = 0; i < 8; ++i) { s[i] += __shfl_xor(s[i], 8); s[i] += __shfl_xor(s[i], 16); s[i] += __shfl_xor(s[i], 32); }
    if (rg == 0) { float* o = (float*)(a.ws + WS_KM) + (size_t)item * 64 + 8 * c;
        *(f32x4*)o = (f32x4){s[0], s[1], s[2], s[3]} * (1.0f / 256.0f); *(f32x4*)(o + 4) = (f32x4){s[4], s[5], s[6], s[7]} * (1.0f / 256.0f); }
}
DI void p5_ln(const Args& a, const Frame& F) {
    const int gw = F.bx * NWAVES + F.wave, NGW = F.G * NWAVES;
    const f32x4* gn = (const f32x4*)a.in[11] + F.lane; const f32x4* bs = (const f32x4*)a.in[12] + F.lane;
    for (int r = gw; r < M; r += NGW) {
        f32x4* xr = (f32x4*)(a.out + (size_t)r * DM) + F.lane; f32x4 v[4]; float s = 0.f;
#pragma unroll
        for (int j = 0; j < 4; ++j) { v[j] = xr[64 * j]; s += (v[j][0] + v[j][1]) + (v[j][2] + v[j][3]); }
        const float mean = wave_sum(s) * (1.0f / DM); float s2 = 0.f;
#pragma unroll
        for (int j = 0; j < 4; ++j) { v[j] = v[j] - mean; s2 += (v[j][0] * v[j][0] + v[j][1] * v[j][1]) + (v[j][2] * v[j][2] + v[j][3] * v[j][3]); }
        const float rstd = 1.0f / sqrtf(wave_sum(s2) * (1.0f / DM) + LN_EPS);
#pragma unroll
        for (int j = 0; j < 4; ++j) xr[64 * j] = v[j] * rstd * gn[64 * j] + bs[64 * j];
    }
}
__global__ void __launch_bounds__(NTHREADS, 2) hymba_fwd(Args args) {
    extern __shared__ __attribute__((aligned(16))) unsigned char lds_raw[];
    cg::grid_group grid = cg::this_grid();
    Frame F; F.lds = (lptr)lds_raw; F.tid = threadIdx.x; F.lane = F.tid & 63; F.wave = __builtin_amdgcn_readfirstlane(F.tid >> 6); F.G = gridDim.x; F.bx = blockIdx.x;
    unsigned char* ws = args.ws;
    const int lo = args.ph_lo, hi = args.ph_hi;
    if (F.tid < 2) ((LAS unsigned*)(F.lds + LDS_MISC))[F.tid] = 0u;
    __syncthreads();
    XcdBarrier xbar; xbar.bar = nullptr; xbar.x = 0; xbar.st = nullptr;
#define IN(k) (lo <= (k) && (k) < hi)
#define SEAM(k) do { if (IN(k) && IN((k) + 1)) { if ((k) == 0 || !USE_XCD_BARRIER) grid.sync(); else xcd_barrier(xbar); } } while (0)
#ifndef USE_XCD_BARRIER
#define USE_XCD_BARRIER 1
#endif
#ifndef REPEAT_MASK
#define REPEAT_MASK 0
#endif
#define NREP(k) (((REPEAT_MASK) >> (k)) & 1 ? 2 : 1)
    for (int rep = 0; rep < NREP(0); ++rep) { if (rep) { if (USE_XCD_BARRIER) xcd_barrier(xbar); else grid.sync(); }
    if (IN(0)) { p0_prep(args, F); }
    }
    SEAM(0);
    if (USE_XCD_BARRIER && IN(0) && IN(1)) xbar = xcd_barrier_post((unsigned*)(ws + WS_CTL) + CW_BAR, (volatile LAS unsigned*)(F.lds + LDS_MISC));
    for (int rep = 0; rep < NREP(1); ++rep) { if (rep) { if (USE_XCD_BARRIER) xcd_barrier(xbar); else grid.sync(); }
    if (IN(1)) {
        pg8::Gemm g{(const bf16_t*)(ws + WS_XB), (const bf16_t*)(ws + WS_WT), M, NPROJ, DM}; pg8::StaticOrder S; S.init(M, NPROJ, F.G, F.bx);
        pg8::EpiProj E{ws};
        pg8::gemm_phase<pg8::EpiProj, pg8::StaticOrder, true, true>((PG8_LAS unsigned char*)F.lds, g, S, E);
    }
    }
    SEAM(1);
    for (int rep = 0; rep < NREP(2); ++rep) { if (rep) { if (USE_XCD_BARRIER) xcd_barrier(xbar); else grid.sync(); }
    if (IN(2)) {
        for (int it = F.bx; it < 128; it += F.G) p2_compress_item(args, F, it);
        const int gw = ((F.bx + F.G - 128 % F.G) % F.G) * NWAVES + F.wave;
        for (int it = gw; it < 1024; it += F.G * NWAVES) p2_kmean_item(args, F, it);
    }
    }
    SEAM(2);
    const att::AP P{ws};
    if (IN(3)) {
        for (int it = F.bx; it < 1024; it += F.G) { const int own = it & 31, bh = it >> 5; if (own > 0) att::moba_select_item(P, F.lds, bh >> 3, bh & 7, own, F.wave, F.lane, F.tid); }
    }
    SEAM(3);
    for (int rep = 0; rep < NREP(4); ++rep) { if (rep) { if (USE_XCD_BARRIER) xcd_barrier(xbar); else grid.sync(); }
    if (IN(4)) {
        LAS unsigned* pre = (LAS unsigned*)(F.lds + 70656);
        LAS unsigned* qw = (LAS unsigned*)(F.lds + 66560);
        if (F.wave == 0) {
            const unsigned* cnt = P.CNT(); unsigned loc[16]; unsigned s = 0u;
#pragma unroll
            for (int k = 0; k < 16; ++k) { loc[k] = (cnt[16 * F.lane + k] + 255u) >> 8; s += loc[k]; }
            unsigned inc = s;
#pragma unroll
            for (int o = 1; o < 64; o <<= 1) { const unsigned v = __shfl_up(inc, o); if (F.lane >= o) inc += v; }
            unsigned run = inc - s;
#pragma unroll
            for (int k = 0; k < 16; ++k) { pre[16 * F.lane + k] = run; run += loc[k]; }
            if (F.lane == 63) pre[1024] = run;
        }
        __syncthreads();
        const unsigned ntot = pre[1024];
        unsigned* qctr = (unsigned*)(ws + WS_CTL) + 8 + rep;
        for (;;) {
            if (F.tid == 0) *qw = atomicAdd(qctr, 1u);
            __syncthreads();
            const unsigned n = *qw;
            __syncthreads();
            if (n >= ntot) break;
            int lo_ = 0, hi_ = 1024;
            while (hi_ - lo_ > 1) { const int mid = (lo_ + hi_) >> 1; if (pre[mid] <= n) lo_ = mid; else hi_ = mid; }
            att::moba_past_item(P, F.lds, lo_, (int)(n - pre[lo_]), F.wave, F.lane);
        }
    }
    }
    SEAM(4);
    for (int rep = 0; rep < NREP(5); ++rep) { if (rep) { if (USE_XCD_BARRIER) xcd_barrier(xbar); else grid.sync(); }
    if (IN(5)) {
        unsigned* qctr = (unsigned*)(ws + WS_CTL) + rep;
        LAS unsigned* qw = (LAS unsigned*)(F.lds + 66560);
        for (;;) {
            if (F.tid == 0) *qw = atomicAdd(qctr, 1u);
            __syncthreads();
            const unsigned n = *qw;
            __syncthreads();
            if (n >= 2048u) break;
            if (n < 1024u) { const int c = 127 - (int)(n >> 3), bg = (int)(n & 7); att::nsa_item(P, F.lds, bg >> 1, bg & 1, c, F.wave, F.lane); }
            else { const unsigned k = n - 1024u; const int own = 31 - (int)(k >> 5), bh = (int)(k & 31); att::moba_own_item(P, F.lds, bh >> 3, bh & 7, own, F.wave, F.lane); }
        }
    }
    }
    SEAM(5);
    for (int rep = 0; rep < NREP(6); ++rep) { if (rep) { if (USE_XCD_BARRIER) xcd_barrier(xbar); else grid.sync(); }
    if (IN(6)) {
        pg8::Gemm g{(const bf16_t*)(ws + WS_Y), (const bf16_t*)(ws + WS_WOT), M, DM, DM}; pg8::StaticOrder S; S.init(M, DM, F.G, F.bx);
        pg8::EpiOut E{args.in[0], args.out, 1.189207115002721f};
        pg8::gemm_phase<pg8::EpiOut, pg8::StaticOrder, true, true>((PG8_LAS unsigned char*)F.lds, g, S, E);
    }
    SEAM(6);
    if (IN(7)) p5_ln(args, F);
    }
#undef IN
#undef SEAM
}
#ifndef N_LAUNCHES
#define N_LAUNCHES 1
#endif
extern "C" void kernel_launch(void* const* d_in, const int* in_sizes, int n_in, void* d_out, int out_size, void* d_ws, size_t ws_size, hipStream_t stream) {
    static int grid = 0;
    if (grid == 0) {
        if (n_in != 13 || in_sizes[0] != M * DM || out_size != M * DM || ws_size < WS_END) { fprintf(stderr, "kernel_launch: unexpected shapes (n_in %d, in0 %d, out %d, ws %zu)\n", n_in, n_in > 0 ? in_sizes[0] : -1, out_size, ws_size); grid = -1; return; }
        int dev = 0, cus = 0, per_cu = 0;
        (void)hipGetDevice(&dev); (void)hipDeviceGetAttribute(&cus, hipDeviceAttributeMultiprocessorCount, dev);
        if (hipFuncSetAttribute((const void*)hymba_fwd, hipFuncAttributeMaxDynamicSharedMemorySize, LDS_BYTES) != hipSuccess) { fprintf(stderr, "kernel_launch: hipFuncSetAttribute failed\n"); grid = -1; return; }
        if (hipOccupancyMaxActiveBlocksPerMultiprocessor(&per_cu, (const void*)hymba_fwd, NTHREADS, LDS_BYTES) != hipSuccess || per_cu < 1) { fprintf(stderr, "kernel_launch: occupancy query failed (%d)\n", per_cu); (void)hipGetLastError(); per_cu = 1; }
        grid = cus * (per_cu < 1 ? 1 : 1);
    }
    if (grid < 0) return;
    Args a{};
    for (int i = 0; i < 13; ++i) a.in[i] = (const float*)d_in[i];
    a.out = (float*)d_out; a.ws = (unsigned char*)d_ws;
#if N_LAUNCHES == 1
    a.ph_lo = 0; a.ph_hi = 8;
    void* kargs[] = {&a};
    hipError_t e = hipLaunchCooperativeKernel((const void*)hymba_fwd, dim3(grid), dim3(NTHREADS), kargs, LDS_BYTES, stream);
    if (e != hipSuccess) fprintf(stderr, "cooperative launch failed: %s (grid %d)\n", hipGetErrorString(e), grid);
#else
    for (int p = 0; p < 8; ++p) { a.ph_lo = p; a.ph_hi = p + 1; hipLaunchKernelGGL(hymba_fwd, dim3(grid), dim3(NTHREADS), LDS_BYTES, stream, a); }
#endif
}
```

```cpp
#include <hip/hip_runtime.h>
#include <hip/hip_cooperative_groups.h>
#include <cstdio>
#include <cstdint>
namespace cg = cooperative_groups;
#define DI __device__ __forceinline__
namespace pg8 {
#define PG8_LAS __attribute__((address_space(3)))
typedef unsigned short bf16_t;
typedef short bf16x8 __attribute__((ext_vector_type(8)));
typedef float f32x4 __attribute__((ext_vector_type(4)));
typedef unsigned u32x4 __attribute__((ext_vector_type(4)));
constexpr int BM = 256, BK = 64, HALF = 128, HTB = HALF * BK * 2  , STAGE_BYTES = 8 * HTB, NXCD = 8, WGM = 8;

__host__ __device__ __forceinline__ int lds_byte(int r, int c) { const int st = (r >> 4) * 2 + (c >> 5), rr = r & 15, cc = c & 31, ob = rr * 64 + cc * 2; return st * 1024 + (ob ^ (((ob >> 9) & 1) << 5)); }
__host__ __device__ __forceinline__ void stage_rc(int b, int& R, int& C) { const int st = b / 1024, sb = b % 1024, swz = sb ^ (((sb >> 9) & 1) << 5); R = (st >> 1) * 16 + swz / 64; C = (st & 1) * 32 + (swz % 64) / 2; }
__host__ __device__ __forceinline__ int perm32(int rho) { const int n = rho >> 4, i = rho & 15; return 8 * (i >> 2) + 4 * n + (i & 3); }

struct Unit { int pm, pn; };
struct Gemm { const bf16_t* A; const bf16_t* Bt; int M, N, K; };

struct StaticOrder {
    int nM, nN, nwg, G, c;
    __host__ __device__ void init(int M, int N, int G_, int c_) { nM = M / BM; nN = N / BM; nwg = nM * nN; G = G_; c = c_; }
    __host__ __device__ bool next(int i, Unit& u) const {
        const long L = (long)i * G + c; if (L >= nwg) return false;
        int wgid = (int)L; { const int q = nwg / NXCD, r = nwg % NXCD, xcd = wgid % NXCD, off = wgid / NXCD; wgid = (xcd < r ? xcd * (q + 1) : r * (q + 1) + (xcd - r) * q) + off; }
        const int nig = WGM * nN, gid = wgid / nig, fm = gid * WGM, gsz = (nM - fm) < WGM ? (nM - fm) : WGM;
        u.pm = fm + ((wgid % nig) % gsz); u.pn = (wgid % nig) / gsz; return true;
    }
    __device__ __forceinline__ void a_ready(const Unit&) const {}
    __device__ __forceinline__ void done(const Unit&) const {}
};

typedef float f32x2_t __attribute__((ext_vector_type(2))); typedef __bf16 bf16x2_t __attribute__((ext_vector_type(2)));
DI unsigned cvtpk(float lo, float hi) { f32x2_t v = {lo, hi}; bf16x2_t b = __builtin_convertvector(v, bf16x2_t); return __builtin_bit_cast(unsigned, b); }
DI float silu_f(float v) { return v / (1.0f + __expf(-v)); }
DI float sigm_f(float v) { return 1.0f / (1.0f + __expf(-v)); }
constexpr int SEQ = 8192;
struct EpiProj {
    static constexpr bool PERM = true, AFTER_DRAIN = false;
    unsigned char* ws;
    DI void store8(bf16_t* dst, const float (&v)[8]) const { u32x4 w; w.x = cvtpk(v[0], v[1]); w.y = cvtpk(v[2], v[3]); w.z = cvtpk(v[4], v[5]); w.w = cvtpk(v[6], v[7]); *(u32x4*)dst = w; }
    DI void operator()(const f32x4 (&acc)[2][2][4][2], const Unit& u, int wr, int wc, int fr, int fq) const {
        const int pn = u.pn;
        bf16_t* const QN = (bf16_t*)(ws + (80ull << 20)); bf16_t* const QR = (bf16_t*)(ws + (112ull << 20)); bf16_t* const KC = (bf16_t*)(ws + (144ull << 20)); bf16_t* const VC = (bf16_t*)(ws + (152ull << 20));
        bf16_t* const KS = (bf16_t*)(ws + (160ull << 20)); bf16_t* const VS = (bf16_t*)(ws + (168ull << 20)); bf16_t* const KW = (bf16_t*)(ws + (176ull << 20)); bf16_t* const VW = (bf16_t*)(ws + (184ull << 20));
        bf16_t* const ZS = (bf16_t*)(ws + (192ull << 20)); bf16_t* const MQ = (bf16_t*)(ws + (256ull << 20)); bf16_t* const MK = (bf16_t*)(ws + (288ull << 20)); bf16_t* const MV = (bf16_t*)(ws + (320ull << 20));
        float* const GT = (float*)(ws + (352ull << 20)); const float* const ROPE = (const float*)(ws + (1ull << 20));
#pragma unroll
        for (int ai = 0; ai < 2; ++ai)
#pragma unroll
            for (int m = 0; m < 4; ++m) {
                const int row = u.pm * BM + ai * HALF + wr * 64 + m * 16 + fr; const int b = row >> 13, t = row & (SEQ - 1);
#pragma unroll
                for (int bj = 0; bj < 2; ++bj) {
                    const int col0 = bj * HALF + wc * 32 + 8 * fq; const int hd = col0 >> 6, d0 = col0 & 63;
                    float v[8];
#pragma unroll
                    for (int i = 0; i < 4; ++i) { v[i] = acc[ai][bj][m][0][i]; v[4 + i] = acc[ai][bj][m][1][i]; }
                    int kind = 0; bf16_t* dst = nullptr; bf16_t* dst2 = nullptr; float sc = 1.0f, sc2 = 1.0f;
                    if (pn <= 1)      { kind = 1; sc = 0.125f; sc2 = 1.4426950408889634f; const size_t o = ((size_t)(b * 8 + pn * 4 + hd) * SEQ + t) * 64 + d0; dst = QR + o; dst2 = QN + o; }
                    else if (pn == 2) { const size_t o = ((size_t)(b * 2 + (hd & 1)) * SEQ + t) * 64 + d0; dst = (hd < 2 ? KC : VC) + o; }
                    else if (pn == 3) { const size_t o = ((size_t)(b * 2 + (hd & 1)) * SEQ + t) * 64 + d0; dst = (hd < 2 ? KS : VS) + o; kind = hd < 2 ? 1 : 0; }
                    else if (pn == 4) { const size_t o = ((size_t)(b * 2 + (hd & 1)) * SEQ + t) * 64 + d0; dst = (hd < 2 ? KW : VW) + o; kind = hd < 2 ? 1 : 0; }
                    else if (pn <= 6) { kind = 2; dst = ZS + (size_t)row * 1024 + (pn - 5) * 256 + col0; }
                    else if (pn <= 8) { kind = 1; sc = 0.125f * 1.4426950408889634f; dst = MQ + ((size_t)(b * 8 + (pn - 7) * 4 + hd) * SEQ + t) * 64 + d0; }
                    else if (pn <= 10) { kind = 1; dst = MK + ((size_t)(b * 8 + (pn - 9) * 4 + hd) * SEQ + t) * 64 + d0; }
                    else if (pn <= 12) { dst = MV + ((size_t)(b * 8 + (pn - 11) * 4 + hd) * SEQ + t) * 64 + d0; }
                    else if (pn <= 14) { kind = 2; dst = ZS + (size_t)row * 1024 + 512 + (pn - 13) * 256 + col0; }
                    else kind = 3;
                    if (kind == 3) {
                        if (col0 < 24) {
#pragma unroll
                            for (int i = 0; i < 8; ++i) v[i] = sigm_f(v[i]);
                            float* gp = GT + (size_t)row * 32 + col0; *(f32x4*)gp = (f32x4){v[0], v[1], v[2], v[3]}; *(f32x4*)(gp + 4) = (f32x4){v[4], v[5], v[6], v[7]};
                        }
                        continue;
                    }
                    if (kind == 2) {
#pragma unroll
                        for (int i = 0; i < 8; ++i) v[i] = silu_f(v[i]);
                        store8(dst, v); continue;
                    }
                    if (sc != 1.0f) {
#pragma unroll
                        for (int i = 0; i < 8; ++i) v[i] *= sc;
                    }
                    if (kind == 1) {
                        if (dst2) { store8(dst2, v);
#pragma unroll
                            for (int i = 0; i < 8; ++i) v[i] *= sc2; }
                        if ((wc & 1) == 0) {
                            float pr[8];
#pragma unroll
                            for (int i = 0; i < 8; ++i) pr[i] = __shfl_xor(v[i], 16);
                            if (fq < 2) {
                                const f32x4 c0 = *(const f32x4*)(ROPE + (size_t)t * 16), c1 = *(const f32x4*)(ROPE + (size_t)t * 16 + 4), s0 = *(const f32x4*)(ROPE + (size_t)t * 16 + 8), s1 = *(const f32x4*)(ROPE + (size_t)t * 16 + 12);
                                const float sg = fq == 0 ? -1.0f : 1.0f;
#pragma unroll
                                for (int i = 0; i < 4; ++i) { v[i] = v[i] * c0[i] + sg * pr[i] * s0[i]; v[4 + i] = v[4 + i] * c1[i] + sg * pr[4 + i] * s1[i]; }
                            }
                        }
                    }
                    store8(dst, v);
                }
            }
    }
};
struct EpiOut {
    static constexpr bool PERM = false, AFTER_DRAIN = false;
    const float* Xin; float* O; float alpha;
    DI void operator()(const f32x4 (&acc)[2][2][4][2], const Unit& u, int wr, int wc, int fr, int fq) const {
#pragma unroll
        for (int ai = 0; ai < 2; ++ai)
#pragma unroll
            for (int m = 0; m < 4; ++m) {
                const size_t row = (size_t)(u.pm * BM + ai * HALF + wr * 64 + m * 16 + fr);
#pragma unroll
                for (int bj = 0; bj < 2; ++bj)
#pragma unroll
                    for (int n = 0; n < 2; ++n) { const size_t off = row * 1024 + u.pn * BM + bj * HALF + wc * 32 + n * 16 + 4 * fq; const f32x4 xv = *(const f32x4*)(Xin + off); *(f32x4*)(O + off) = xv * alpha + acc[ai][bj][m][n]; }
            }
    }
};
template <class Epi, class Sched, bool ALIGN_EPI = false, bool SP2 = false>
__device__ __forceinline__ void gemm_phase(PG8_LAS unsigned char* lds, const Gemm g, const Sched& S, const Epi& E) {
    const int tid = threadIdx.x, wid = __builtin_amdgcn_readfirstlane(tid >> 6), lane = tid & 63, wr = wid >> 2, wc = wid & 3, fr = lane & 15, fq = lane >> 4;
    const int K = g.K, nt = K / BK;
    unsigned voffA[2], voffB[2];
#pragma unroll
    for (int i = 0; i < 2; ++i) { int R, C; stage_rc(tid * 16 + i * 8192, R, C); const int Rb = Epi::PERM ? ((R & ~31) + perm32(R & 31)) : R;
        voffA[i] = (unsigned)(R * K + C) * 2u; voffB[i] = (unsigned)(Rb * K + C) * 2u; }
    const size_t kstep = (size_t)(BK * 2);
    const size_t hstep = (size_t)HALF * K * 2;
    const size_t tstep = 2 * hstep;
    const unsigned ldsw = (unsigned)wid * 1024u;
    const int aoff = lds_byte(wr * 64 + fr, fq * 8), boff = lds_byte(wc * 32 + fr, fq * 8);
#define PG8_SA(b, h) (((b) * 2 + (h)) * HTB)
#define PG8_SB(b, h) ((4 + (b) * 2 + (h)) * HTB)
#define PG8_STAGE(bufoff, gbase, voff) do { _Pragma("unroll") for (int _i = 0; _i < 2; ++_i) \
        __builtin_amdgcn_global_load_lds((const unsigned*)((const char*)(gbase) + (voff)[_i]), (PG8_LAS unsigned*)(lds + (bufoff) + ldsw + _i * 8192), 16, 0, 0); } while (0)
#define PG8_LDA(dst, b, h) do { _Pragma("unroll") for (int m = 0; m < 4; ++m) _Pragma("unroll") for (int k = 0; k < 2; ++k) dst[m][k] = *(const PG8_LAS bf16x8*)(lds + PG8_SA(b, h) + aoff + m * 2048 + k * 1024); } while (0)
#define PG8_LDB(dst, b, h) do { _Pragma("unroll") for (int n = 0; n < 2; ++n) _Pragma("unroll") for (int k = 0; k < 2; ++k) dst[n][k] = *(const PG8_LAS bf16x8*)(lds + PG8_SB(b, h) + boff + n * 2048 + k * 1024); } while (0)
#define PG8_MMA(ai, bj, At, Bt) do { __builtin_amdgcn_s_setprio(1); _Pragma("unroll") for (int m = 0; m < 4; ++m) _Pragma("unroll") for (int n = 0; n < 2; ++n) _Pragma("unroll") for (int k = 0; k < 2; ++k) \
        acc[ai][bj][m][n] = __builtin_amdgcn_mfma_f32_16x16x32_bf16(Bt[n][k], At[m][k], acc[ai][bj][m][n], 0, 0, 0); __builtin_amdgcn_s_setprio(0); } while (0)
#define PG8_WAIT_V(n) asm volatile("s_waitcnt vmcnt(" #n ")" ::: "memory")
#define PG8_WAIT_L(n) asm volatile("s_waitcnt lgkmcnt(" #n ")" ::: "memory")
#define PG8_BAR __builtin_amdgcn_s_barrier()
#define PG8_SCHED __builtin_amdgcn_sched_barrier(0)
    Unit cur, nxt; int ui = 0;
    if (!S.next(0, cur)) return;
    f32x4 acc[2][2][4][2];
#pragma unroll
    for (int a = 0; a < 2; ++a)
#pragma unroll
        for (int b = 0; b < 2; ++b)
#pragma unroll
            for (int m = 0; m < 4; ++m)
#pragma unroll
                for (int n = 0; n < 2; ++n) acc[a][b][m][n] = (f32x4){0.f, 0.f, 0.f, 0.f};
    bf16x8 At[4][2], B0[2][2], B1[2][2];
    const char* cA = (const char*)g.A + (size_t)cur.pm * tstep; const char* cB = (const char*)g.Bt + (size_t)cur.pn * tstep;
    S.a_ready(cur);
    if constexpr (SP2) {
        PG8_STAGE(PG8_SB(0, 0), cB, voffB); PG8_STAGE(PG8_SB(0, 1), cB + hstep, voffB); PG8_STAGE(PG8_SA(0, 0), cA, voffA); PG8_STAGE(PG8_SA(0, 1), cA + hstep, voffA);
        if (wr == 1) PG8_BAR;
        PG8_WAIT_V(2); PG8_BAR;
        PG8_STAGE(PG8_SB(1, 0), cB + kstep, voffB); PG8_STAGE(PG8_SA(1, 0), cA + kstep, voffA); PG8_STAGE(PG8_SB(1, 1), cB + hstep + kstep, voffB);
        PG8_WAIT_V(6); PG8_BAR;
    } else {
        PG8_STAGE(PG8_SB(0, 0), cB, voffB); PG8_STAGE(PG8_SA(0, 0), cA, voffA); PG8_STAGE(PG8_SB(0, 1), cB + hstep, voffB); PG8_STAGE(PG8_SA(0, 1), cA + hstep, voffA);
        if (wr == 1) PG8_BAR;
        PG8_WAIT_V(4); PG8_BAR;
        PG8_STAGE(PG8_SB(1, 0), cB + kstep, voffB); PG8_STAGE(PG8_SA(1, 0), cA + kstep, voffA); PG8_STAGE(PG8_SB(1, 1), cB + hstep + kstep, voffB);
        PG8_WAIT_V(6); PG8_BAR;
    }
    for (;;) {
        const bool has_next = S.next(ui + 1, nxt);
        const char* nA = has_next ? (const char*)g.A + (size_t)nxt.pm * tstep : cA; const char* nB = has_next ? (const char*)g.Bt + (size_t)nxt.pn * tstep : cB;
        for (int t = 0; t < nt; t += 2) {
            const bool last = (t == nt - 2);
            const char* a1 = cA + (size_t)(t + 1) * kstep;
            const char* a2 = last ? nA : cA + (size_t)(t + 2) * kstep; const char* b2 = last ? nB : cB + (size_t)(t + 2) * kstep;
            const char* a3 = a2 + kstep; const char* b3 = b2 + kstep;
            if (last && has_next) S.a_ready(nxt);
            if constexpr (SP2) {
            PG8_LDB(B0, 0, 0); PG8_LDB(B1, 0, 1); PG8_SCHED; PG8_LDA(At, 0, 0); PG8_STAGE(PG8_SA(1, 1), a1 + hstep, voffA);
            PG8_WAIT_V(8); PG8_WAIT_L(0); PG8_BAR; PG8_MMA(0, 0, At, B0); PG8_MMA(0, 1, At, B1); PG8_BAR; PG8_SCHED;
            PG8_LDA(At, 0, 1); PG8_STAGE(PG8_SB(0, 0), b2, voffB); PG8_STAGE(PG8_SB(0, 1), b2 + hstep, voffB); PG8_STAGE(PG8_SA(0, 0), a2, voffA);
            PG8_WAIT_V(8); PG8_WAIT_L(0); PG8_BAR; PG8_MMA(1, 0, At, B0); PG8_MMA(1, 1, At, B1); PG8_BAR; PG8_SCHED;
            PG8_LDB(B0, 1, 0); PG8_LDB(B1, 1, 1); PG8_SCHED; PG8_LDA(At, 1, 0); PG8_STAGE(PG8_SA(0, 1), a2 + hstep, voffA);
            PG8_WAIT_V(8); PG8_WAIT_L(0); PG8_BAR; PG8_MMA(0, 0, At, B0); PG8_MMA(0, 1, At, B1); PG8_BAR; PG8_SCHED;
            PG8_LDA(At, 1, 1); PG8_STAGE(PG8_SB(1, 0), b3, voffB); PG8_STAGE(PG8_SB(1, 1), b3 + hstep, voffB); PG8_STAGE(PG8_SA(1, 0), a3, voffA);
            PG8_WAIT_V(8); PG8_WAIT_L(0); PG8_BAR; PG8_MMA(1, 0, At, B0); PG8_MMA(1, 1, At, B1); PG8_BAR; PG8_SCHED;
            } else {
            PG8_LDB(B0, 0, 0); PG8_SCHED; PG8_LDA(At, 0, 0); PG8_STAGE(PG8_SA(1, 1), a1 + hstep, voffA);
            PG8_WAIT_L(8); PG8_BAR; PG8_WAIT_L(0); PG8_MMA(0, 0, At, B0); PG8_BAR; PG8_SCHED;
            PG8_LDB(B1, 0, 1); PG8_STAGE(PG8_SB(0, 0), b2, voffB);
            PG8_BAR; PG8_WAIT_L(0); PG8_MMA(0, 1, At, B1); PG8_BAR;
            PG8_LDA(At, 0, 1); PG8_STAGE(PG8_SA(0, 0), a2, voffA);
            PG8_BAR; PG8_WAIT_L(0); PG8_MMA(1, 0, At, B0); PG8_BAR; PG8_SCHED;
            PG8_STAGE(PG8_SB(0, 1), b2 + hstep, voffB);
            PG8_WAIT_V(6); PG8_BAR; PG8_MMA(1, 1, At, B1); PG8_BAR;
            PG8_LDB(B0, 1, 0); PG8_SCHED; PG8_LDA(At, 1, 0); PG8_STAGE(PG8_SA(0, 1), a2 + hstep, voffA);
            PG8_WAIT_L(8); PG8_BAR; PG8_WAIT_L(0); PG8_MMA(0, 0, At, B0); PG8_BAR; PG8_SCHED;
            PG8_LDB(B1, 1, 1); PG8_STAGE(PG8_SB(1, 0), b3, voffB);
            PG8_BAR; PG8_WAIT_L(0); PG8_MMA(0, 1, At, B1); PG8_BAR;
            PG8_LDA(At, 1, 1); PG8_STAGE(PG8_SA(1, 0), a3, voffA);
            PG8_BAR; PG8_WAIT_L(0); PG8_MMA(1, 0, At, B0); PG8_BAR; PG8_SCHED;
            PG8_STAGE(PG8_SB(1, 1), b3 + hstep, voffB);
            PG8_WAIT_V(6); PG8_BAR; PG8_MMA(1, 1, At, B1); PG8_BAR;
            }
        }
        if constexpr (ALIGN_EPI) { if (wr == 0) PG8_BAR; }
        if constexpr (!Epi::AFTER_DRAIN) { E(acc, cur, wr, wc, fr, fq); S.done(cur); }
        if (!has_next) break;
#pragma unroll
        for (int a = 0; a < 2; ++a)
#pragma unroll
            for (int b = 0; b < 2; ++b)
#pragma unroll
                for (int m = 0; m < 4; ++m)
#pragma unroll
                    for (int n = 0; n < 2; ++n) acc[a][b][m][n] = (f32x4){0.f, 0.f, 0.f, 0.f};
        cur = nxt; cA = nA; cB = nB; ++ui;
        if constexpr (ALIGN_EPI) { if (wr == 1) PG8_BAR; }
    }
    PG8_WAIT_V(0);
    if constexpr (!ALIGN_EPI) { if (wr == 0) PG8_BAR; }
    PG8_BAR;
    if constexpr (Epi::AFTER_DRAIN) { E.fused(acc, cur, wr, wc, fr, fq, lds, wid, lane); S.done(cur); }
#undef PG8_SA
#undef PG8_SB
#undef PG8_STAGE
#undef PG8_LDA
#undef PG8_LDB
#undef PG8_MMA
#undef PG8_WAIT_V
#undef PG8_WAIT_L
#undef PG8_BAR
#undef PG8_SCHED
}
}

namespace att {
using pg8::bf16_t; using pg8::bf16x8; using pg8::u32x4; using pg8::f32x4;
typedef float f32x16 __attribute__((ext_vector_type(16)));
typedef short s16x4 __attribute__((ext_vector_type(4)));
typedef short v4i16_t __attribute__((ext_vector_type(4)));
typedef unsigned u32x2 __attribute__((ext_vector_type(2)));
#define LAS __attribute__((address_space(3)))
typedef LAS char* lptr; typedef const LAS char* lcptr;
constexpr float L2E = 1.4426950408889634f;
constexpr float NEG_INIT = -1e30f;
constexpr int SEQ = 8192;
#define MFMA32(a, b, c) __builtin_amdgcn_mfma_f32_32x32x16_bf16((a), (b), (c), 0, 0, 0)
DI int crow(int r, int hi) { return (r & 3) + 8 * (r >> 2) + 4 * hi; }
DI s16x4 vtr(lcptr p) { return __builtin_bit_cast(s16x4, __builtin_amdgcn_ds_read_tr16_b64_v4i16((LAS v4i16_t*)p)); }
DI float xhalf(float v) { return __shfl_xor(v, 32); }
DI void stage_load(const bf16_t* Kt, const bf16_t* Vt, int wid, int lane, u32x4& kr, u32x4& vr, bool needV) {
    kr = *(const u32x4*)(Kt + lane * 64 + wid * 8);
    if (needV) vr = *(const u32x4*)(Vt + (16 * (wid & 3) + (lane >> 2)) * 64 + (wid >> 2) * 32 + (lane & 3) * 8);
}
DI void stage_write(lptr slot, int wid, int lane, const u32x4& kr, const u32x4& vr, bool needV) {
    *(LAS u32x4*)(slot + wid * 1024 + lane * 16) = kr;
    if (needV) *(LAS u32x4*)(slot + 8192 + wid * 1024 + lane * 16) = vr;
}
DI void qk_tile(f32x16& p0, f32x16& p1, lcptr Ks, const bf16x8 (&qr)[4], int r32, int hi) {
    lcptr kb = Ks + hi * 1024 + r32 * 16;
    f32x16 z;
#pragma unroll
    for (int i = 0; i < 16; ++i) z[i] = 0.f;
    p0 = z; p1 = z;
#pragma unroll
    for (int d0 = 0; d0 < 4; ++d0) {
        const bf16x8 b0 = *(const LAS bf16x8*)(kb + d0 * 2048), b1 = *(const LAS bf16x8*)(kb + d0 * 2048 + 512);
        p0 = MFMA32(b0, qr[d0], p0); p1 = MFMA32(b1, qr[d0], p1);
    }
}
DI bf16x8 pack8(const f32x16& p, int base) {
    u32x4 w; w.x = pg8::cvtpk(p[base], p[base + 1]); w.y = pg8::cvtpk(p[base + 2], p[base + 3]); w.z = pg8::cvtpk(p[base + 4], p[base + 5]); w.w = pg8::cvtpk(p[base + 6], p[base + 7]);
    return __builtin_bit_cast(bf16x8, w);
}
DI void pv_tile(f32x16 (&o)[2], lcptr Vs, const f32x16& p0, const f32x16& p1, int lane, int hi) {
    lcptr vb = Vs + ((lane >> 4) & 1) * 32 + (lane & 3) * 8 + (4 * hi + ((lane & 15) >> 2)) * 64;
    bf16x8 pf[4]; pf[0] = pack8(p0, 0); pf[1] = pack8(p0, 8); pf[2] = pack8(p1, 0); pf[3] = pack8(p1, 8);
#pragma unroll
    for (int dh = 0; dh < 2; ++dh)
#pragma unroll
        for (int ks = 0; ks < 4; ++ks) {
            const s16x4 lo = vtr(vb + dh * 4096 + ks * 1024), hh = vtr(vb + dh * 4096 + ks * 1024 + 512);
            const bf16x8 vf = (bf16x8){lo[0], lo[1], lo[2], lo[3], hh[0], hh[1], hh[2], hh[3]};
            o[dh] = MFMA32(vf, pf[ks], o[dh]);
        }
}
DI float mask_scale(f32x16& p0, f32x16& p1, int klo, int khi, int hi) {
    const bool full = (klo <= 0) && (khi >= 63), none = (khi < klo) || (khi < 0) || (klo > 63);
    float mx;
    if (__all(full || none)) {
        const float bias = full ? 0.f : -INFINITY;
        float a = fmaxf(p0[0], p1[0]);
#pragma unroll
        for (int r = 1; r < 16; ++r) a = fmaxf(a, fmaxf(p0[r], p1[r]));
#pragma unroll
        for (int r = 0; r < 16; ++r) { p0[r] = p0[r] * L2E + bias; p1[r] = p1[r] * L2E + bias; }
        mx = a * L2E + bias;
    } else {
        const int lo2 = klo - 4 * hi, hi2 = khi - 4 * hi;
        float a = -INFINITY;
#pragma unroll
        for (int r = 0; r < 16; ++r) { const int kc = (r & 3) + 8 * (r >> 2);
            p0[r] = (kc >= lo2 && kc <= hi2) ? p0[r] * L2E : -INFINITY; p1[r] = (kc + 32 >= lo2 && kc + 32 <= hi2) ? p1[r] * L2E : -INFINITY; a = fmaxf(a, fmaxf(p0[r], p1[r])); }
        mx = a;
    }
    return fmaxf(mx, xhalf(mx));
}
DI void tile_online(lcptr slot, const bf16x8 (&qr)[4], int klo, int khi, float& m, float& l, f32x16 (&o)[2], int lane, int r32, int hi) {
    { const bool none = (khi < klo) || (khi < 0) || (klo > 63); if (__all(none)) return; }
    f32x16 p0, p1; qk_tile(p0, p1, slot, qr, r32, hi);
    const float mt = mask_scale(p0, p1, klo, khi, hi);
    const float mn = fmaxf(m, mt), alpha = __builtin_amdgcn_exp2f(m - mn); m = mn;
    float s = 0.f;
#pragma unroll
    for (int r = 0; r < 16; ++r) { p0[r] = __builtin_amdgcn_exp2f(p0[r] - mn); p1[r] = __builtin_amdgcn_exp2f(p1[r] - mn); s += p0[r] + p1[r]; }
    l = l * alpha + s;
#pragma unroll
    for (int r = 0; r < 16; ++r) { o[0][r] *= alpha; o[1][r] *= alpha; }
    pv_tile(o, slot + 8192, p0, p1, lane, hi);
}
constexpr float THR = 4.0f;
DI float max3f(float a, float b, float c) { return __builtin_fmaxf(__builtin_fmaxf(a, b), c); }
DI void tile_online2(lcptr slot, const bf16x8 (&qr)[4], int klo, int khi, float& mneg, bool& has, float& l, f32x16 (&o)[2], int lane, int r32, int hi) {
    const bool full = (klo <= 0) && (khi >= 63), none = (khi < klo) || (khi < 0) || (klo > 63);
    if (__all(none)) return;
    f32x16 p0, p1;
    { const float cinit = none ? -INFINITY : mneg;
#pragma unroll
      for (int r = 0; r < 16; ++r) { p0[r] = cinit; p1[r] = cinit; }
      lcptr kb = slot + hi * 1024 + r32 * 16;
#pragma unroll
      for (int d0 = 0; d0 < 4; ++d0) {
          const bf16x8 b0 = *(const LAS bf16x8*)(kb + d0 * 2048), b1 = *(const LAS bf16x8*)(kb + d0 * 2048 + 512);
          p0 = MFMA32(b0, qr[d0], p0); p1 = MFMA32(b1, qr[d0], p1);
      } }
    if (!__all(full || none)) {
        const int lo2 = klo - 4 * hi, hi2 = khi - 4 * hi;
#pragma unroll
        for (int r = 0; r < 16; ++r) { const int kc = (r & 3) + 8 * (r >> 2);
            p0[r] = (kc >= lo2 && kc <= hi2) ? p0[r] : -INFINITY; p1[r] = (kc + 32 >= lo2 && kc + 32 <= hi2) ? p1[r] : -INFINITY; }
    }
    float rm;
    { float a = max3f(p0[0], p0[1], p1[0]), b = max3f(p0[2], p0[3], p1[1]); a = max3f(a, p1[2], p1[3]);
#pragma unroll
      for (int r = 4; r < 16; r += 4) { a = max3f(a, p0[r], p0[r + 1]); b = max3f(b, p0[r + 2], p0[r + 3]); a = max3f(a, p1[r], p1[r + 1]); b = max3f(b, p1[r + 2], p1[r + 3]); }
      rm = fmaxf(a, b); rm = fmaxf(rm, xhalf(rm)); }
    const bool trig = has ? (rm > THR) : (rm > -INFINITY);
    if (__any(trig)) {
        const float dl = trig ? rm : 0.f;
        const float f = has ? __builtin_amdgcn_exp2f(-dl) : 1.0f;
        mneg -= dl; has = has || trig;
#pragma unroll
        for (int r = 0; r < 16; ++r) { p0[r] -= dl; p1[r] -= dl; }
        l *= f;
#pragma unroll
        for (int r = 0; r < 16; ++r) { o[0][r] *= f; o[1][r] *= f; }
    }
    float s0 = 0.f, s1 = 0.f;
#pragma unroll
    for (int r = 0; r < 16; ++r) { p0[r] = __builtin_amdgcn_exp2f(p0[r]); p1[r] = __builtin_amdgcn_exp2f(p1[r]); s0 += p0[r]; s1 += p1[r]; }
    l += s0 + s1;
    pv_tile(o, slot + 8192, p0, p1, lane, hi);
}
DI void tile_stats(lcptr slot, const bf16x8 (&qr)[4], int klo, int khi, float& m, float& l, int r32, int hi) {
    f32x16 p0, p1; qk_tile(p0, p1, slot, qr, r32, hi);
    const float mt = mask_scale(p0, p1, klo, khi, hi);
    const float mn = fmaxf(m, mt), alpha = __builtin_amdgcn_exp2f(m - mn); m = mn;
    float s = 0.f;
#pragma unroll
    for (int r = 0; r < 16; ++r) s += __builtin_amdgcn_exp2f(p0[r] - mn) + __builtin_amdgcn_exp2f(p1[r] - mn);
    l = l * alpha + s;
}
DI void tile_final(lcptr slot, const bf16x8 (&qr)[4], int klo, int khi, float m, float inv, f32x16 (&o)[2], float& carry, LAS float* imp_row  , bool writer, int lane, int r32, int hi) {
    f32x16 p0, p1; qk_tile(p0, p1, slot, qr, r32, hi);
    (void)mask_scale(p0, p1, klo, khi, hi);
#pragma unroll
    for (int r = 0; r < 16; ++r) { p0[r] = __builtin_amdgcn_exp2f(p0[r] - m) * inv; p1[r] = __builtin_amdgcn_exp2f(p1[r] - m) * inv; }
    float y3[8];
#pragma unroll
    for (int x = 0; x < 4; ++x) { y3[x] = xhalf(p0[4 * x + 3]); y3[4 + x] = xhalf(p1[4 * x + 3]); }
#pragma unroll
    for (int x = 0; x < 8; ++x) {
        const float bs = (x < 4) ? (p0[4 * x] + p0[4 * x + 1]) + (p0[4 * x + 2] + p0[4 * x + 3]) : (p1[4 * (x - 4)] + p1[4 * (x - 4) + 1]) + (p1[4 * (x - 4) + 2] + p1[4 * (x - 4) + 3]);
        const float prev = (x == 0) ? carry : y3[x == 0 ? 0 : x - 1];
        float v = bs + (hi ? y3[x] : prev);
        v += __shfl_xor(v, 1); v += __shfl_xor(v, 2);
        if (writer) imp_row[2 * x + hi] = v;
    }
    carry = y3[7];
    pv_tile(o, slot + 8192, p0, p1, lane, hi);
}
struct AP {
    unsigned char* ws;
#define AP_PTR(name, T_, off) DI T_* name() const { return (T_*)(ws + (off)); }
    AP_PTR(QN, const bf16_t, 80ull << 20) AP_PTR(QR, const bf16_t, 112ull << 20) AP_PTR(KCC, const bf16_t, (2ull << 20) + 256 * 1024) AP_PTR(VCC, const bf16_t, (2ull << 20) + 768 * 1024)
    AP_PTR(KS, const bf16_t, 160ull << 20) AP_PTR(VS, const bf16_t, 168ull << 20) AP_PTR(KW, const bf16_t, 176ull << 20) AP_PTR(VW, const bf16_t, 184ull << 20)
    AP_PTR(ZS, const bf16_t, 192ull << 20) AP_PTR(MQ, const bf16_t, 256ull << 20) AP_PTR(MK, const bf16_t, 288ull << 20) AP_PTR(MV, const bf16_t, 320ull << 20)
    AP_PTR(GT, const float, 352ull << 20) AP_PTR(KM, const float, 2ull << 20) AP_PTR(Y, bf16_t, 16ull << 20)
    AP_PTR(CNT, unsigned, 32768) AP_PTR(LIST, unsigned, 356ull << 20) AP_PTR(PO, bf16_t, 388ull << 20) AP_PTR(PML, float, 484ull << 20)
#undef AP_PTR
};
#define TILE_LOOP(NT, KPTR_EXPR, VPTR_EXPR, NEEDV, BOUNDS_STMT, COMPUTE_STMT) \
  { u32x4 kr_ = {0u, 0u, 0u, 0u}, vr_ = {0u, 0u, 0u, 0u}; \
    { const int i = 0; (void)i; stage_load(KPTR_EXPR, VPTR_EXPR, wid, lane, kr_, vr_, NEEDV); } \
    stage_write(lds, wid, lane, kr_, vr_, NEEDV); __syncthreads(); \
    const int nt_ = (NT); \
    for (int i_ = 0; i_ < nt_; ++i_) { \
      const bool more_ = i_ + 1 < nt_; \
      if (more_) { const int i = i_ + 1; (void)i; stage_load(KPTR_EXPR, VPTR_EXPR, wid, lane, kr_, vr_, NEEDV); } \
      { const int i = i_; (void)i; lcptr slot = lds + (i_ & 1) * 16384; int klo, khi; BOUNDS_STMT; COMPUTE_STMT; } \
      if (more_) stage_write(lds + ((i_ + 1) & 1) * 16384, wid, lane, kr_, vr_, NEEDV); \
      __syncthreads(); } }
DI void zero2(f32x16 (&o)[2]) {
#pragma unroll
    for (int r = 0; r < 16; ++r) { o[0][r] = 0.f; o[1][r] = 0.f; }
}
DI void load_q(bf16x8 (&qr)[4], const bf16_t* qrow, int hi) {
#pragma unroll
    for (int d0 = 0; d0 < 4; ++d0) qr[d0] = *(const bf16x8*)(qrow + 16 * d0 + 8 * hi);
}
DI float bf_lo(unsigned w) { return __uint_as_float(w << 16); }
DI float bf_hi(unsigned w) { return __uint_as_float(w & 0xffff0000u); }
DI void write_y(const f32x16 (&o)[2], float scale, const bf16_t* zrow, bf16_t* yrow, int hi) {
#pragma unroll
    for (int dh = 0; dh < 2; ++dh)
#pragma unroll
        for (int gq = 0; gq < 4; ++gq) {
            const int d = 32 * dh + 8 * gq + 4 * hi;
            const u32x2 z = *(const u32x2*)(zrow + d);
            u32x2 w; w.x = pg8::cvtpk(o[dh][4 * gq] * scale * bf_lo(z.x), o[dh][4 * gq + 1] * scale * bf_hi(z.x)); w.y = pg8::cvtpk(o[dh][4 * gq + 2] * scale * bf_lo(z.y), o[dh][4 * gq + 3] * scale * bf_hi(z.y));
            *(u32x2*)(yrow + d) = w;
        }
}
DI void nsa_item(const AP& P, lptr lds, int b, int g, int c, int wid, int lane) {
    const int r32 = lane & 31, hi = lane >> 5, qi = r32 >> 2, hh = r32 & 3, H = 4 * g + hh;
    const int tq = 64 * c + 8 * wid + qi;
    const size_t qoff = ((size_t)(b * 8 + H) * SEQ + tq) * 64;
    const size_t row = (size_t)b * SEQ + tq;
    bf16x8 qr[4]; load_q(qr, P.QN() + qoff, hi);
    const float* gp = P.GT() + row * 32 + H * 3; const float g0 = gp[0], g1 = gp[1], g2 = gp[2];
    f32x16 o[2];
    LAS float* otl = (LAS float*)(lds + 69632) + (wid * 64 + lane);
    const int ntok = (4 * c + 3) < 511 ? (4 * c + 3) : 511, ntc = (ntok + 63) >> 6;
    const bf16_t* kcc = P.KCC() + (size_t)(b * 2 + g) * 512 * 64; const bf16_t* vcc = P.VCC() + (size_t)(b * 2 + g) * 512 * 64;
    int khi_abs = (tq - 31) >> 4; khi_abs = khi_abs < 510 ? khi_abs : 510;
    float m = NEG_INIT, l = 0.f;
    TILE_LOOP(ntc, kcc + i * 4096, vcc + i * 4096, false, { klo = -64 * i; khi = khi_abs - 64 * i; }, tile_stats(slot, qr, klo, khi, m, l, r32, hi));
    l += xhalf(l);
    { const float inv = l > 0.f ? 1.0f / l : 0.f; float carry = 0.f; zero2(o);
      LAS float* imp = (LAS float*)(lds + 32768) + (8 * wid + qi) * 128;
      TILE_LOOP(ntc, kcc + i * 4096, vcc + i * 4096, true, { klo = -64 * i; khi = khi_abs - 64 * i; }, tile_final(slot, qr, klo, khi, m, inv, o, carry, imp + 16 * i, hh == 0, lane, r32, hi));
#pragma unroll
      for (int r = 0; r < 16; ++r) { otl[r * 512] = g0 * o[0][r]; otl[(16 + r) * 512] = g0 * o[1][r]; } }
    LAS unsigned* selb = (LAS unsigned*)(lds + 65536);
    for (int q2 = 0; q2 < 8; ++q2) {
        unsigned long long s0, s1;
        if (c <= 15) { s0 = (2ull << c) - 1ull; s1 = 0ull; }
        else {
            const LAS float* ir = (const LAS float*)(lds + 32768) + (8 * wid + q2) * 128;
            const float v0 = ir[lane], v1 = ir[64 + lane];
            const int nc2 = c - 2;
            const unsigned k0 = (lane >= 1 && lane <= nc2) ? __float_as_uint(v0) + 1u : 0u, k1 = (lane + 64 <= nc2) ? __float_as_uint(v1) + 1u : 0u;
            unsigned lo = 1u, hb = 0x7f800002u; unsigned long long m0 = 0ull, m1 = 0ull; bool exact = false;
            while (hb - lo > 1u) {
                const unsigned mid = lo + ((hb - lo) >> 1);
                m0 = __ballot(k0 >= mid); m1 = __ballot(k1 >= mid);
                const int cnt = __popcll(m0) + __popcll(m1);
                if (cnt == 13) { exact = true; break; }
                if (cnt > 13) lo = mid; else hb = mid;
            }
            if (!exact) {
                const unsigned long long gg0 = __ballot(k0 > lo), gg1 = __ballot(k1 > lo), e0 = __ballot(k0 == lo), e1 = __ballot(k1 == lo);
                const int need = 13 - __popcll(gg0) - __popcll(gg1);
                const unsigned long long lt = (1ull << lane) - 1ull;
                const int r0 = __popcll(e0 & lt), r1 = __popcll(e0) + __popcll(e1 & lt);
                m0 = gg0 | __ballot(k0 == lo && r0 < need); m1 = gg1 | __ballot(k1 == lo && r1 < need);
            }
            s0 = m0 | 1ull; s1 = m1;
            if (c - 1 < 64) s0 |= 1ull << (c - 1); else s1 |= 1ull << (c - 65);
            if (c < 64) s0 |= 1ull << c; else s1 |= 1ull << (c - 64);
        }
        if (lane == 0) { LAS unsigned* sp = selb + (8 * wid + q2) * 4; sp[0] = (unsigned)s0; sp[1] = (unsigned)(s0 >> 32); sp[2] = (unsigned)s1; sp[3] = (unsigned)(s1 >> 32); }
    }
    const unsigned sb0 = selb[(8 * wid + qi) * 4 + 0], sb1 = selb[(8 * wid + qi) * 4 + 1], sb2 = selb[(8 * wid + qi) * 4 + 2], sb3 = selb[(8 * wid + qi) * 4 + 3];
    load_q(qr, P.QR() + qoff, hi);
    const bf16_t* ks = P.KS() + (size_t)(b * 2 + g) * SEQ * 64; const bf16_t* vs = P.VS() + (size_t)(b * 2 + g) * SEQ * 64;
    float mneg = 0.f; bool has = false; l = 0.f; zero2(o);
    TILE_LOOP(c + 1, ks + (size_t)i * 4096, vs + (size_t)i * 4096, true,
              { klo = 0; const unsigned w = i < 32 ? sb0 : i < 64 ? sb1 : i < 96 ? sb2 : sb3; khi = (i == c) ? (tq - 64 * c) : (((w >> (i & 31)) & 1u) ? 63 : -1); },
              tile_online2(slot, qr, klo, khi, mneg, has, l, o, lane, r32, hi));
    l += xhalf(l);
    { const float f = l > 0.f ? g1 / l : 0.f;
#pragma unroll
      for (int r = 0; r < 16; ++r) { otl[r * 512] += f * o[0][r]; otl[(16 + r) * 512] += f * o[1][r]; } }
    const bf16_t* kw = P.KW() + (size_t)(b * 2 + g) * SEQ * 64; const bf16_t* vw = P.VW() + (size_t)(b * 2 + g) * SEQ * 64;
    const int j0 = c > 8 ? c - 8 : 0;
    mneg = 0.f; has = false; l = 0.f; zero2(o);
    TILE_LOOP(c - j0 + 1, kw + (size_t)(j0 + i) * 4096, vw + (size_t)(j0 + i) * 4096, true,
              { const int base = 64 * (j0 + i); klo = tq - 511 - base; khi = tq - base; },
              tile_online2(slot, qr, klo, khi, mneg, has, l, o, lane, r32, hi));
    l += xhalf(l);
    { const float f = l > 0.f ? g2 / l : 0.f;
#pragma unroll
      for (int r = 0; r < 16; ++r) { o[0][r] = otl[r * 512] + f * o[0][r]; o[1][r] = otl[(16 + r) * 512] + f * o[1][r]; } }
    write_y(o, 1.0f, P.ZS() + row * 1024 + H * 64, P.Y() + row * 1024 + H * 64, hi);
}
constexpr int LCAP = 8192;
DI void moba_select_item(const AP& P, lptr lds, int b, int h, int own, int wid, int lane, int tid) {
    const int r32 = lane & 31, hi = lane >> 5;
    const int tq = 256 * own + 32 * wid + r32, bh = b * 8 + h;
    unsigned bits = 0u;
    if (own <= 3) bits = (1u << own) - 1u;
    else {
        bf16x8 qr[4]; load_q(qr, P.MQ() + ((size_t)bh * SEQ + tq) * 64, hi);
        { const int j = tid >> 4, d4 = (tid & 15) * 4;
          const f32x4 km = *(const f32x4*)(P.KM() + ((size_t)bh * 32 + j) * 64 + d4);
          const unsigned h01 = pg8::cvtpk(km[0], km[1]), h23 = pg8::cvtpk(km[2], km[3]);
          const unsigned l01 = pg8::cvtpk(km[0] - bf_lo(h01), km[1] - bf_hi(h01)), l23 = pg8::cvtpk(km[2] - bf_lo(h23), km[3] - bf_hi(h23));
          const int off = (d4 >> 3) * 1024 + j * 16 + (d4 & 7) * 2;
          *(LAS u32x2*)(lds + off) = (u32x2){h01, h23}; *(LAS u32x2*)(lds + 16384 + off) = (u32x2){l01, l23}; }
        __syncthreads();
        f32x16 sg;
#pragma unroll
        for (int r = 0; r < 16; ++r) sg[r] = 0.f;
        { lcptr kb = lds + hi * 1024 + r32 * 16;
#pragma unroll
          for (int d0 = 0; d0 < 4; ++d0) { const bf16x8 a = *(const LAS bf16x8*)(kb + d0 * 2048), a2 = *(const LAS bf16x8*)(kb + 16384 + d0 * 2048); sg = MFMA32(a, qr[d0], sg); sg = MFMA32(a2, qr[d0], sg); } }
#pragma unroll
        for (int r = 0; r < 16; ++r) if (crow(r, hi) >= own) sg[r] = -INFINITY;
#pragma unroll
        for (int rd = 0; rd < 3; ++rd) {
            float best = sg[0]; int bj = crow(0, hi);
#pragma unroll
            for (int r = 1; r < 16; ++r) if (sg[r] > best) { best = sg[r]; bj = crow(r, hi); }
            const float ob = xhalf(best); const int oj = __shfl_xor(bj, 32);
            if (ob > best || (ob == best && oj < bj)) { best = ob; bj = oj; }
            if (best > -INFINITY) bits |= 1u << bj;
#pragma unroll
            for (int r = 0; r < 16; ++r) if (crow(r, hi) == bj) sg[r] = -INFINITY;
        }
        __syncthreads();
    }
    unsigned* cnt = P.CNT() + bh * 32; unsigned* list = P.LIST() + (size_t)bh * 32 * LCAP;
    LAS unsigned* wcnt = (LAS unsigned*)(lds + 32768);
    LAS unsigned* gbase = (LAS unsigned*)(lds + 32768 + 1024);
    for (int j = 0; j < own; ++j) {
        const unsigned long long mask = __ballot((hi == 0) && ((bits >> j) & 1u));
        if (lane == 0) wcnt[wid * 32 + j] = (unsigned)__popcll(mask);
    }
    __syncthreads();
    if (tid < own) {
        unsigned run = 0u;
#pragma unroll
        for (int w = 0; w < 8; ++w) { const unsigned c = wcnt[w * 32 + tid]; wcnt[w * 32 + tid] = run; run += c; }
        gbase[tid] = run ? atomicAdd(cnt + tid, run) : 0u;
    }
    __syncthreads();
    for (int j = 0; j < own; ++j) {
        const bool sel = (hi == 0) && ((bits >> j) & 1u);
        const unsigned long long mask = __ballot(sel);
        if (sel) list[(size_t)j * LCAP + gbase[j] + wcnt[wid * 32 + j] + __popcll(mask & ((1ull << lane) - 1ull))] = ((unsigned)tq << 2) | (unsigned)__popc(bits & ((1u << j) - 1u));
    }
    __syncthreads();
}
DI void moba_past_item(const AP& P, lptr lds, int bhj, int g, int wid, int lane) {
    const int r32 = lane & 31, hi = lane >> 5, bh = bhj >> 5, j = bhj & 31;
    const unsigned cnt = P.CNT()[bhj], idx = 256u * g + 32u * wid + r32;
    const bool valid = idx < cnt;
    const unsigned e = P.LIST()[(size_t)bhj * LCAP + (valid ? idx : 256u * g)];
    const int tq = (int)(e >> 2), slot = (int)(e & 3u);
    bf16x8 qr[4]; load_q(qr, P.MQ() + ((size_t)bh * SEQ + tq) * 64, hi);
    const bf16_t* mk = P.MK() + ((size_t)bh * SEQ + 256 * j) * 64; const bf16_t* mv = P.MV() + ((size_t)bh * SEQ + 256 * j) * 64;
    float mneg = 0.f, l = 0.f; bool has = false; f32x16 o[2]; zero2(o);
    TILE_LOOP(4, mk + (size_t)i * 4096, mv + (size_t)i * 4096, true, { klo = 0; khi = valid ? 63 : -1; }, tile_online2(slot, qr, klo, khi, mneg, has, l, o, lane, r32, hi));
    l += xhalf(l);
    if (valid) {
        const size_t prow = ((size_t)bh * SEQ + tq) * 3 + slot;
        bf16_t* po = P.PO() + prow * 64;
#pragma unroll
        for (int dh = 0; dh < 2; ++dh)
#pragma unroll
            for (int gq = 0; gq < 4; ++gq) { u32x2 w; w.x = pg8::cvtpk(o[dh][4 * gq], o[dh][4 * gq + 1]); w.y = pg8::cvtpk(o[dh][4 * gq + 2], o[dh][4 * gq + 3]); *(u32x2*)(po + 32 * dh + 8 * gq + 4 * hi) = w; }
        if (hi == 0) { float* pm = (float*)P.PML() + prow * 2; pm[0] = -mneg; pm[1] = l; }
    }
}
DI void moba_own_item(const AP& P, lptr lds, int b, int h, int own, int wid, int lane) {
    const int r32 = lane & 31, hi = lane >> 5;
    const int tq = 256 * own + 32 * wid + r32, bh = b * 8 + h;
    const size_t hb = (size_t)bh * SEQ * 64;
    const size_t row = (size_t)b * SEQ + tq;
    bf16x8 qr[4]; load_q(qr, P.MQ() + hb + (size_t)tq * 64, hi);
    float mneg = 0.f, l = 0.f; bool has = false; f32x16 o[2]; zero2(o);
    const int np = own < 3 ? own : 3;
    if (np > 0) {
        const size_t prow = ((size_t)bh * SEQ + tq) * 3;
        const float* pm = P.PML() + prow * 2;
        float mm[3], ll[3];
#pragma unroll
        for (int s = 0; s < 3; ++s) { mm[s] = s < np ? pm[2 * s] : -INFINITY; ll[s] = s < np ? pm[2 * s + 1] : 0.f; }
        const float mx = fmaxf(fmaxf(mm[0], mm[1]), mm[2]);
        mneg = -mx; has = true;
#pragma unroll
        for (int s = 0; s < 3; ++s) if (s < np) {
            const float w = __builtin_amdgcn_exp2f(mm[s] - mx);
            if (hi == 0) l += ll[s] * w;
            const bf16_t* po = P.PO() + (prow + s) * 64;
#pragma unroll
            for (int dh = 0; dh < 2; ++dh)
#pragma unroll
                for (int gq = 0; gq < 4; ++gq) { const u32x2 z = *(const u32x2*)(po + 32 * dh + 8 * gq + 4 * hi);
                    o[dh][4 * gq] += w * bf_lo(z.x); o[dh][4 * gq + 1] += w * bf_hi(z.x); o[dh][4 * gq + 2] += w * bf_lo(z.y); o[dh][4 * gq + 3] += w * bf_hi(z.y); }
        }
    }
    const bf16_t* mk = P.MK() + hb + (size_t)own * 256 * 64; const bf16_t* mv = P.MV() + hb + (size_t)own * 256 * 64;
    TILE_LOOP(4, mk + (size_t)i * 4096, mv + (size_t)i * 4096, true, { klo = 0; khi = 32 * wid + r32 - 64 * i; }, tile_online2(slot, qr, klo, khi, mneg, has, l, o, lane, r32, hi));
    l += xhalf(l);
    write_y(o, l > 0.f ? 1.0f / l : 0.f, P.ZS() + row * 1024 + 512 + h * 64, P.Y() + row * 1024 + 512 + h * 64, hi);
}
}
using att::lptr; using att::lcptr;
using pg8::bf16_t; using pg8::bf16x8; using pg8::u32x4; using pg8::f32x4;
constexpr int NWAVES = 8, NTHREADS = 512;
constexpr int BATCH = 4, T = 8192, DM = 1024, M = BATCH * T;
constexpr int NPROJ = 4096;
constexpr float LN_EPS = 1e-5f;
constexpr size_t MiB = 1u << 20;
constexpr size_t WS_CTL = 0;
constexpr size_t WS_ROPE = 1 * MiB;
constexpr size_t WS_B1P = WS_ROPE + 512 * 1024;
constexpr size_t WS_KM = 2 * MiB;
constexpr size_t WS_KCC = WS_KM + 256 * 1024;
constexpr size_t WS_VCC = WS_KCC + 512 * 1024;
constexpr size_t WS_W2T = WS_VCC + 512 * 1024;
constexpr size_t WS_W1T = 4 * MiB;
constexpr size_t WS_WOT = 6 * MiB;
constexpr size_t WS_WT = 8 * MiB;
constexpr size_t WS_XB = 16 * MiB;
constexpr size_t WS_Y = WS_XB;
constexpr size_t WS_QN = 80 * MiB, WS_QR = 112 * MiB;
constexpr size_t WS_KC = 144 * MiB, WS_VC = 152 * MiB, WS_KS = 160 * MiB, WS_VS = 168 * MiB, WS_KW = 176 * MiB, WS_VW = 184 * MiB;
constexpr size_t WS_ZS = 192 * MiB;
constexpr size_t WS_MQ = 256 * MiB, WS_MK = 288 * MiB, WS_MV = 320 * MiB;
constexpr size_t WS_GT = 352 * MiB;
constexpr size_t WS_LIST = 356 * MiB;
constexpr size_t WS_PO = 388 * MiB;
constexpr size_t WS_PML = 484 * MiB;
constexpr size_t WS_END = 490 * MiB;
constexpr int CW_CNT = 8192;
constexpr int LDS_BYTES = 136192;
constexpr int LDS_MISC = 135168;
constexpr int CW_BAR = 1024; static_assert(1024 + 3456 <= 8192, "barrier words below the list counters");

static_assert(WS_QN == (80ull << 20) && WS_QR == (112ull << 20) && WS_KCC == (2ull << 20) + 256 * 1024 && WS_VCC == (2ull << 20) + 768 * 1024 && WS_KS == (160ull << 20) && WS_VS == (168ull << 20) && WS_KW == (176ull << 20) && WS_VW == (184ull << 20) && WS_ZS == (192ull << 20) && WS_MQ == (256ull << 20) && WS_MK == (288ull << 20) && WS_MV == (320ull << 20) && WS_GT == (352ull << 20) && WS_KM == (2ull << 20) && WS_Y == (16ull << 20) && WS_KC == (144ull << 20) && WS_VC == (152ull << 20) && WS_ROPE == (1ull << 20) && WS_CTL + CW_CNT * 4 == 32768 && WS_LIST == (356ull << 20) && WS_PO == (388ull << 20) && WS_PML == (484ull << 20), "AP / EpiProj offsets");
struct Args { const float* in[13]; float* out; unsigned char* ws; int ph_lo, ph_hi, rep, pad; };

DI unsigned pk2(float lo, float hi) { return pg8::cvtpk(lo, hi); }
template <class Map> DI void transpose_item(const float* W, int ldw, Map srccol, bf16_t* WT, int K, LAS float* scr, int kb, int nb, int lane) {
    const int k0 = 64 * kb, n0 = 32 * nb; const int sc = srccol(n0 + (lane & 31));
#pragma unroll 8
    for (int i = 0; i < 32; ++i) { const int kk = 2 * i + (lane >> 5); scr[kk * 33 + (lane & 31)] = sc >= 0 ? W[(size_t)(k0 + kk) * ldw + sc] : 0.f; }
    asm volatile("s_waitcnt lgkmcnt(0)" ::: "memory");
    const int c = lane & 7;
#pragma unroll
    for (int j = 0; j < 4; ++j) { const int n = (lane >> 3) + 8 * j; const LAS float* s = scr + (8 * c) * 33 + n;
        u32x4 o; o.x = pk2(s[0 * 33], s[1 * 33]); o.y = pk2(s[2 * 33], s[3 * 33]); o.z = pk2(s[4 * 33], s[5 * 33]); o.w = pk2(s[6 * 33], s[7 * 33]);
        *(u32x4*)(WT + (size_t)(n0 + n) * K + k0 + 8 * c) = o; }
    asm volatile("s_waitcnt lgkmcnt(0)" ::: "memory");
}
struct MapIdent { DI int operator()(int n) const { return n; } };
struct MapProj { DI int operator()(int n) const { return n < 1280 ? n : n < 3840 ? n + 24 : n < 3864 ? n - 2560 : -1; } };
DI float wave_sum(float v) {
#pragma unroll
    for (int o = 1; o < 64; o <<= 1) v += __shfl_xor(v, o);
    return v;
}
DI void sincos_d(double a, double& s, double& c) {
    const double q = __builtin_rint(a * 0.63661977236758134308);
    double r = __builtin_fma(-q, 1.57079632679489655800e+00, a); r = __builtin_fma(-q, 6.12323399573676603587e-17, r);
    const double r2 = r * r;
    double ps = -1.0 / 1307674368000.0; ps = ps * r2 + 1.0 / 6227020800.0; ps = ps * r2 - 1.0 / 39916800.0; ps = ps * r2 + 1.0 / 362880.0; ps = ps * r2 - 1.0 / 5040.0; ps = ps * r2 + 1.0 / 120.0; ps = ps * r2 - 1.0 / 6.0; ps = ps * r2 * r + r;
    double pc = 1.0 / 20922789888000.0; pc = pc * r2 - 1.0 / 87178291200.0; pc = pc * r2 + 1.0 / 479001600.0; pc = pc * r2 - 1.0 / 3628800.0; pc = pc * r2 + 1.0 / 40320.0; pc = pc * r2 - 1.0 / 720.0; pc = pc * r2 + 1.0 / 24.0; pc = pc * r2 - 0.5; pc = pc * r2 + 1.0;
    const int qi = (int)((long long)q & 3);
    s = (qi == 0) ? ps : (qi == 1) ? pc : (qi == 2) ? -ps : -pc;
    c = (qi == 0) ? pc : (qi == 1) ? -ps : (qi == 2) ? -pc : ps;
}
#define XB_TMO      128
#define XB_XCNT(j)  (256  + 64 * (j))
#define XB_XSUB(j)  (1280 + 64 * (j))
#define XB_XGEN(j)  (2304 + 64 * (j))
#define XB_TOP      3328
#define XB_TOPGEN   3392
#define XCD_BAR_WORDS 3456
#define XB_SPIN_CAP (1u << 18)

__device__ __forceinline__ unsigned xb_ld(unsigned* p)              { return __hip_atomic_load(p, __ATOMIC_RELAXED, __HIP_MEMORY_SCOPE_AGENT); }
__device__ __forceinline__ unsigned xb_add(unsigned* p, unsigned v) { return __hip_atomic_fetch_add(p, v, __ATOMIC_RELAXED, __HIP_MEMORY_SCOPE_AGENT); }
__device__ __forceinline__ unsigned xb_xcc_id() { return (unsigned)__builtin_amdgcn_s_getreg((3 << 11) | 20) & 0xFu; }
#define XB_SPIN(cond, bar) do { unsigned _sp = 0; while (cond) { __builtin_amdgcn_s_sleep(1); \
    if ((++_sp & 255u) == 0u) { if (xb_ld(&(bar)[XB_TMO])) break; if (_sp > XB_SPIN_CAP) { atomicAdd(&(bar)[XB_TMO], 1u); break; } } } } while (0)

struct XcdBarrier {
    unsigned* bar; unsigned x;
    volatile LAS unsigned* st;
};

__device__ __forceinline__ XcdBarrier xcd_barrier_post(unsigned* bar, volatile LAS unsigned* st) {
    XcdBarrier b; b.bar = bar; b.x = xb_xcc_id(); b.st = st;
    if (threadIdx.x == 0) (void)xb_add(&bar[XB_XCNT(b.x)], 1u);
    return b;
}
__device__ __forceinline__ void xcd_barrier_complete(unsigned* bar, unsigned x, unsigned& nloc, unsigned& nx) {
    const unsigned G = gridDim.x * gridDim.y * gridDim.z;
    unsigned sum, cnt, mine, sp = 0u;
    for (;;) {
        sum = 0u; cnt = 0u; mine = 0u;
#pragma unroll
        for (unsigned j = 0; j < 16; ++j) { const unsigned c = xb_ld(&bar[XB_XCNT(j)]); sum += c; cnt += (c > 0u) ? 1u : 0u; mine = (j == x) ? c : mine; }
        if (sum == G) break;
        __builtin_amdgcn_s_sleep(1);
        if ((++sp & 255u) == 0u) { if (xb_ld(&bar[XB_TMO])) break; if (sp > XB_SPIN_CAP) { atomicAdd(&bar[XB_TMO], 1u); break; } }
    }
    nloc = mine > 0u ? mine : 1u; nx = cnt > 0u ? cnt : 1u;
}

__device__ __forceinline__ void xcd_barrier(const XcdBarrier& b) {
    asm volatile("s_waitcnt vmcnt(0)" ::: "memory");
    __syncthreads();
    if (threadIdx.x == 0) {
        unsigned* bar = b.bar;
        __builtin_amdgcn_s_waitcnt(0);
        unsigned nloc = b.st[0], nx = b.st[1];
        if (nloc == 0u) { xcd_barrier_complete(bar, b.x, nloc, nx); b.st[0] = nloc; b.st[1] = nx; }
        const unsigned old = xb_add(&bar[XB_XSUB(b.x)], 1u);
        const unsigned gen = old / nloc;
        if (old + 1u == (gen + 1u) * nloc) {
            __builtin_amdgcn_fence(__ATOMIC_RELEASE, "agent");
            asm volatile("s_waitcnt vmcnt(0)" ::: "memory");
            const unsigned og = xb_add(&bar[XB_TOP], 1u);
            const unsigned tg = og / nx;
            if (og + 1u == (tg + 1u) * nx) xb_add(&bar[XB_TOPGEN], 1u);
            else XB_SPIN(xb_ld(&bar[XB_TOPGEN]) == tg, bar);
            __builtin_amdgcn_fence(__ATOMIC_ACQUIRE, "agent");
            xb_add(&bar[XB_XGEN(b.x)], 1u);
            asm volatile("s_waitcnt vmcnt(0)" ::: "memory");
        } else {
            XB_SPIN(xb_ld(&bar[XB_XGEN(b.x)]) == gen, bar);
            __builtin_amdgcn_fence(__ATOMIC_ACQUIRE, "agent");
            asm volatile("s_waitcnt vmcnt(0)" ::: "memory");
        }
    }
    __syncthreads();
}

struct Frame { lptr lds; int tid, lane, wave, G, bx; };

DI void p0_prep(const Args& a, const Frame& F) {
    unsigned char* ws = a.ws;
    LAS float* scr = (LAS float*)(F.lds + F.wave * 16384);
    const int gw = F.bx * NWAVES + F.wave, NGW = F.G * NWAVES;
    if (F.bx == 0) { for (int i = F.tid; i < CW_CNT + 1024; i += NTHREADS) ((unsigned*)(ws + WS_CTL))[i] = 0u; }
    constexpr int I0 = 16 * 128, I1 = 16 * 32, I2 = 32 * 8, I3 = 4 * 2, I4 = 128;
    constexpr int NITEMS = I0 + I1 + 2 * I2 + 2 * I3 + I4;
    for (int it = gw; it < NITEMS; it += NGW) {
        int r = it;
        if (r < I0) { transpose_item(a.in[1], 3864, MapProj(), (bf16_t*)(ws + WS_WT), 1024, scr, r / 128, r % 128, F.lane); continue; } r -= I0;
        if (r < I1) { transpose_item(a.in[10], 1024, MapIdent(), (bf16_t*)(ws + WS_WOT), 1024, scr, r / 32, r % 32, F.lane); continue; } r -= I1;
        if (r < 2 * I2) { const int kv = r / I2; r %= I2; transpose_item(a.in[kv ? 7 : 3], 256, MapIdent(), (bf16_t*)(ws + WS_W1T) + (size_t)kv * 256 * 2048, 2048, scr, r / 8, r % 8, F.lane); continue; } r -= 2 * I2;
        if (r < 2 * I3) { const int kv = r / I3; r %= I3; transpose_item(a.in[kv ? 9 : 5], 64, MapIdent(), (bf16_t*)(ws + WS_W2T) + (size_t)kv * 64 * 256, 256, scr, r / 2, r % 2, F.lane); continue; } r -= 2 * I3;
        {
            float* pp = (float*)(ws + WS_B1P) + (size_t)r * 512;
#pragma unroll
            for (int e = 0; e < 8; ++e) { const int idx = e * 64 + F.lane, kv = idx >> 8, n = idx & 255; const float* pos = a.in[kv ? 6 : 2]; const float* w1 = a.in[kv ? 7 : 3];
                float s = 0.f;
#pragma unroll
                for (int k = 0; k < 16; ++k) s += pos[16 * r + k] * w1[(size_t)(16 * r + k) * 256 + n];
                pp[idx] = s; }
        }
    }
    { const f32x4* x4 = (const f32x4*)a.in[0]; u32x4* xb = (u32x4*)(ws + WS_XB); const size_t n8 = (size_t)M * DM / 8, stride = (size_t)F.G * NTHREADS;
      for (size_t i = (size_t)F.bx * NTHREADS + F.tid; i < n8; i += stride) { const f32x4 v0 = x4[2 * i], v1 = x4[2 * i + 1]; u32x4 o; o.x = pk2(v0[0], v0[1]); o.y = pk2(v0[2], v0[3]); o.z = pk2(v1[0], v1[1]); o.w = pk2(v1[2], v1[3]); xb[i] = o; } }
    { float* rp = (float*)(ws + WS_ROPE);
      for (int i = F.bx * NTHREADS + F.tid; i < T * 8; i += F.G * NTHREADS) { const int t = i >> 3, f = i & 7;
          const float invf = f == 0 ? 1.0f : f == 1 ? 0.19392274f : f == 2 ? 0.03760603f : f == 3 ? 0.0072926646f : f == 4 ? 0.0014142136f : f == 5 ? 0.0002742482f : f == 6 ? 5.318296e-05f : 1.0313386e-05f;
          const float ang = (float)t * invf; double s, c; sincos_d((double)ang, s, c);
          rp[t * 16 + f] = (float)c; rp[t * 16 + 8 + f] = (float)s; } }
}
DI void p2_compress_item(const Args& a, const Frame& F, int item) {
    unsigned char* ws = a.ws;
    const int kv = item >> 7, bg = (item >> 4) & 7, ib = item & 15;
    const bf16_t* src = (const bf16_t*)(ws + (kv ? WS_VC : WS_KC)) + (size_t)bg * T * 64;
    const bf16_t* w1t = (const bf16_t*)(ws + WS_W1T) + (size_t)kv * 256 * 2048;
    const bf16_t* w2t = (const bf16_t*)(ws + WS_W2T) + (size_t)kv * 64 * 256;
    bf16_t* dst = (bf16_t*)(ws + (kv ? WS_VCC : WS_KCC)) + (size_t)bg * 512 * 64;
    LAS float* b1p = (LAS float*)(F.lds);
    LAS float* red = (LAS float*)(F.lds + 1024);
    LAS bf16_t* Hs = (LAS bf16_t*)(F.lds + 4096);
    const int lane = F.lane, wid = F.wave, r32 = lane & 31, hi = lane >> 5;
    { const int n = F.tid & 255, half = F.tid >> 8; const float* pp = (const float*)(ws + WS_B1P) + kv * 256 + n; float s = 0.f;
#pragma unroll 16
      for (int j = 0; j < 64; ++j) s += pp[(size_t)(half * 64 + j) * 512];
      red[half * 256 + n] = s; }
    att::f32x16 acc0;
#pragma unroll
    for (int r = 0; r < 16; ++r) acc0[r] = 0.f;
    { int i0 = 32 * ib + r32; i0 = i0 < 510 ? i0 : 510;
      const bf16_t* a0p = src + (size_t)i0 * 16 * 64 + 8 * hi; const bf16_t* bp = w1t + (size_t)(32 * wid + r32) * 2048 + 8 * hi;
      for (int s0 = 0; s0 < 128; s0 += 8) {
          bf16x8 fa[8], fb[8];
#pragma unroll
          for (int u = 0; u < 8; ++u) { fa[u] = *(const bf16x8*)(a0p + 16 * (s0 + u)); fb[u] = *(const bf16x8*)(bp + 16 * (s0 + u)); }
#pragma unroll
          for (int u = 0; u < 8; ++u) acc0 = MFMA32(fa[u], fb[u], acc0);
      } }
    __syncthreads();
    if (F.tid < 256) b1p[F.tid] = red[F.tid] + red[256 + F.tid] + a.in[kv ? 8 : 4][F.tid];
    __syncthreads();
    { const int n = 32 * wid + r32; const float bb = b1p[n];
#pragma unroll
      for (int r = 0; r < 16; ++r) { const int i = att::crow(r, hi); Hs[i * 264 + n] = (bf16_t)(pg8::cvtpk(pg8::silu_f(acc0[r] + bb), 0.f) & 0xffffu); } }
    __syncthreads();
    if (wid < 2) {
        const int ct = wid; att::f32x16 acc2;
#pragma unroll
        for (int r = 0; r < 16; ++r) acc2[r] = 0.f;
#pragma unroll
        for (int s = 0; s < 16; ++s) { const bf16x8 fa = *(const LAS bf16x8*)(Hs + r32 * 264 + 16 * s + 8 * hi), fb = *(const bf16x8*)(w2t + (size_t)(32 * ct + r32) * 256 + 16 * s + 8 * hi);
            acc2 = MFMA32(fa, fb, acc2); }
#pragma unroll
        for (int r = 0; r < 16; ++r) { const int i = 32 * ib + att::crow(r, hi); dst[(size_t)i * 64 + 32 * ct + r32] = (bf16_t)(pg8::cvtpk(acc2[r], 0.f) & 0xffffu); }
    }
    __syncthreads();
}
DI void p2_kmean_item(const Args& a, const Frame& F, int item) {
    const bf16_t* mk = (const bf16_t*)(a.ws + WS_MK) + (size_t)item * 256 * 64;
    const int c = F.lane & 7, rg = F.lane >> 3; float s[8];
#pragma unroll
    for (int i = 0; i < 8; ++i) s[i] = 0.f;
#pragma unroll 4
    for (int p = 0; p < 32; ++p) { const u32x4 v = *(const u32x4*)(mk + (size_t)(8 * p + rg) * 64 + 8 * c);
        s[0] += att::bf_lo(v.x); s[1] += att::bf_hi(v.x); s[2] += att::bf_lo(v.y); s[3] += att::bf_hi(v.y); s[4] += att::bf_lo(v.z); s[5] += att::bf_hi(v.z); s[6] += att::bf_lo(v.w); s[7] += att::bf_hi(v.w); }
#pragma unroll
    for (int i = 0; i < 8; ++i) { s[i] += __shfl_xor(s[i], 8); s[i] += __shfl_xor(s[i], 16); s[i] += __shfl_xor(s[i], 32); }
    if (rg == 0) { float* o = (float*)(a.ws + WS_KM) + (size_t)item * 64 + 8 * c;
        *(f32x4*)o = (f32x4){s[0], s[1], s[2], s[3]} * (1.0f / 256.0f); *(f32x4*)(o + 4) = (f32x4){s[4], s[5], s[6], s[7]} * (1.0f / 256.0f); }
}
DI void p5_ln(const Args& a, const Frame& F) {
    const int gw = F.bx * NWAVES + F.wave, NGW = F.G * NWAVES;
    const f32x4* gn = (const f32x4*)a.in[11] + F.lane; const f32x4* bs = (const f32x4*)a.in[12] + F.lane;
    for (int r = gw; r < M; r += NGW) {
        f32x4* xr = (f32x4*)(a.out + (size_t)r * DM) + F.lane; f32x4 v[4]; float s = 0.f;
#pragma unroll
        for (int j = 0; j < 4; ++j) { v[j] = xr[64 * j]; s += (v[j][0] + v[j][1]) + (v[j][2] + v[j][3]); }
        const float mean = wave_sum(s) * (1.0f / DM); float s2 = 0.f;
#pragma unroll
        for (int j = 0; j < 4; ++j) { v[j] = v[j] - mean; s2 += (v[j][0] * v[j][0] + v[j][1] * v[j][1]) + (v[j][2] * v[j][2] + v[j][3] * v[j][3]); }
        const float rstd = 1.0f / sqrtf(wave_sum(s2) * (1.0f / DM) + LN_EPS);
#pragma unroll
        for (int j = 0; j < 4; ++j) xr[64 * j] = v[j] * rstd * gn[64 * j] + bs[64 * j];
    }
}
__global__ void __launch_bounds__(NTHREADS, 2) hymba_fwd(Args args) {
    extern __shared__ __attribute__((aligned(16))) unsigned char lds_raw[];
    cg::grid_group grid = cg::this_grid();
    Frame F; F.lds = (lptr)lds_raw; F.tid = threadIdx.x; F.lane = F.tid & 63; F.wave = __builtin_amdgcn_readfirstlane(F.tid >> 6); F.G = gridDim.x; F.bx = blockIdx.x;
    unsigned char* ws = args.ws;
    const int lo = args.ph_lo, hi = args.ph_hi;
    if (F.tid < 2) ((LAS unsigned*)(F.lds + LDS_MISC))[F.tid] = 0u;
    __syncthreads();
    XcdBarrier xbar; xbar.bar = nullptr; xbar.x = 0; xbar.st = nullptr;
#define IN(k) (lo <= (k) && (k) < hi)
#define SEAM(k) do { if (IN(k) && IN((k) + 1)) { if ((k) == 0 || !USE_XCD_BARRIER) grid.sync(); else xcd_barrier(xbar); } } while (0)
#ifndef USE_XCD_BARRIER
#define USE_XCD_BARRIER 1
#endif
#ifndef REPEAT_MASK
#define REPEAT_MASK 0
#endif
#define NREP(k) (((REPEAT_MASK) >> (k)) & 1 ? 2 : 1)
    for (int rep = 0; rep < NREP(0); ++rep) { if (rep) { if (USE_XCD_BARRIER) xcd_barrier(xbar); else grid.sync(); }
    if (IN(0)) { p0_prep(args, F); }
    }
    SEAM(0);
    if (USE_XCD_BARRIER && IN(0) && IN(1)) xbar = xcd_barrier_post((unsigned*)(ws + WS_CTL) + CW_BAR, (volatile LAS unsigned*)(F.lds + LDS_MISC));
    for (int rep = 0; rep < NREP(1); ++rep) { if (rep) { if (USE_XCD_BARRIER) xcd_barrier(xbar); else grid.sync(); }
    if (IN(1)) {
        pg8::Gemm g{(const bf16_t*)(ws + WS_XB), (const bf16_t*)(ws + WS_WT), M, NPROJ, DM}; pg8::StaticOrder S; S.init(M, NPROJ, F.G, F.bx);
        pg8::EpiProj E{ws};
        pg8::gemm_phase<pg8::EpiProj, pg8::StaticOrder, true, true>((PG8_LAS unsigned char*)F.lds, g, S, E);
    }
    }
    SEAM(1);
    for (int rep = 0; rep < NREP(2); ++rep) { if (rep) { if (USE_XCD_BARRIER) xcd_barrier(xbar); else grid.sync(); }
    if (IN(2)) {
        for (int it = F.bx * NWAVES + F.wave; it < 1024; it += F.G * NWAVES) p2_kmean_item(args, F, it);
        for (int it = F.bx; it < 256; it += F.G) p2_compress_item(args, F, it);
    }
    }
    SEAM(2);
    const att::AP P{ws};
    if (IN(3)) {
        for (int it = F.bx; it < 1024; it += F.G) { const int own = it & 31, bh = it >> 5; if (own > 0) att::moba_select_item(P, F.lds, bh >> 3, bh & 7, own, F.wave, F.lane, F.tid); }
    }
    SEAM(3);
    for (int rep = 0; rep < NREP(4); ++rep) { if (rep) { if (USE_XCD_BARRIER) xcd_barrier(xbar); else grid.sync(); }
    if (IN(4)) {
        LAS unsigned* pre = (LAS unsigned*)(F.lds + 70656);
        LAS unsigned* qw = (LAS unsigned*)(F.lds + 66560);
        if (F.wave == 0) {
            const unsigned* cnt = P.CNT(); unsigned loc[16]; unsigned s = 0u;
#pragma unroll
            for (int k = 0; k < 16; ++k) { loc[k] = (cnt[16 * F.lane + k] + 255u) >> 8; s += loc[k]; }
            unsigned inc = s;
#pragma unroll
            for (int o = 1; o < 64; o <<= 1) { const unsigned v = __shfl_up(inc, o); if (F.lane >= o) inc += v; }
            unsigned run = inc - s;
#pragma unroll
            for (int k = 0; k < 16; ++k) { pre[16 * F.lane + k] = run; run += loc[k]; }
            if (F.lane == 63) pre[1024] = run;
        }
        __syncthreads();
        const unsigned ntot = pre[1024];
        unsigned* qctr = (unsigned*)(ws + WS_CTL) + 8 + rep + args.rep;
        for (;;) {
            if (F.tid == 0) *qw = atomicAdd(qctr, 1u);
            __syncthreads();
            const unsigned n = *qw;
            __syncthreads();
            if (n >= ntot) break;
            int lo_ = 0, hi_ = 1024;
            while (hi_ - lo_ > 1) { const int mid = (lo_ + hi_) >> 1; if (pre[mid] <= n) lo_ = mid; else hi_ = mid; }
            att::moba_past_item(P, F.lds, lo_, (int)(n - pre[lo_]), F.wave, F.lane);
        }
    }
    }
    SEAM(4);
    for (int rep = 0; rep < NREP(5); ++rep) { if (rep) { if (USE_XCD_BARRIER) xcd_barrier(xbar); else grid.sync(); }
    if (IN(5)) {
        unsigned* qctr = (unsigned*)(ws + WS_CTL) + rep + args.rep;
        LAS unsigned* qw = (LAS unsigned*)(F.lds + 66560);
        for (;;) {
            if (F.tid == 0) *qw = atomicAdd(qctr, 1u);
            __syncthreads();
            const unsigned n = *qw;
            __syncthreads();
            if (n >= 2048u) break;
            if (n < 1024u) { const int c = 127 - (int)(n >> 3), bg = (int)(n & 7); att::nsa_item(P, F.lds, bg >> 1, bg & 1, c, F.wave, F.lane); }
            else { const unsigned k = n - 1024u; const int own = 31 - (int)(k >> 5), bh = (int)(k & 31); att::moba_own_item(P, F.lds, bh >> 3, bh & 7, own, F.wave, F.lane); }
        }
    }
    }
    SEAM(5);
    for (int rep = 0; rep < NREP(6); ++rep) { if (rep) { if (USE_XCD_BARRIER) xcd_barrier(xbar); else grid.sync(); }
    if (IN(6)) {
        pg8::Gemm g{(const bf16_t*)(ws + WS_Y), (const bf16_t*)(ws + WS_WOT), M, DM, DM}; pg8::StaticOrder S; S.init(M, DM, F.G, F.bx);
        pg8::EpiOut E{args.in[0], args.out, 1.189207115002721f};
        pg8::gemm_phase<pg8::EpiOut, pg8::StaticOrder, true, true>((PG8_LAS unsigned char*)F.lds, g, S, E);
    }
    SEAM(6);
    if (IN(7)) p5_ln(args, F);
    }
#undef IN
#undef SEAM
}
#ifndef N_LAUNCHES
#define N_LAUNCHES 1
#endif
extern "C" void kernel_launch(void* const* d_in, const int* in_sizes, int n_in, void* d_out, int out_size, void* d_ws, size_t ws_size, hipStream_t stream) {
    static int grid = 0;
    if (grid == 0) {
        if (n_in != 13 || in_sizes[0] != M * DM || out_size != M * DM || ws_size < WS_END) { fprintf(stderr, "kernel_launch: unexpected shapes (n_in %d, in0 %d, out %d, ws %zu)\n", n_in, n_in > 0 ? in_sizes[0] : -1, out_size, ws_size); grid = -1; return; }
        int dev = 0, cus = 0, per_cu = 0;
        (void)hipGetDevice(&dev); (void)hipDeviceGetAttribute(&cus, hipDeviceAttributeMultiprocessorCount, dev);
        if (hipFuncSetAttribute((const void*)hymba_fwd, hipFuncAttributeMaxDynamicSharedMemorySize, LDS_BYTES) != hipSuccess) { fprintf(stderr, "kernel_launch: hipFuncSetAttribute failed\n"); grid = -1; return; }
        if (hipOccupancyMaxActiveBlocksPerMultiprocessor(&per_cu, (const void*)hymba_fwd, NTHREADS, LDS_BYTES) != hipSuccess || per_cu < 1) { fprintf(stderr, "kernel_launch: occupancy query failed (%d)\n", per_cu); (void)hipGetLastError(); per_cu = 1; }
        grid = cus * (per_cu < 1 ? 1 : 1);
    }
    if (grid < 0) return;
    Args a{};
    for (int i = 0; i < 13; ++i) a.in[i] = (const float*)d_in[i];
    a.out = (float*)d_out; a.ws = (unsigned char*)d_ws;
#if N_LAUNCHES == 1
    a.ph_lo = 0; a.ph_hi = 8;
    void* kargs[] = {&a};
    hipError_t e = hipLaunchCooperativeKernel((const void*)hymba_fwd, dim3(grid), dim3(NTHREADS), kargs, LDS_BYTES, stream);
    if (e != hipSuccess) fprintf(stderr, "cooperative launch failed: %s (grid %d)\n", hipGetErrorString(e), grid);
#ifdef PROBE_RELAUNCH
    a.ph_lo = PROBE_RELAUNCH; a.ph_hi = PROBE_RELAUNCH_END; a.rep = 1;
    (void)hipLaunchCooperativeKernel((const void*)hymba_fwd, dim3(grid), dim3(NTHREADS), kargs, LDS_BYTES, stream);
#endif
#else
    for (int p = 0; p < 8; ++p) { a.ph_lo = p; a.ph_hi = p + 1; hipLaunchKernelGGL(hymba_fwd, dim3(grid), dim3(NTHREADS), LDS_BYTES, stream, a); }
#endif
}
```

```cpp
#include <hip/hip_runtime.h>
#include <hip/hip_cooperative_groups.h>
#include <cstdio>
#include <cstdint>
namespace cg = cooperative_groups;
#define DI __device__ __forceinline__
namespace pg8 {
#define PG8_LAS __attribute__((address_space(3)))
typedef unsigned short bf16_t;
typedef short bf16x8 __attribute__((ext_vector_type(8)));
typedef float f32x4 __attribute__((ext_vector_type(4)));
typedef unsigned u32x4 __attribute__((ext_vector_type(4)));
constexpr int BM = 256, BK = 64, HALF = 128, HTB = HALF * BK * 2  , STAGE_BYTES = 8 * HTB, NXCD = 8, WGM = 8;

__host__ __device__ __forceinline__ int lds_byte(int r, int c) { const int st = (r >> 4) * 2 + (c >> 5), rr = r & 15, cc = c & 31, ob = rr * 64 + cc * 2; return st * 1024 + (ob ^ (((ob >> 9) & 1) << 5)); }
__host__ __device__ __forceinline__ void stage_rc(int b, int& R, int& C) { const int st = b / 1024, sb = b % 1024, swz = sb ^ (((sb >> 9) & 1) << 5); R = (st >> 1) * 16 + swz / 64; C = (st & 1) * 32 + (swz % 64) / 2; }
__host__ __device__ __forceinline__ int perm32(int rho) { const int n = rho >> 4, i = rho & 15; return 8 * (i >> 2) + 4 * n + (i & 3); }

struct Unit { int pm, pn; };
struct Gemm { const bf16_t* A; const bf16_t* Bt; int M, N, K; };

struct StaticOrder {
    int nM, nN, nwg, G, c;
    __host__ __device__ void init(int M, int N, int G_, int c_) { nM = M / BM; nN = N / BM; nwg = nM * nN; G = G_; c = c_; }
    __host__ __device__ bool next(int i, Unit& u) const {
        const long L = (long)i * G + c; if (L >= nwg) return false;
        int wgid = (int)L; { const int q = nwg / NXCD, r = nwg % NXCD, xcd = wgid % NXCD, off = wgid / NXCD; wgid = (xcd < r ? xcd * (q + 1) : r * (q + 1) + (xcd - r) * q) + off; }
        const int nig = WGM * nN, gid = wgid / nig, fm = gid * WGM, gsz = (nM - fm) < WGM ? (nM - fm) : WGM;
        u.pm = fm + ((wgid % nig) % gsz); u.pn = (wgid % nig) / gsz; return true;
    }
    __device__ __forceinline__ void a_ready(const Unit&) const {}
    __device__ __forceinline__ void done(const Unit&) const {}
};

typedef float f32x2_t __attribute__((ext_vector_type(2))); typedef __bf16 bf16x2_t __attribute__((ext_vector_type(2)));
DI unsigned cvtpk(float lo, float hi) { f32x2_t v = {lo, hi}; bf16x2_t b = __builtin_convertvector(v, bf16x2_t); return __builtin_bit_cast(unsigned, b); }
DI float silu_f(float v) { return v / (1.0f + __expf(-v)); }
DI float sigm_f(float v) { return 1.0f / (1.0f + __expf(-v)); }
constexpr int SEQ = 8192;
struct EpiProj {
    static constexpr bool PERM = true, AFTER_DRAIN = false;
    unsigned char* ws;
    DI void store8(bf16_t* dst, const float (&v)[8]) const { u32x4 w; w.x = cvtpk(v[0], v[1]); w.y = cvtpk(v[2], v[3]); w.z = cvtpk(v[4], v[5]); w.w = cvtpk(v[6], v[7]); *(u32x4*)dst = w; }
    DI void operator()(const f32x4 (&acc)[2][2][4][2], const Unit& u, int wr, int wc, int fr, int fq) const {
        const int pn = u.pn;
        bf16_t* const QN = (bf16_t*)(ws + (80ull << 20)); bf16_t* const QR = (bf16_t*)(ws + (112ull << 20)); bf16_t* const KC = (bf16_t*)(ws + (144ull << 20)); bf16_t* const VC = (bf16_t*)(ws + (152ull << 20));
        bf16_t* const KS = (bf16_t*)(ws + (160ull << 20)); bf16_t* const VS = (bf16_t*)(ws + (168ull << 20)); bf16_t* const KW = (bf16_t*)(ws + (176ull << 20)); bf16_t* const VW = (bf16_t*)(ws + (184ull << 20));
        bf16_t* const ZS = (bf16_t*)(ws + (192ull << 20)); bf16_t* const MQ = (bf16_t*)(ws + (256ull << 20)); bf16_t* const MK = (bf16_t*)(ws + (288ull << 20)); bf16_t* const MV = (bf16_t*)(ws + (320ull << 20));
        float* const GT = (float*)(ws + (352ull << 20)); const float* const ROPE = (const float*)(ws + (1ull << 20));
#pragma unroll
        for (int ai = 0; ai < 2; ++ai)
#pragma unroll
            for (int m = 0; m < 4; ++m) {
                const int row = u.pm * BM + ai * HALF + wr * 64 + m * 16 + fr; const int b = row >> 13, t = row & (SEQ - 1);
#pragma unroll
                for (int bj = 0; bj < 2; ++bj) {
                    const int col0 = bj * HALF + wc * 32 + 8 * fq; const int hd = col0 >> 6, d0 = col0 & 63;
                    float v[8];
#pragma unroll
                    for (int i = 0; i < 4; ++i) { v[i] = acc[ai][bj][m][0][i]; v[4 + i] = acc[ai][bj][m][1][i]; }
                    int kind = 0; bf16_t* dst = nullptr; bf16_t* dst2 = nullptr; float sc = 1.0f, sc2 = 1.0f;
                    if (pn <= 1)      { kind = 1; sc = 0.125f; sc2 = 1.4426950408889634f; const size_t o = ((size_t)(b * 8 + pn * 4 + hd) * SEQ + t) * 64 + d0; dst = QR + o; dst2 = QN + o; }
                    else if (pn == 2) { const size_t o = ((size_t)(b * 2 + (hd & 1)) * SEQ + t) * 64 + d0; dst = (hd < 2 ? KC : VC) + o; }
                    else if (pn == 3) { const size_t o = ((size_t)(b * 2 + (hd & 1)) * SEQ + t) * 64 + d0; dst = (hd < 2 ? KS : VS) + o; kind = hd < 2 ? 1 : 0; }
                    else if (pn == 4) { const size_t o = ((size_t)(b * 2 + (hd & 1)) * SEQ + t) * 64 + d0; dst = (hd < 2 ? KW : VW) + o; kind = hd < 2 ? 1 : 0; }
                    else if (pn <= 6) { kind = 2; dst = ZS + (size_t)row * 1024 + (pn - 5) * 256 + col0; }
                    else if (pn <= 8) { kind = 1; sc = 0.125f * 1.4426950408889634f; dst = MQ + ((size_t)(b * 8 + (pn - 7) * 4 + hd) * SEQ + t) * 64 + d0; }
                    else if (pn <= 10) { kind = 1; dst = MK + ((size_t)(b * 8 + (pn - 9) * 4 + hd) * SEQ + t) * 64 + d0; }
                    else if (pn <= 12) { dst = MV + ((size_t)(b * 8 + (pn - 11) * 4 + hd) * SEQ + t) * 64 + d0; }
                    else if (pn <= 14) { kind = 2; dst = ZS + (size_t)row * 1024 + 512 + (pn - 13) * 256 + col0; }
                    else kind = 3;
                    if (kind == 3) {
                        if (col0 < 24) {
#pragma unroll
                            for (int i = 0; i < 8; ++i) v[i] = sigm_f(v[i]);
                            float* gp = GT + (size_t)row * 32 + col0; *(f32x4*)gp = (f32x4){v[0], v[1], v[2], v[3]}; *(f32x4*)(gp + 4) = (f32x4){v[4], v[5], v[6], v[7]};
                        }
                        continue;
                    }
                    if (kind == 2) {
#pragma unroll
                        for (int i = 0; i < 8; ++i) v[i] = silu_f(v[i]);
                        store8(dst, v); continue;
                    }
                    if (sc != 1.0f) {
#pragma unroll
                        for (int i = 0; i < 8; ++i) v[i] *= sc;
                    }
                    if (kind == 1) {
                        if (dst2) { store8(dst2, v);
#pragma unroll
                            for (int i = 0; i < 8; ++i) v[i] *= sc2; }
                        if ((wc & 1) == 0) {
                            float pr[8];
#pragma unroll
                            for (int i = 0; i < 8; ++i) pr[i] = __shfl_xor(v[i], 16);
                            if (fq < 2) {
                                const f32x4 c0 = *(const f32x4*)(ROPE + (size_t)t * 16), c1 = *(const f32x4*)(ROPE + (size_t)t * 16 + 4), s0 = *(const f32x4*)(ROPE + (size_t)t * 16 + 8), s1 = *(const f32x4*)(ROPE + (size_t)t * 16 + 12);
                                const float sg = fq == 0 ? -1.0f : 1.0f;
#pragma unroll
                                for (int i = 0; i < 4; ++i) { v[i] = v[i] * c0[i] + sg * pr[i] * s0[i]; v[4 + i] = v[4 + i] * c1[i] + sg * pr[4 + i] * s1[i]; }
                            }
                        }
                    }
                    store8(dst, v);
                }
            }
    }
};
struct EpiOut {
    static constexpr bool PERM = false, AFTER_DRAIN = false;
    const float* Xin; float* O; float alpha;
    DI void operator()(const f32x4 (&acc)[2][2][4][2], const Unit& u, int wr, int wc, int fr, int fq) const {
#pragma unroll
        for (int ai = 0; ai < 2; ++ai)
#pragma unroll
            for (int m = 0; m < 4; ++m) {
                const size_t row = (size_t)(u.pm * BM + ai * HALF + wr * 64 + m * 16 + fr);
#pragma unroll
                for (int bj = 0; bj < 2; ++bj)
#pragma unroll
                    for (int n = 0; n < 2; ++n) { const size_t off = row * 1024 + u.pn * BM + bj * HALF + wc * 32 + n * 16 + 4 * fq; const f32x4 xv = *(const f32x4*)(Xin + off); *(f32x4*)(O + off) = xv * alpha + acc[ai][bj][m][n]; }
            }
    }
};
template <class Epi, class Sched, bool ALIGN_EPI = false, bool SP2 = false>
__device__ __forceinline__ void gemm_phase(PG8_LAS unsigned char* lds, const Gemm g, const Sched& S, const Epi& E) {
    const int tid = threadIdx.x, wid = __builtin_amdgcn_readfirstlane(tid >> 6), lane = tid & 63, wr = wid >> 2, wc = wid & 3, fr = lane & 15, fq = lane >> 4;
    const int K = g.K, nt = K / BK;
    unsigned voffA[2], voffB[2];
#pragma unroll
    for (int i = 0; i < 2; ++i) { int R, C; stage_rc(tid * 16 + i * 8192, R, C); const int Rb = Epi::PERM ? ((R & ~31) + perm32(R & 31)) : R;
        voffA[i] = (unsigned)(R * K + C) * 2u; voffB[i] = (unsigned)(Rb * K + C) * 2u; }
    const size_t kstep = (size_t)(BK * 2);
    const size_t hstep = (size_t)HALF * K * 2;
    const size_t tstep = 2 * hstep;
    const unsigned ldsw = (unsigned)wid * 1024u;
    const int aoff = lds_byte(wr * 64 + fr, fq * 8), boff = lds_byte(wc * 32 + fr, fq * 8);
#define PG8_SA(b, h) (((b) * 2 + (h)) * HTB)
#define PG8_SB(b, h) ((4 + (b) * 2 + (h)) * HTB)
#define PG8_STAGE(bufoff, gbase, voff) do { _Pragma("unroll") for (int _i = 0; _i < 2; ++_i) \
        __builtin_amdgcn_global_load_lds((const unsigned*)((const char*)(gbase) + (voff)[_i]), (PG8_LAS unsigned*)(lds + (bufoff) + ldsw + _i * 8192), 16, 0, 0); } while (0)
#define PG8_LDA(dst, b, h) do { _Pragma("unroll") for (int m = 0; m < 4; ++m) _Pragma("unroll") for (int k = 0; k < 2; ++k) dst[m][k] = *(const PG8_LAS bf16x8*)(lds + PG8_SA(b, h) + aoff + m * 2048 + k * 1024); } while (0)
#define PG8_LDB(dst, b, h) do { _Pragma("unroll") for (int n = 0; n < 2; ++n) _Pragma("unroll") for (int k = 0; k < 2; ++k) dst[n][k] = *(const PG8_LAS bf16x8*)(lds + PG8_SB(b, h) + boff + n * 2048 + k * 1024); } while (0)
#define PG8_MMA(ai, bj, At, Bt) do { __builtin_amdgcn_s_setprio(1); _Pragma("unroll") for (int m = 0; m < 4; ++m) _Pragma("unroll") for (int n = 0; n < 2; ++n) _Pragma("unroll") for (int k = 0; k < 2; ++k) \
        acc[ai][bj][m][n] = __builtin_amdgcn_mfma_f32_16x16x32_bf16(Bt[n][k], At[m][k], acc[ai][bj][m][n], 0, 0, 0); __builtin_amdgcn_s_setprio(0); } while (0)
#define PG8_WAIT_V(n) asm volatile("s_waitcnt vmcnt(" #n ")" ::: "memory")
#define PG8_WAIT_L(n) asm volatile("s_waitcnt lgkmcnt(" #n ")" ::: "memory")
#define PG8_BAR __builtin_amdgcn_s_barrier()
#define PG8_SCHED __builtin_amdgcn_sched_barrier(0)
    Unit cur, nxt; int ui = 0;
    if (!S.next(0, cur)) return;
    f32x4 acc[2][2][4][2];
#pragma unroll
    for (int a = 0; a < 2; ++a)
#pragma unroll
        for (int b = 0; b < 2; ++b)
#pragma unroll
            for (int m = 0; m < 4; ++m)
#pragma unroll
                for (int n = 0; n < 2; ++n) acc[a][b][m][n] = (f32x4){0.f, 0.f, 0.f, 0.f};
    bf16x8 At[4][2], B0[2][2], B1[2][2];
    const char* cA = (const char*)g.A + (size_t)cur.pm * tstep; const char* cB = (const char*)g.Bt + (size_t)cur.pn * tstep;
    S.a_ready(cur);
    if constexpr (SP2) {
        PG8_STAGE(PG8_SB(0, 0), cB, voffB); PG8_STAGE(PG8_SB(0, 1), cB + hstep, voffB); PG8_STAGE(PG8_SA(0, 0), cA, voffA); PG8_STAGE(PG8_SA(0, 1), cA + hstep, voffA);
        if (wr == 1) PG8_BAR;
        PG8_WAIT_V(2); PG8_BAR;
        PG8_STAGE(PG8_SB(1, 0), cB + kstep, voffB); PG8_STAGE(PG8_SA(1, 0), cA + kstep, voffA); PG8_STAGE(PG8_SB(1, 1), cB + hstep + kstep, voffB);
        PG8_WAIT_V(6); PG8_BAR;
    } else {
        PG8_STAGE(PG8_SB(0, 0), cB, voffB); PG8_STAGE(PG8_SA(0, 0), cA, voffA); PG8_STAGE(PG8_SB(0, 1), cB + hstep, voffB); PG8_STAGE(PG8_SA(0, 1), cA + hstep, voffA);
        if (wr == 1) PG8_BAR;
        PG8_WAIT_V(4); PG8_BAR;
        PG8_STAGE(PG8_SB(1, 0), cB + kstep, voffB); PG8_STAGE(PG8_SA(1, 0), cA + kstep, voffA); PG8_STAGE(PG8_SB(1, 1), cB + hstep + kstep, voffB);
        PG8_WAIT_V(6); PG8_BAR;
    }
    for (;;) {
        const bool has_next = S.next(ui + 1, nxt);
        const char* nA = has_next ? (const char*)g.A + (size_t)nxt.pm * tstep : cA; const char* nB = has_next ? (const char*)g.Bt + (size_t)nxt.pn * tstep : cB;
        for (int t = 0; t < nt; t += 2) {
            const bool last = (t == nt - 2);
            const char* a1 = cA + (size_t)(t + 1) * kstep;
            const char* a2 = last ? nA : cA + (size_t)(t + 2) * kstep; const char* b2 = last ? nB : cB + (size_t)(t + 2) * kstep;
            const char* a3 = a2 + kstep; const char* b3 = b2 + kstep;
            if (last && has_next) S.a_ready(nxt);
            if constexpr (SP2) {
            PG8_LDB(B0, 0, 0); PG8_LDB(B1, 0, 1); PG8_SCHED; PG8_LDA(At, 0, 0); PG8_STAGE(PG8_SA(1, 1), a1 + hstep, voffA);
            PG8_WAIT_V(8); PG8_WAIT_L(0); PG8_BAR; PG8_MMA(0, 0, At, B0); PG8_MMA(0, 1, At, B1); PG8_BAR; PG8_SCHED;
            PG8_LDA(At, 0, 1); PG8_STAGE(PG8_SB(0, 0), b2, voffB); PG8_STAGE(PG8_SB(0, 1), b2 + hstep, voffB); PG8_STAGE(PG8_SA(0, 0), a2, voffA);
            PG8_WAIT_V(8); PG8_WAIT_L(0); PG8_BAR; PG8_MMA(1, 0, At, B0); PG8_MMA(1, 1, At, B1); PG8_BAR; PG8_SCHED;
            PG8_LDB(B0, 1, 0); PG8_LDB(B1, 1, 1); PG8_SCHED; PG8_LDA(At, 1, 0); PG8_STAGE(PG8_SA(0, 1), a2 + hstep, voffA);
            PG8_WAIT_V(8); PG8_WAIT_L(0); PG8_BAR; PG8_MMA(0, 0, At, B0); PG8_MMA(0, 1, At, B1); PG8_BAR; PG8_SCHED;
            PG8_LDA(At, 1, 1); PG8_STAGE(PG8_SB(1, 0), b3, voffB); PG8_STAGE(PG8_SB(1, 1), b3 + hstep, voffB); PG8_STAGE(PG8_SA(1, 0), a3, voffA);
            PG8_WAIT_V(8); PG8_WAIT_L(0); PG8_BAR; PG8_MMA(1, 0, At, B0); PG8_MMA(1, 1, At, B1); PG8_BAR; PG8_SCHED;
            } else {
            PG8_LDB(B0, 0, 0); PG8_SCHED; PG8_LDA(At, 0, 0); PG8_STAGE(PG8_SA(1, 1), a1 + hstep, voffA);
            PG8_WAIT_L(8); PG8_BAR; PG8_WAIT_L(0); PG8_MMA(0, 0, At, B0); PG8_BAR; PG8_SCHED;
            PG8_LDB(B1, 0, 1); PG8_STAGE(PG8_SB(0, 0), b2, voffB);
            PG8_BAR; PG8_WAIT_L(0); PG8_MMA(0, 1, At, B1); PG8_BAR;
            PG8_LDA(At, 0, 1); PG8_STAGE(PG8_SA(0, 0), a2, voffA);
            PG8_BAR; PG8_WAIT_L(0); PG8_MMA(1, 0, At, B0); PG8_BAR; PG8_SCHED;
            PG8_STAGE(PG8_SB(0, 1), b2 + hstep, voffB);
            PG8_WAIT_V(6); PG8_BAR; PG8_MMA(1, 1, At, B1); PG8_BAR;
            PG8_LDB(B0, 1, 0); PG8_SCHED; PG8_LDA(At, 1, 0); PG8_STAGE(PG8_SA(0, 1), a2 + hstep, voffA);
            PG8_WAIT_L(8); PG8_BAR; PG8_WAIT_L(0); PG8_MMA(0, 0, At, B0); PG8_BAR; PG8_SCHED;
            PG8_LDB(B1, 1, 1); PG8_STAGE(PG8_SB(1, 0), b3, voffB);
            PG8_BAR; PG8_WAIT_L(0); PG8_MMA(0, 1, At, B1); PG8_BAR;
            PG8_LDA(At, 1, 1); PG8_STAGE(PG8_SA(1, 0), a3, voffA);
            PG8_BAR; PG8_WAIT_L(0); PG8_MMA(1, 0, At, B0); PG8_BAR; PG8_SCHED;
            PG8_STAGE(PG8_SB(1, 1), b3 + hstep, voffB);
            PG8_WAIT_V(6); PG8_BAR; PG8_MMA(1, 1, At, B1); PG8_BAR;
            }
        }
        if constexpr (ALIGN_EPI) { if (wr == 0) PG8_BAR; }
        if constexpr (!Epi::AFTER_DRAIN) { E(acc, cur, wr, wc, fr, fq); S.done(cur); }
        if (!has_next) break;
#pragma unroll
        for (int a = 0; a < 2; ++a)
#pragma unroll
            for (int b = 0; b < 2; ++b)
#pragma unroll
                for (int m = 0; m < 4; ++m)
#pragma unroll
                    for (int n = 0; n < 2; ++n) acc[a][b][m][n] = (f32x4){0.f, 0.f, 0.f, 0.f};
        cur = nxt; cA = nA; cB = nB; ++ui;
        if constexpr (ALIGN_EPI) { if (wr == 1) PG8_BAR; }
    }
    PG8_WAIT_V(0);
    if constexpr (!ALIGN_EPI) { if (wr == 0) PG8_BAR; }
    PG8_BAR;
    if constexpr (Epi::AFTER_DRAIN) { E.fused(acc, cur, wr, wc, fr, fq, lds, wid, lane); S.done(cur); }
#undef PG8_SA
#undef PG8_SB
#undef PG8_STAGE
#undef PG8_LDA
#undef PG8_LDB
#undef PG8_MMA
#undef PG8_WAIT_V
#undef PG8_WAIT_L
#undef PG8_BAR
#undef PG8_SCHED
}
}

namespace att {
using pg8::bf16_t; using pg8::bf16x8; using pg8::u32x4; using pg8::f32x4;
typedef float f32x16 __attribute__((ext_vector_type(16)));
typedef short s16x4 __attribute__((ext_vector_type(4)));
typedef short v4i16_t __attribute__((ext_vector_type(4)));
typedef unsigned u32x2 __attribute__((ext_vector_type(2)));
#define LAS __attribute__((address_space(3)))
typedef LAS char* lptr; typedef const LAS char* lcptr;
constexpr float L2E = 1.4426950408889634f;
constexpr float NEG_INIT = -1e30f;
constexpr int SEQ = 8192;
#define MFMA32(a, b, c) __builtin_amdgcn_mfma_f32_32x32x16_bf16((a), (b), (c), 0, 0, 0)
DI int crow(int r, int hi) { return (r & 3) + 8 * (r >> 2) + 4 * hi; }
DI s16x4 vtr(lcptr p) { return __builtin_bit_cast(s16x4, __builtin_amdgcn_ds_read_tr16_b64_v4i16((LAS v4i16_t*)p)); }
DI float xhalf(float v) { return __shfl_xor(v, 32); }
DI void stage_load(const bf16_t* Kt, const bf16_t* Vt, int wid, int lane, u32x4& kr, u32x4& vr, bool needV) {
    kr = *(const u32x4*)(Kt + lane * 64 + wid * 8);
    if (needV) vr = *(const u32x4*)(Vt + (16 * (wid & 3) + (lane >> 2)) * 64 + (wid >> 2) * 32 + (lane & 3) * 8);
}
DI void stage_write(lptr slot, int wid, int lane, const u32x4& kr, const u32x4& vr, bool needV) {
    *(LAS u32x4*)(slot + wid * 1024 + lane * 16) = kr;
    if (needV) *(LAS u32x4*)(slot + 8192 + wid * 1024 + lane * 16) = vr;
}
DI void qk_tile(f32x16& p0, f32x16& p1, lcptr Ks, const bf16x8 (&qr)[4], int r32, int hi) {
    lcptr kb = Ks + hi * 1024 + r32 * 16;
    f32x16 z;
#pragma unroll
    for (int i = 0; i < 16; ++i) z[i] = 0.f;
    p0 = z; p1 = z;
#pragma unroll
    for (int d0 = 0; d0 < 4; ++d0) {
        const bf16x8 b0 = *(const LAS bf16x8*)(kb + d0 * 2048), b1 = *(const LAS bf16x8*)(kb + d0 * 2048 + 512);
        p0 = MFMA32(b0, qr[d0], p0); p1 = MFMA32(b1, qr[d0], p1);
    }
}
DI bf16x8 pack8(const f32x16& p, int base) {
    u32x4 w; w.x = pg8::cvtpk(p[base], p[base + 1]); w.y = pg8::cvtpk(p[base + 2], p[base + 3]); w.z = pg8::cvtpk(p[base + 4], p[base + 5]); w.w = pg8::cvtpk(p[base + 6], p[base + 7]);
    return __builtin_bit_cast(bf16x8, w);
}
DI void pv_tile(f32x16 (&o)[2], lcptr Vs, const f32x16& p0, const f32x16& p1, int lane, int hi) {
    lcptr vb = Vs + ((lane >> 4) & 1) * 32 + (lane & 3) * 8 + (4 * hi + ((lane & 15) >> 2)) * 64;
    bf16x8 pf[4]; pf[0] = pack8(p0, 0); pf[1] = pack8(p0, 8); pf[2] = pack8(p1, 0); pf[3] = pack8(p1, 8);
#pragma unroll
    for (int dh = 0; dh < 2; ++dh)
#pragma unroll
        for (int ks = 0; ks < 4; ++ks) {
            const s16x4 lo = vtr(vb + dh * 4096 + ks * 1024), hh = vtr(vb + dh * 4096 + ks * 1024 + 512);
            const bf16x8 vf = (bf16x8){lo[0], lo[1], lo[2], lo[3], hh[0], hh[1], hh[2], hh[3]};
            o[dh] = MFMA32(vf, pf[ks], o[dh]);
        }
}
DI float mask_scale(f32x16& p0, f32x16& p1, int klo, int khi, int hi) {
    const bool full = (klo <= 0) && (khi >= 63), none = (khi < klo) || (khi < 0) || (klo > 63);
    float mx;
    if (__all(full || none)) {
        const float bias = full ? 0.f : -INFINITY;
        float a = fmaxf(p0[0], p1[0]);
#pragma unroll
        for (int r = 1; r < 16; ++r) a = fmaxf(a, fmaxf(p0[r], p1[r]));
#pragma unroll
        for (int r = 0; r < 16; ++r) { p0[r] = p0[r] * L2E + bias; p1[r] = p1[r] * L2E + bias; }
        mx = a * L2E + bias;
    } else {
        const int lo2 = klo - 4 * hi, hi2 = khi - 4 * hi;
        float a = -INFINITY;
#pragma unroll
        for (int r = 0; r < 16; ++r) { const int kc = (r & 3) + 8 * (r >> 2);
            p0[r] = (kc >= lo2 && kc <= hi2) ? p0[r] * L2E : -INFINITY; p1[r] = (kc + 32 >= lo2 && kc + 32 <= hi2) ? p1[r] * L2E : -INFINITY; a = fmaxf(a, fmaxf(p0[r], p1[r])); }
        mx = a;
    }
    return fmaxf(mx, xhalf(mx));
}
DI void tile_online(lcptr slot, const bf16x8 (&qr)[4], int klo, int khi, float& m, float& l, f32x16 (&o)[2], int lane, int r32, int hi) {
    { const bool none = (khi < klo) || (khi < 0) || (klo > 63); if (__all(none)) return; }
    f32x16 p0, p1; qk_tile(p0, p1, slot, qr, r32, hi);
    const float mt = mask_scale(p0, p1, klo, khi, hi);
    const float mn = fmaxf(m, mt), alpha = __builtin_amdgcn_exp2f(m - mn); m = mn;
    float s = 0.f;
#pragma unroll
    for (int r = 0; r < 16; ++r) { p0[r] = __builtin_amdgcn_exp2f(p0[r] - mn); p1[r] = __builtin_amdgcn_exp2f(p1[r] - mn); s += p0[r] + p1[r]; }
    l = l * alpha + s;
#pragma unroll
    for (int r = 0; r < 16; ++r) { o[0][r] *= alpha; o[1][r] *= alpha; }
    pv_tile(o, slot + 8192, p0, p1, lane, hi);
}
constexpr float THR = 4.0f;
DI float max3f(float a, float b, float c) { return __builtin_fmaxf(__builtin_fmaxf(a, b), c); }
DI void tile_online2(lcptr slot, const bf16x8 (&qr)[4], int klo, int khi, float& mneg, bool& has, float& l, f32x16 (&o)[2], int lane, int r32, int hi) {
    const bool full = (klo <= 0) && (khi >= 63), none = (khi < klo) || (khi < 0) || (klo > 63);
    if (__all(none)) return;
    f32x16 p0, p1;
    { const float cinit = none ? -INFINITY : mneg;
#pragma unroll
      for (int r = 0; r < 16; ++r) { p0[r] = cinit; p1[r] = cinit; }
      lcptr kb = slot + hi * 1024 + r32 * 16;
#pragma unroll
      for (int d0 = 0; d0 < 4; ++d0) {
          const bf16x8 b0 = *(const LAS bf16x8*)(kb + d0 * 2048), b1 = *(const LAS bf16x8*)(kb + d0 * 2048 + 512);
          p0 = MFMA32(b0, qr[d0], p0); p1 = MFMA32(b1, qr[d0], p1);
      } }
    if (!__all(full || none)) {
        const int lo2 = klo - 4 * hi, hi2 = khi - 4 * hi;
#pragma unroll
        for (int r = 0; r < 16; ++r) { const int kc = (r & 3) + 8 * (r >> 2);
            p0[r] = (kc >= lo2 && kc <= hi2) ? p0[r] : -INFINITY; p1[r] = (kc + 32 >= lo2 && kc + 32 <= hi2) ? p1[r] : -INFINITY; }
    }
    float rm;
    { float a = max3f(p0[0], p0[1], p1[0]), b = max3f(p0[2], p0[3], p1[1]); a = max3f(a, p1[2], p1[3]);
#pragma unroll
      for (int r = 4; r < 16; r += 4) { a = max3f(a, p0[r], p0[r + 1]); b = max3f(b, p0[r + 2], p0[r + 3]); a = max3f(a, p1[r], p1[r + 1]); b = max3f(b, p1[r + 2], p1[r + 3]); }
      rm = fmaxf(a, b); rm = fmaxf(rm, xhalf(rm)); }
    const bool trig = has ? (rm > THR) : (rm > -INFINITY);
    if (__any(trig)) {
        const float dl = trig ? rm : 0.f;
        const float f = has ? __builtin_amdgcn_exp2f(-dl) : 1.0f;
        mneg -= dl; has = has || trig;
#pragma unroll
        for (int r = 0; r < 16; ++r) { p0[r] -= dl; p1[r] -= dl; }
        l *= f;
#pragma unroll
        for (int r = 0; r < 16; ++r) { o[0][r] *= f; o[1][r] *= f; }
    }
    float s0 = 0.f, s1 = 0.f;
#pragma unroll
    for (int r = 0; r < 16; ++r) { p0[r] = __builtin_amdgcn_exp2f(p0[r]); p1[r] = __builtin_amdgcn_exp2f(p1[r]); s0 += p0[r]; s1 += p1[r]; }
    l += s0 + s1;
    pv_tile(o, slot + 8192, p0, p1, lane, hi);
}
DI void tile_stats(lcptr slot, const bf16x8 (&qr)[4], int klo, int khi, float& m, float& l, int r32, int hi) {
    f32x16 p0, p1; qk_tile(p0, p1, slot, qr, r32, hi);
    const float mt = mask_scale(p0, p1, klo, khi, hi);
    const float mn = fmaxf(m, mt), alpha = __builtin_amdgcn_exp2f(m - mn); m = mn;
    float s = 0.f;
#pragma unroll
    for (int r = 0; r < 16; ++r) s += __builtin_amdgcn_exp2f(p0[r] - mn) + __builtin_amdgcn_exp2f(p1[r] - mn);
    l = l * alpha + s;
}
DI void tile_final(lcptr slot, const bf16x8 (&qr)[4], int klo, int khi, float m, float inv, f32x16 (&o)[2], float& carry, LAS float* imp_row  , bool writer, int lane, int r32, int hi) {
    f32x16 p0, p1; qk_tile(p0, p1, slot, qr, r32, hi);
    (void)mask_scale(p0, p1, klo, khi, hi);
#pragma unroll
    for (int r = 0; r < 16; ++r) { p0[r] = __builtin_amdgcn_exp2f(p0[r] - m) * inv; p1[r] = __builtin_amdgcn_exp2f(p1[r] - m) * inv; }
    float y3[8];
#pragma unroll
    for (int x = 0; x < 4; ++x) { y3[x] = xhalf(p0[4 * x + 3]); y3[4 + x] = xhalf(p1[4 * x + 3]); }
#pragma unroll
    for (int x = 0; x < 8; ++x) {
        const float bs = (x < 4) ? (p0[4 * x] + p0[4 * x + 1]) + (p0[4 * x + 2] + p0[4 * x + 3]) : (p1[4 * (x - 4)] + p1[4 * (x - 4) + 1]) + (p1[4 * (x - 4) + 2] + p1[4 * (x - 4) + 3]);
        const float prev = (x == 0) ? carry : y3[x == 0 ? 0 : x - 1];
        float v = bs + (hi ? y3[x] : prev);
        v += __shfl_xor(v, 1); v += __shfl_xor(v, 2);
        if (writer) imp_row[2 * x + hi] = v;
    }
    carry = y3[7];
    pv_tile(o, slot + 8192, p0, p1, lane, hi);
}
struct AP {
    unsigned char* ws;
#define AP_PTR(name, T_, off) DI T_* name() const { return (T_*)(ws + (off)); }
    AP_PTR(QN, const bf16_t, 80ull << 20) AP_PTR(QR, const bf16_t, 112ull << 20) AP_PTR(KCC, const bf16_t, (2ull << 20) + 256 * 1024) AP_PTR(VCC, const bf16_t, (2ull << 20) + 768 * 1024)
    AP_PTR(KS, const bf16_t, 160ull << 20) AP_PTR(VS, const bf16_t, 168ull << 20) AP_PTR(KW, const bf16_t, 176ull << 20) AP_PTR(VW, const bf16_t, 184ull << 20)
    AP_PTR(ZS, const bf16_t, 192ull << 20) AP_PTR(MQ, const bf16_t, 256ull << 20) AP_PTR(MK, const bf16_t, 288ull << 20) AP_PTR(MV, const bf16_t, 320ull << 20)
    AP_PTR(GT, const float, 352ull << 20) AP_PTR(KM, const float, 2ull << 20) AP_PTR(Y, bf16_t, 16ull << 20)
    AP_PTR(CNT, unsigned, 32768) AP_PTR(LIST, unsigned, 356ull << 20) AP_PTR(PO, bf16_t, 388ull << 20) AP_PTR(PML, float, 484ull << 20)
#undef AP_PTR
};
#define TILE_LOOP(NT, KPTR_EXPR, VPTR_EXPR, NEEDV, BOUNDS_STMT, COMPUTE_STMT) \
  { u32x4 kr_ = {0u, 0u, 0u, 0u}, vr_ = {0u, 0u, 0u, 0u}; \
    { const int i = 0; (void)i; stage_load(KPTR_EXPR, VPTR_EXPR, wid, lane, kr_, vr_, NEEDV); } \
    stage_write(lds, wid, lane, kr_, vr_, NEEDV); __syncthreads(); \
    const int nt_ = (NT); \
    for (int i_ = 0; i_ < nt_; ++i_) { \
      const bool more_ = i_ + 1 < nt_; \
      if (more_) { const int i = i_ + 1; (void)i; stage_load(KPTR_EXPR, VPTR_EXPR, wid, lane, kr_, vr_, NEEDV); } \
      { const int i = i_; (void)i; lcptr slot = lds + (i_ & 1) * 16384; int klo, khi; BOUNDS_STMT; COMPUTE_STMT; } \
      if (more_) stage_write(lds + ((i_ + 1) & 1) * 16384, wid, lane, kr_, vr_, NEEDV); \
      __syncthreads(); } }
DI void zero2(f32x16 (&o)[2]) {
#pragma unroll
    for (int r = 0; r < 16; ++r) { o[0][r] = 0.f; o[1][r] = 0.f; }
}
DI void load_q(bf16x8 (&qr)[4], const bf16_t* qrow, int hi) {
#pragma unroll
    for (int d0 = 0; d0 < 4; ++d0) qr[d0] = *(const bf16x8*)(qrow + 16 * d0 + 8 * hi);
}
DI float bf_lo(unsigned w) { return __uint_as_float(w << 16); }
DI float bf_hi(unsigned w) { return __uint_as_float(w & 0xffff0000u); }
DI void write_y(const f32x16 (&o)[2], float scale, const bf16_t* zrow, bf16_t* yrow, int hi) {
#pragma unroll
    for (int dh = 0; dh < 2; ++dh)
#pragma unroll
        for (int gq = 0; gq < 4; ++gq) {
            const int d = 32 * dh + 8 * gq + 4 * hi;
            const u32x2 z = *(const u32x2*)(zrow + d);
            u32x2 w; w.x = pg8::cvtpk(o[dh][4 * gq] * scale * bf_lo(z.x), o[dh][4 * gq + 1] * scale * bf_hi(z.x)); w.y = pg8::cvtpk(o[dh][4 * gq + 2] * scale * bf_lo(z.y), o[dh][4 * gq + 3] * scale * bf_hi(z.y));
            *(u32x2*)(yrow + d) = w;
        }
}
DI void nsa_item(const AP& P, lptr lds, int b, int g, int c, int wid, int lane) {
    const int r32 = lane & 31, hi = lane >> 5, qi = r32 >> 2, hh = r32 & 3, H = 4 * g + hh;
    const int tq = 64 * c + 8 * wid + qi;
    const size_t qoff = ((size_t)(b * 8 + H) * SEQ + tq) * 64;
    const size_t row = (size_t)b * SEQ + tq;
    bf16x8 qr[4]; load_q(qr, P.QN() + qoff, hi);
    const float* gp = P.GT() + row * 32 + H * 3; const float g0 = gp[0], g1 = gp[1], g2 = gp[2];
    f32x16 o[2];
    LAS float* otl = (LAS float*)(lds + 69632) + (wid * 64 + lane);
    const int ntok = (4 * c + 3) < 511 ? (4 * c + 3) : 511, ntc = (ntok + 63) >> 6;
    const bf16_t* kcc = P.KCC() + (size_t)(b * 2 + g) * 512 * 64; const bf16_t* vcc = P.VCC() + (size_t)(b * 2 + g) * 512 * 64;
    int khi_abs = (tq - 31) >> 4; khi_abs = khi_abs < 510 ? khi_abs : 510;
    float m = NEG_INIT, l = 0.f;
    TILE_LOOP(ntc, kcc + i * 4096, vcc + i * 4096, false, { klo = -64 * i; khi = khi_abs - 64 * i; }, tile_stats(slot, qr, klo, khi, m, l, r32, hi));
    l += xhalf(l);
    { const float inv = l > 0.f ? 1.0f / l : 0.f; float carry = 0.f; zero2(o);
      LAS float* imp = (LAS float*)(lds + 32768) + (8 * wid + qi) * 128;
      TILE_LOOP(ntc, kcc + i * 4096, vcc + i * 4096, true, { klo = -64 * i; khi = khi_abs - 64 * i; }, tile_final(slot, qr, klo, khi, m, inv, o, carry, imp + 16 * i, hh == 0, lane, r32, hi));
#pragma unroll
      for (int r = 0; r < 16; ++r) { otl[r * 512] = g0 * o[0][r]; otl[(16 + r) * 512] = g0 * o[1][r]; } }
    LAS unsigned* selb = (LAS unsigned*)(lds + 65536);
    for (int q2 = 0; q2 < 8; ++q2) {
        unsigned long long s0, s1;
        if (c <= 15) { s0 = (2ull << c) - 1ull; s1 = 0ull; }
        else {
            const LAS float* ir = (const LAS float*)(lds + 32768) + (8 * wid + q2) * 128;
            const float v0 = ir[lane], v1 = ir[64 + lane];
            const int nc2 = c - 2;
            const unsigned k0 = (lane >= 1 && lane <= nc2) ? __float_as_uint(v0) + 1u : 0u, k1 = (lane + 64 <= nc2) ? __float_as_uint(v1) + 1u : 0u;
            unsigned lo = 1u, hb = 0x7f800002u; unsigned long long m0 = 0ull, m1 = 0ull; bool exact = false;
            while (hb - lo > 1u) {
                const unsigned mid = lo + ((hb - lo) >> 1);
                m0 = __ballot(k0 >= mid); m1 = __ballot(k1 >= mid);
                const int cnt = __popcll(m0) + __popcll(m1);
                if (cnt == 13) { exact = true; break; }
                if (cnt > 13) lo = mid; else hb = mid;
            }
            if (!exact) {
                const unsigned long long gg0 = __ballot(k0 > lo), gg1 = __ballot(k1 > lo), e0 = __ballot(k0 == lo), e1 = __ballot(k1 == lo);
                const int need = 13 - __popcll(gg0) - __popcll(gg1);
                const unsigned long long lt = (1ull << lane) - 1ull;
                const int r0 = __popcll(e0 & lt), r1 = __popcll(e0) + __popcll(e1 & lt);
                m0 = gg0 | __ballot(k0 == lo && r0 < need); m1 = gg1 | __ballot(k1 == lo && r1 < need);
            }
            s0 = m0 | 1ull; s1 = m1;
            if (c - 1 < 64) s0 |= 1ull << (c - 1); else s1 |= 1ull << (c - 65);
            if (c < 64) s0 |= 1ull << c; else s1 |= 1ull << (c - 64);
        }
        if (lane == 0) { LAS unsigned* sp = selb + (8 * wid + q2) * 4; sp[0] = (unsigned)s0; sp[1] = (unsigned)(s0 >> 32); sp[2] = (unsigned)s1; sp[3] = (unsigned)(s1 >> 32); }
    }
    const unsigned sb0 = selb[(8 * wid + qi) * 4 + 0], sb1 = selb[(8 * wid + qi) * 4 + 1], sb2 = selb[(8 * wid + qi) * 4 + 2], sb3 = selb[(8 * wid + qi) * 4 + 3];
    load_q(qr, P.QR() + qoff, hi);
    const bf16_t* ks = P.KS() + (size_t)(b * 2 + g) * SEQ * 64; const bf16_t* vs = P.VS() + (size_t)(b * 2 + g) * SEQ * 64;
    float mneg = 0.f; bool has = false; l = 0.f; zero2(o);
    TILE_LOOP(c + 1, ks + (size_t)i * 4096, vs + (size_t)i * 4096, true,
              { klo = 0; const unsigned w = i < 32 ? sb0 : i < 64 ? sb1 : i < 96 ? sb2 : sb3; khi = (i == c) ? (tq - 64 * c) : (((w >> (i & 31)) & 1u) ? 63 : -1); },
              tile_online2(slot, qr, klo, khi, mneg, has, l, o, lane, r32, hi));
    l += xhalf(l);
    { const float f = l > 0.f ? g1 / l : 0.f;
#pragma unroll
      for (int r = 0; r < 16; ++r) { otl[r * 512] += f * o[0][r]; otl[(16 + r) * 512] += f * o[1][r]; } }
    const bf16_t* kw = P.KW() + (size_t)(b * 2 + g) * SEQ * 64; const bf16_t* vw = P.VW() + (size_t)(b * 2 + g) * SEQ * 64;
    const int j0 = c > 8 ? c - 8 : 0;
    mneg = 0.f; has = false; l = 0.f; zero2(o);
    TILE_LOOP(c - j0 + 1, kw + (size_t)(j0 + i) * 4096, vw + (size_t)(j0 + i) * 4096, true,
              { const int base = 64 * (j0 + i); klo = tq - 511 - base; khi = tq - base; },
              tile_online2(slot, qr, klo, khi, mneg, has, l, o, lane, r32, hi));
    l += xhalf(l);
    { const float f = l > 0.f ? g2 / l : 0.f;
#pragma unroll
      for (int r = 0; r < 16; ++r) { o[0][r] = otl[r * 512] + f * o[0][r]; o[1][r] = otl[(16 + r) * 512] + f * o[1][r]; } }
    write_y(o, 1.0f, P.ZS() + row * 1024 + H * 64, P.Y() + row * 1024 + H * 64, hi);
}
constexpr int LCAP = 8192;
DI void moba_select_item(const AP& P, lptr lds, int b, int h, int own, int wid, int lane, int tid) {
    const int r32 = lane & 31, hi = lane >> 5;
    const int tq = 256 * own + 32 * wid + r32, bh = b * 8 + h;
    unsigned bits = 0u;
    if (own <= 3) bits = (1u << own) - 1u;
    else {
        bf16x8 qr[4]; load_q(qr, P.MQ() + ((size_t)bh * SEQ + tq) * 64, hi);
        { const int j = tid >> 4, d4 = (tid & 15) * 4;
          const f32x4 km = *(const f32x4*)(P.KM() + ((size_t)bh * 32 + j) * 64 + d4);
          const unsigned h01 = pg8::cvtpk(km[0], km[1]), h23 = pg8::cvtpk(km[2], km[3]);
          const unsigned l01 = pg8::cvtpk(km[0] - bf_lo(h01), km[1] - bf_hi(h01)), l23 = pg8::cvtpk(km[2] - bf_lo(h23), km[3] - bf_hi(h23));
          const int off = (d4 >> 3) * 1024 + j * 16 + (d4 & 7) * 2;
          *(LAS u32x2*)(lds + off) = (u32x2){h01, h23}; *(LAS u32x2*)(lds + 16384 + off) = (u32x2){l01, l23}; }
        __syncthreads();
        f32x16 sg;
#pragma unroll
        for (int r = 0; r < 16; ++r) sg[r] = 0.f;
        { lcptr kb = lds + hi * 1024 + r32 * 16;
#pragma unroll
          for (int d0 = 0; d0 < 4; ++d0) { const bf16x8 a = *(const LAS bf16x8*)(kb + d0 * 2048), a2 = *(const LAS bf16x8*)(kb + 16384 + d0 * 2048); sg = MFMA32(a, qr[d0], sg); sg = MFMA32(a2, qr[d0], sg); } }
#pragma unroll
        for (int r = 0; r < 16; ++r) if (crow(r, hi) >= own) sg[r] = -INFINITY;
#pragma unroll
        for (int rd = 0; rd < 3; ++rd) {
            float best = sg[0]; int bj = crow(0, hi);
#pragma unroll
            for (int r = 1; r < 16; ++r) if (sg[r] > best) { best = sg[r]; bj = crow(r, hi); }
            const float ob = xhalf(best); const int oj = __shfl_xor(bj, 32);
            if (ob > best || (ob == best && oj < bj)) { best = ob; bj = oj; }
            if (best > -INFINITY) bits |= 1u << bj;
#pragma unroll
            for (int r = 0; r < 16; ++r) if (crow(r, hi) == bj) sg[r] = -INFINITY;
        }
        __syncthreads();
    }
    unsigned* cnt = P.CNT() + bh * 32; unsigned* list = P.LIST() + (size_t)bh * 32 * LCAP;
    LAS unsigned* wcnt = (LAS unsigned*)(lds + 32768);
    LAS unsigned* gbase = (LAS unsigned*)(lds + 32768 + 1024);
    for (int j = 0; j < own; ++j) {
        const unsigned long long mask = __ballot((hi == 0) && ((bits >> j) & 1u));
        if (lane == 0) wcnt[wid * 32 + j] = (unsigned)__popcll(mask);
    }
    __syncthreads();
    if (tid < own) {
        unsigned run = 0u;
#pragma unroll
        for (int w = 0; w < 8; ++w) { const unsigned c = wcnt[w * 32 + tid]; wcnt[w * 32 + tid] = run; run += c; }
        gbase[tid] = run ? atomicAdd(cnt + tid, run) : 0u;
    }
    __syncthreads();
    for (int j = 0; j < own; ++j) {
        const bool sel = (hi == 0) && ((bits >> j) & 1u);
        const unsigned long long mask = __ballot(sel);
        if (sel) list[(size_t)j * LCAP + gbase[j] + wcnt[wid * 32 + j] + __popcll(mask & ((1ull << lane) - 1ull))] = ((unsigned)tq << 2) | (unsigned)__popc(bits & ((1u << j) - 1u));
    }
    __syncthreads();
}
DI void moba_past_item(const AP& P, lptr lds, int bhj, int g, int wid, int lane) {
    const int r32 = lane & 31, hi = lane >> 5, bh = bhj >> 5, j = bhj & 31;
    const unsigned cnt = P.CNT()[bhj], idx = 256u * g + 32u * wid + r32;
    const bool valid = idx < cnt;
    const unsigned e = P.LIST()[(size_t)bhj * LCAP + (valid ? idx : 256u * g)];
    const int tq = (int)(e >> 2), slot = (int)(e & 3u);
    bf16x8 qr[4]; load_q(qr, P.MQ() + ((size_t)bh * SEQ + tq) * 64, hi);
    const bf16_t* mk = P.MK() + ((size_t)bh * SEQ + 256 * j) * 64; const bf16_t* mv = P.MV() + ((size_t)bh * SEQ + 256 * j) * 64;
    float mneg = 0.f, l = 0.f; bool has = false; f32x16 o[2]; zero2(o);
    TILE_LOOP(4, mk + (size_t)i * 4096, mv + (size_t)i * 4096, true, { klo = 0; khi = valid ? 63 : -1; }, tile_online2(slot, qr, klo, khi, mneg, has, l, o, lane, r32, hi));
    l += xhalf(l);
    if (valid) {
        const size_t prow = ((size_t)bh * SEQ + tq) * 3 + slot;
        bf16_t* po = P.PO() + prow * 64;
#pragma unroll
        for (int dh = 0; dh < 2; ++dh)
#pragma unroll
            for (int gq = 0; gq < 4; ++gq) { u32x2 w; w.x = pg8::cvtpk(o[dh][4 * gq], o[dh][4 * gq + 1]); w.y = pg8::cvtpk(o[dh][4 * gq + 2], o[dh][4 * gq + 3]); *(u32x2*)(po + 32 * dh + 8 * gq + 4 * hi) = w; }
        if (hi == 0) { float* pm = (float*)P.PML() + prow * 2; pm[0] = -mneg; pm[1] = l; }
    }
}
DI void moba_own_item(const AP& P, lptr lds, int b, int h, int own, int wid, int lane) {
    const int r32 = lane & 31, hi = lane >> 5;
    const int tq = 256 * own + 32 * wid + r32, bh = b * 8 + h;
    const size_t hb = (size_t)bh * SEQ * 64;
    const size_t row = (size_t)b * SEQ + tq;
    bf16x8 qr[4]; load_q(qr, P.MQ() + hb + (size_t)tq * 64, hi);
    float mneg = 0.f, l = 0.f; bool has = false; f32x16 o[2]; zero2(o);
    const int np = own < 3 ? own : 3;
    if (np > 0) {
        const size_t prow = ((size_t)bh * SEQ + tq) * 3;
        const float* pm = P.PML() + prow * 2;
        float mm[3], ll[3];
#pragma unroll
        for (int s = 0; s < 3; ++s) { mm[s] = s < np ? pm[2 * s] : -INFINITY; ll[s] = s < np ? pm[2 * s + 1] : 0.f; }
        const float mx = fmaxf(fmaxf(mm[0], mm[1]), mm[2]);
        mneg = -mx; has = true;
#pragma unroll
        for (int s = 0; s < 3; ++s) if (s < np) {
            const float w = __builtin_amdgcn_exp2f(mm[s] - mx);
            if (hi == 0) l += ll[s] * w;
            const bf16_t* po = P.PO() + (prow + s) * 64;
#pragma unroll
            for (int dh = 0; dh < 2; ++dh)
#pragma unroll
                for (int gq = 0; gq < 4; ++gq) { const u32x2 z = *(const u32x2*)(po + 32 * dh + 8 * gq + 4 * hi);
                    o[dh][4 * gq] += w * bf_lo(z.x); o[dh][4 * gq + 1] += w * bf_hi(z.x); o[dh][4 * gq + 2] += w * bf_lo(z.y); o[dh][4 * gq + 3] += w * bf_hi(z.y); }
        }
    }
    const bf16_t* mk = P.MK() + hb + (size_t)own * 256 * 64; const bf16_t* mv = P.MV() + hb + (size_t)own * 256 * 64;
    TILE_LOOP(4, mk + (size_t)i * 4096, mv + (size_t)i * 4096, true, { klo = 0; khi = 32 * wid + r32 - 64 * i; }, tile_online2(slot, qr, klo, khi, mneg, has, l, o, lane, r32, hi));
    l += xhalf(l);
    write_y(o, l > 0.f ? 1.0f / l : 0.f, P.ZS() + row * 1024 + 512 + h * 64, P.Y() + row * 1024 + 512 + h * 64, hi);
}
}
using att::lptr; using att::lcptr;
using pg8::bf16_t; using pg8::bf16x8; using pg8::u32x4; using pg8::f32x4;
constexpr int NWAVES = 8, NTHREADS = 512;
constexpr int BATCH = 4, T = 8192, DM = 1024, M = BATCH * T;
constexpr int NPROJ = 4096;
constexpr float LN_EPS = 1e-5f;
constexpr size_t MiB = 1u << 20;
constexpr size_t WS_CTL = 0;
constexpr size_t WS_ROPE = 1 * MiB;
constexpr size_t WS_B1P = WS_ROPE + 512 * 1024;
constexpr size_t WS_KM = 2 * MiB;
constexpr size_t WS_KCC = WS_KM + 256 * 1024;
constexpr size_t WS_VCC = WS_KCC + 512 * 1024;
constexpr size_t WS_W2T = WS_VCC + 512 * 1024;
constexpr size_t WS_W1T = 4 * MiB;
constexpr size_t WS_WOT = 6 * MiB;
constexpr size_t WS_WT = 8 * MiB;
constexpr size_t WS_XB = 16 * MiB;
constexpr size_t WS_Y = WS_XB;
constexpr size_t WS_QN = 80 * MiB, WS_QR = 112 * MiB;
constexpr size_t WS_KC = 144 * MiB, WS_VC = 152 * MiB, WS_KS = 160 * MiB, WS_VS = 168 * MiB, WS_KW = 176 * MiB, WS_VW = 184 * MiB;
constexpr size_t WS_ZS = 192 * MiB;
constexpr size_t WS_MQ = 256 * MiB, WS_MK = 288 * MiB, WS_MV = 320 * MiB;
constexpr size_t WS_GT = 352 * MiB;
constexpr size_t WS_LIST = 356 * MiB;
constexpr size_t WS_PO = 388 * MiB;
constexpr size_t WS_PML = 484 * MiB;
constexpr size_t WS_END = 490 * MiB;
constexpr int CW_CNT = 8192;
constexpr int LDS_BYTES = 136192;
constexpr int LDS_MISC = 135168;
constexpr int CW_BAR = 1024; static_assert(1024 + 3456 <= 8192, "barrier words below the list counters");

static_assert(WS_QN == (80ull << 20) && WS_QR == (112ull << 20) && WS_KCC == (2ull << 20) + 256 * 1024 && WS_VCC == (2ull << 20) + 768 * 1024 && WS_KS == (160ull << 20) && WS_VS == (168ull << 20) && WS_KW == (176ull << 20) && WS_VW == (184ull << 20) && WS_ZS == (192ull << 20) && WS_MQ == (256ull << 20) && WS_MK == (288ull << 20) && WS_MV == (320ull << 20) && WS_GT == (352ull << 20) && WS_KM == (2ull << 20) && WS_Y == (16ull << 20) && WS_KC == (144ull << 20) && WS_VC == (152ull << 20) && WS_ROPE == (1ull << 20) && WS_CTL + CW_CNT * 4 == 32768 && WS_LIST == (356ull << 20) && WS_PO == (388ull << 20) && WS_PML == (484ull << 20), "AP / EpiProj offsets");
struct Args { const float* in[13]; float* out; unsigned char* ws; int ph_lo, ph_hi, rep, pad; };

DI unsigned pk2(float lo, float hi) { return pg8::cvtpk(lo, hi); }
template <class Map> DI void transpose_item(const float* W, int ldw, Map srccol, bf16_t* WT, int K, LAS float* scr, int kb, int nb, int lane) {
    const int k0 = 64 * kb, n0 = 32 * nb; const int sc = srccol(n0 + (lane & 31));
#pragma unroll 8
    for (int i = 0; i < 32; ++i) { const int kk = 2 * i + (lane >> 5); scr[kk * 33 + (lane & 31)] = sc >= 0 ? W[(size_t)(k0 + kk) * ldw + sc] : 0.f; }
    asm volatile("s_waitcnt lgkmcnt(0)" ::: "memory");
    const int c = lane & 7;
#pragma unroll
    for (int j = 0; j < 4; ++j) { const int n = (lane >> 3) + 8 * j; const LAS float* s = scr + (8 * c) * 33 + n;
        u32x4 o; o.x = pk2(s[0 * 33], s[1 * 33]); o.y = pk2(s[2 * 33], s[3 * 33]); o.z = pk2(s[4 * 33], s[5 * 33]); o.w = pk2(s[6 * 33], s[7 * 33]);
        *(u32x4*)(WT + (size_t)(n0 + n) * K + k0 + 8 * c) = o; }
    asm volatile("s_waitcnt lgkmcnt(0)" ::: "memory");
}
struct MapIdent { DI int operator()(int n) const { return n; } };
struct MapProj { DI int operator()(int n) const { return n < 1280 ? n : n < 3840 ? n + 24 : n < 3864 ? n - 2560 : -1; } };
DI float wave_sum(float v) {
#pragma unroll
    for (int o = 1; o < 64; o <<= 1) v += __shfl_xor(v, o);
    return v;
}
DI void sincos_d(double a, double& s, double& c) {
    const double q = __builtin_rint(a * 0.63661977236758134308);
    double r = __builtin_fma(-q, 1.57079632679489655800e+00, a); r = __builtin_fma(-q, 6.12323399573676603587e-17, r);
    const double r2 = r * r;
    double ps = -1.0 / 1307674368000.0; ps = ps * r2 + 1.0 / 6227020800.0; ps = ps * r2 - 1.0 / 39916800.0; ps = ps * r2 + 1.0 / 362880.0; ps = ps * r2 - 1.0 / 5040.0; ps = ps * r2 + 1.0 / 120.0; ps = ps * r2 - 1.0 / 6.0; ps = ps * r2 * r + r;
    double pc = 1.0 / 20922789888000.0; pc = pc * r2 - 1.0 / 87178291200.0; pc = pc * r2 + 1.0 / 479001600.0; pc = pc * r2 - 1.0 / 3628800.0; pc = pc * r2 + 1.0 / 40320.0; pc = pc * r2 - 1.0 / 720.0; pc = pc * r2 + 1.0 / 24.0; pc = pc * r2 - 0.5; pc = pc * r2 + 1.0;
    const int qi = (int)((long long)q & 3);
    s = (qi == 0) ? ps : (qi == 1) ? pc : (qi == 2) ? -ps : -pc;
    c = (qi == 0) ? pc : (qi == 1) ? -ps : (qi == 2) ? -pc : ps;
}
#define XB_TMO      128
#define XB_XCNT(j)  (256  + 64 * (j))
#define XB_XSUB(j)  (1280 + 64 * (j))
#define XB_XGEN(j)  (2304 + 64 * (j))
#define XB_TOP      3328
#define XB_TOPGEN   3392
#define XCD_BAR_WORDS 3456
#define XB_SPIN_CAP (1u << 18)

__device__ __forceinline__ unsigned xb_ld(unsigned* p)              { return __hip_atomic_load(p, __ATOMIC_RELAXED, __HIP_MEMORY_SCOPE_AGENT); }
__device__ __forceinline__ unsigned xb_add(unsigned* p, unsigned v) { return __hip_atomic_fetch_add(p, v, __ATOMIC_RELAXED, __HIP_MEMORY_SCOPE_AGENT); }
__device__ __forceinline__ unsigned xb_xcc_id() { return (unsigned)__builtin_amdgcn_s_getreg((3 << 11) | 20) & 0xFu; }
#define XB_SPIN(cond, bar) do { unsigned _sp = 0; while (cond) { __builtin_amdgcn_s_sleep(1); \
    if ((++_sp & 255u) == 0u) { if (xb_ld(&(bar)[XB_TMO])) break; if (_sp > XB_SPIN_CAP) { atomicAdd(&(bar)[XB_TMO], 1u); break; } } } } while (0)

struct XcdBarrier {
    unsigned* bar; unsigned x;
    volatile LAS unsigned* st;
};

__device__ __forceinline__ XcdBarrier xcd_barrier_post(unsigned* bar, volatile LAS unsigned* st) {
    XcdBarrier b; b.bar = bar; b.x = xb_xcc_id(); b.st = st;
    if (threadIdx.x == 0) (void)xb_add(&bar[XB_XCNT(b.x)], 1u);
    return b;
}
__device__ __forceinline__ void xcd_barrier_complete(unsigned* bar, unsigned x, unsigned& nloc, unsigned& nx) {
    const unsigned G = gridDim.x * gridDim.y * gridDim.z;
    unsigned sum, cnt, mine, sp = 0u;
    for (;;) {
        sum = 0u; cnt = 0u; mine = 0u;
#pragma unroll
        for (unsigned j = 0; j < 16; ++j) { const unsigned c = xb_ld(&bar[XB_XCNT(j)]); sum += c; cnt += (c > 0u) ? 1u : 0u; mine = (j == x) ? c : mine; }
        if (sum == G) break;
        __builtin_amdgcn_s_sleep(1);
        if ((++sp & 255u) == 0u) { if (xb_ld(&bar[XB_TMO])) break; if (sp > XB_SPIN_CAP) { atomicAdd(&bar[XB_TMO], 1u); break; } }
    }
    nloc = mine > 0u ? mine : 1u; nx = cnt > 0u ? cnt : 1u;
}

__device__ __forceinline__ void xcd_barrier(const XcdBarrier& b) {
    asm volatile("s_waitcnt vmcnt(0)" ::: "memory");
    __syncthreads();
    if (threadIdx.x == 0) {
        unsigned* bar = b.bar;
        __builtin_amdgcn_s_waitcnt(0);
        unsigned nloc = b.st[0], nx = b.st[1];
        if (nloc == 0u) { xcd_barrier_complete(bar, b.x, nloc, nx); b.st[0] = nloc; b.st[1] = nx; }
        const unsigned old = xb_add(&bar[XB_XSUB(b.x)], 1u);
        const unsigned gen = old / nloc;
        if (old + 1u == (gen + 1u) * nloc) {
            __builtin_amdgcn_fence(__ATOMIC_RELEASE, "agent");
            asm volatile("s_waitcnt vmcnt(0)" ::: "memory");
            const unsigned og = xb_add(&bar[XB_TOP], 1u);
            const unsigned tg = og / nx;
            if (og + 1u == (tg + 1u) * nx) xb_add(&bar[XB_TOPGEN], 1u);
            else XB_SPIN(xb_ld(&bar[XB_TOPGEN]) == tg, bar);
            __builtin_amdgcn_fence(__ATOMIC_ACQUIRE, "agent");
            xb_add(&bar[XB_XGEN(b.x)], 1u);
            asm volatile("s_waitcnt vmcnt(0)" ::: "memory");
        } else {
            XB_SPIN(xb_ld(&bar[XB_XGEN(b.x)]) == gen, bar);
            __builtin_amdgcn_fence(__ATOMIC_ACQUIRE, "agent");
            asm volatile("s_waitcnt vmcnt(0)" ::: "memory");
        }
    }
    __syncthreads();
}

struct Frame { lptr lds; int tid, lane, wave, G, bx; };

DI void p0_prep(const Args& a, const Frame& F) {
    unsigned char* ws = a.ws;
    LAS float* scr = (LAS float*)(F.lds + F.wave * 16384);
    const int gw = F.bx * NWAVES + F.wave, NGW = F.G * NWAVES;
    if (F.bx == 0) { for (int i = F.tid; i < CW_CNT + 1024; i += NTHREADS) ((unsigned*)(ws + WS_CTL))[i] = 0u; }
    constexpr int I0 = 16 * 128, I1 = 16 * 32, I2 = 32 * 8, I3 = 4 * 2, I4 = 128;
    constexpr int NITEMS = I0 + I1 + 2 * I2 + 2 * I3 + I4;
    for (int it = gw; it < NITEMS; it += NGW) {
        int r = it;
        if (r < I0) { transpose_item(a.in[1], 3864, MapProj(), (bf16_t*)(ws + WS_WT), 1024, scr, r / 128, r % 128, F.lane); continue; } r -= I0;
        if (r < I1) { transpose_item(a.in[10], 1024, MapIdent(), (bf16_t*)(ws + WS_WOT), 1024, scr, r / 32, r % 32, F.lane); continue; } r -= I1;
        if (r < 2 * I2) { const int kv = r / I2; r %= I2; transpose_item(a.in[kv ? 7 : 3], 256, MapIdent(), (bf16_t*)(ws + WS_W1T) + (size_t)kv * 256 * 2048, 2048, scr, r / 8, r % 8, F.lane); continue; } r -= 2 * I2;
        if (r < 2 * I3) { const int kv = r / I3; r %= I3; transpose_item(a.in[kv ? 9 : 5], 64, MapIdent(), (bf16_t*)(ws + WS_W2T) + (size_t)kv * 64 * 256, 256, scr, r / 2, r % 2, F.lane); continue; } r -= 2 * I3;
        {
            float* pp = (float*)(ws + WS_B1P) + (size_t)r * 512;
#pragma unroll
            for (int e = 0; e < 8; ++e) { const int idx = e * 64 + F.lane, kv = idx >> 8, n = idx & 255; const float* pos = a.in[kv ? 6 : 2]; const float* w1 = a.in[kv ? 7 : 3];
                float s = 0.f;
#pragma unroll
                for (int k = 0; k < 16; ++k) s += pos[16 * r + k] * w1[(size_t)(16 * r + k) * 256 + n];
                pp[idx] = s; }
        }
    }
    { const f32x4* x4 = (const f32x4*)a.in[0]; u32x4* xb = (u32x4*)(ws + WS_XB); const size_t n8 = (size_t)M * DM / 8, stride = (size_t)F.G * NTHREADS;
      for (size_t i = (size_t)F.bx * NTHREADS + F.tid; i < n8; i += stride) { const f32x4 v0 = x4[2 * i], v1 = x4[2 * i + 1]; u32x4 o; o.x = pk2(v0[0], v0[1]); o.y = pk2(v0[2], v0[3]); o.z = pk2(v1[0], v1[1]); o.w = pk2(v1[2], v1[3]); xb[i] = o; } }
    { float* rp = (float*)(ws + WS_ROPE);
      for (int i = F.bx * NTHREADS + F.tid; i < T * 8; i += F.G * NTHREADS) { const int t = i >> 3, f = i & 7;
          const float invf = f == 0 ? 1.0f : f == 1 ? 0.19392274f : f == 2 ? 0.03760603f : f == 3 ? 0.0072926646f : f == 4 ? 0.0014142136f : f == 5 ? 0.0002742482f : f == 6 ? 5.318296e-05f : 1.0313386e-05f;
          const float ang = (float)t * invf; double s, c; sincos_d((double)ang, s, c);
          rp[t * 16 + f] = (float)c; rp[t * 16 + 8 + f] = (float)s; } }
}
DI void p2_compress_item(const Args& a, const Frame& F, int item) {
    unsigned char* ws = a.ws;
    const int kv = item >> 7, bg = (item >> 4) & 7, ib = item & 15;
    const bf16_t* src = (const bf16_t*)(ws + (kv ? WS_VC : WS_KC)) + (size_t)bg * T * 64;
    const bf16_t* w1t = (const bf16_t*)(ws + WS_W1T) + (size_t)kv * 256 * 2048;
    const bf16_t* w2t = (const bf16_t*)(ws + WS_W2T) + (size_t)kv * 64 * 256;
    bf16_t* dst = (bf16_t*)(ws + (kv ? WS_VCC : WS_KCC)) + (size_t)bg * 512 * 64;
    const int lane = F.lane, wid = F.wave, tid = F.tid, r32 = lane & 31, hi = lane >> 5;
    LAS float* b1p = (LAS float*)(F.lds + 73728);
    LAS float* red = (LAS float*)(F.lds + 74752);
    LAS bf16_t* Hs = (LAS bf16_t*)(F.lds + 76800);
    { const int n = tid & 255, half = tid >> 8; const float* pp = (const float*)(ws + WS_B1P) + kv * 256 + n; float s = 0.f;
#pragma unroll 16
      for (int j = 0; j < 64; ++j) s += pp[(size_t)(half * 64 + j) * 512];
      red[half * 256 + n] = s; }
    const int prow = tid >> 3, pc = tid & 7;
    const bf16_t* bsrc = w1t + (size_t)prow * 2048 + pc * 8;
    int ia = 32 * ib + prow; ia = ia < 510 ? ia : 510;
    const bf16_t* asrc = src + (size_t)ia * 1024 + pc * 8;
    const int wofs = prow * 128 + ((pc ^ ((prow >> 1) & 7)) * 16);
    u32x4 rb[4], ra;
#define P2_LOAD(tt) do { _Pragma("unroll") for (int q = 0; q < 4; ++q) rb[q] = *(const u32x4*)(bsrc + (size_t)q * 64 * 2048 + (tt) * 64); if (tid < 256) ra = *(const u32x4*)(asrc + (tt) * 64); } while (0)
#define P2_WRITE(buf) do { lptr base_ = F.lds + (buf) * 36864; _Pragma("unroll") for (int q = 0; q < 4; ++q) *(LAS u32x4*)(base_ + q * 8192 + wofs) = rb[q]; if (tid < 256) *(LAS u32x4*)(base_ + 32768 + wofs) = ra; } while (0)
    att::f32x16 acc0;
#pragma unroll
    for (int r = 0; r < 16; ++r) acc0[r] = 0.f;
    ra = (u32x4){0u, 0u, 0u, 0u};
    P2_LOAD(0); P2_WRITE(0); __syncthreads();
    const int arow = r32, brow = 32 * wid + r32;
    const int aswz = (arow >> 1) & 7, bswz = (brow >> 1) & 7;
    for (int tt = 0; tt < 32; ++tt) {
        if (tt + 1 < 32) P2_LOAD(tt + 1);
        lcptr base = F.lds + (tt & 1) * 36864;
#pragma unroll
        for (int ks = 0; ks < 4; ++ks) {
            const int c = 2 * ks + hi;
            const bf16x8 fa = *(const LAS bf16x8*)(base + 32768 + arow * 128 + ((c ^ aswz) * 16));
            const bf16x8 fb = *(const LAS bf16x8*)(base + brow * 128 + ((c ^ bswz) * 16));
            acc0 = MFMA32(fa, fb, acc0);
        }
        if (tt + 1 < 32) P2_WRITE((tt + 1) & 1);
        __syncthreads();
    }
#undef P2_LOAD
#undef P2_WRITE
    if (tid < 256) b1p[tid] = red[tid] + red[256 + tid] + a.in[kv ? 8 : 4][tid];
    __syncthreads();
    { const int n = 32 * wid + r32; const float bb = b1p[n];
#pragma unroll
      for (int r = 0; r < 16; ++r) { const int i = att::crow(r, hi); Hs[i * 264 + n] = (bf16_t)(pg8::cvtpk(pg8::silu_f(acc0[r] + bb), 0.f) & 0xffffu); } }
    __syncthreads();
    if (wid < 2) {
        const int ct = wid; att::f32x16 acc2;
#pragma unroll
        for (int r = 0; r < 16; ++r) acc2[r] = 0.f;
#pragma unroll
        for (int s = 0; s < 16; ++s) { const bf16x8 fa = *(const LAS bf16x8*)(Hs + r32 * 264 + 16 * s + 8 * hi), fb = *(const bf16x8*)(w2t + (size_t)(32 * ct + r32) * 256 + 16 * s + 8 * hi);
            acc2 = MFMA32(fa, fb, acc2); }
#pragma unroll
        for (int r = 0; r < 16; ++r) { const int i = 32 * ib + att::crow(r, hi); dst[(size_t)i * 64 + 32 * ct + r32] = (bf16_t)(pg8::cvtpk(acc2[r], 0.f) & 0xffffu); }
    }
    __syncthreads();
}
DI void p2_kmean_item(const Args& a, const Frame& F, int item) {
    const bf16_t* mk = (const bf16_t*)(a.ws + WS_MK) + (size_t)item * 256 * 64;
    const int c = F.lane & 7, rg = F.lane >> 3; float s[8];
#pragma unroll
    for (int i = 0; i < 8; ++i) s[i] = 0.f;
#pragma unroll 4
    for (int p = 0; p < 32; ++p) { const u32x4 v = *(const u32x4*)(mk + (size_t)(8 * p + rg) * 64 + 8 * c);
        s[0] += att::bf_lo(v.x); s[1] += att::bf_hi(v.x); s[2] += att::bf_lo(v.y); s[3] += att::bf_hi(v.y); s[4] += att::bf_lo(v.z); s[5] += att::bf_hi(v.z); s[6] += att::bf_lo(v.w); s[7] += att::bf_hi(v.w); }
#pragma unroll
    for (int i = 0; i < 8; ++i) { s[i] += __shfl_xor(s[i], 8); s[i] += __shfl_xor(s[i], 16); s[i] += __shfl_xor(s[i], 32); }
    if (rg == 0) { float* o = (float*)(a.ws + WS_KM) + (size_t)item * 64 + 8 * c;
        *(f32x4*)o = (f32x4){s[0], s[1], s[2], s[3]} * (1.0f / 256.0f); *(f32x4*)(o + 4) = (f32x4){s[4], s[5], s[6], s[7]} * (1.0f / 256.0f); }
}
DI void p5_ln(const Args& a, const Frame& F) {
    const int gw = F.bx * NWAVES + F.wave, NGW = F.G * NWAVES;
    const f32x4* gn = (const f32x4*)a.in[11] + F.lane; const f32x4* bs = (const f32x4*)a.in[12] + F.lane;
    for (int r = gw; r < M; r += NGW) {
        f32x4* xr = (f32x4*)(a.out + (size_t)r * DM) + F.lane; f32x4 v[4]; float s = 0.f;
#pragma unroll
        for (int j = 0; j < 4; ++j) { v[j] = xr[64 * j]; s += (v[j][0] + v[j][1]) + (v[j][2] + v[j][3]); }
        const float mean = wave_sum(s) * (1.0f / DM); float s2 = 0.f;
#pragma unroll
        for (int j = 0; j < 4; ++j) { v[j] = v[j] - mean; s2 += (v[j][0] * v[j][0] + v[j][1] * v[j][1]) + (v[j][2] * v[j][2] + v[j][3] * v[j][3]); }
        const float rstd = 1.0f / sqrtf(wave_sum(s2) * (1.0f / DM) + LN_EPS);
#pragma unroll
        for (int j = 0; j < 4; ++j) xr[64 * j] = v[j] * rstd * gn[64 * j] + bs[64 * j];
    }
}
__global__ void __launch_bounds__(NTHREADS, 2) hymba_fwd(Args args) {
    extern __shared__ __attribute__((aligned(16))) unsigned char lds_raw[];
    cg::grid_group grid = cg::this_grid();
    Frame F; F.lds = (lptr)lds_raw; F.tid = threadIdx.x; F.lane = F.tid & 63; F.wave = __builtin_amdgcn_readfirstlane(F.tid >> 6); F.G = gridDim.x; F.bx = blockIdx.x;
    unsigned char* ws = args.ws;
    const int lo = args.ph_lo, hi = args.ph_hi;
    if (F.tid < 2) ((LAS unsigned*)(F.lds + LDS_MISC))[F.tid] = 0u;
    __syncthreads();
    XcdBarrier xbar; xbar.bar = nullptr; xbar.x = 0; xbar.st = nullptr;
#define IN(k) (lo <= (k) && (k) < hi)
#define SEAM(k) do { if (IN(k) && IN((k) + 1)) { if ((k) == 0 || !USE_XCD_BARRIER) grid.sync(); else xcd_barrier(xbar); } } while (0)
#ifndef USE_XCD_BARRIER
#define USE_XCD_BARRIER 1
#endif
#ifndef REPEAT_MASK
#define REPEAT_MASK 0
#endif
#define NREP(k) (((REPEAT_MASK) >> (k)) & 1 ? 2 : 1)
    for (int rep = 0; rep < NREP(0); ++rep) { if (rep) { if (USE_XCD_BARRIER) xcd_barrier(xbar); else grid.sync(); }
    if (IN(0)) { p0_prep(args, F); }
    }
    SEAM(0);
    if (USE_XCD_BARRIER && IN(0) && IN(1)) xbar = xcd_barrier_post((unsigned*)(ws + WS_CTL) + CW_BAR, (volatile LAS unsigned*)(F.lds + LDS_MISC));
    for (int rep = 0; rep < NREP(1); ++rep) { if (rep) { if (USE_XCD_BARRIER) xcd_barrier(xbar); else grid.sync(); }
    if (IN(1)) {
        pg8::Gemm g{(const bf16_t*)(ws + WS_XB), (const bf16_t*)(ws + WS_WT), M, NPROJ, DM}; pg8::StaticOrder S; S.init(M, NPROJ, F.G, F.bx);
        pg8::EpiProj E{ws};
        pg8::gemm_phase<pg8::EpiProj, pg8::StaticOrder, true, true>((PG8_LAS unsigned char*)F.lds, g, S, E);
    }
    }
    SEAM(1);
    for (int rep = 0; rep < NREP(2); ++rep) { if (rep) { if (USE_XCD_BARRIER) xcd_barrier(xbar); else grid.sync(); }
    if (IN(2)) {
        for (int it = F.bx * NWAVES + F.wave; it < 1024; it += F.G * NWAVES) p2_kmean_item(args, F, it);
        for (int it = F.bx; it < 256; it += F.G) p2_compress_item(args, F, it);
    }
    }
    SEAM(2);
    const att::AP P{ws};
    if (IN(3)) {
        for (int it = F.bx; it < 1024; it += F.G) { const int own = it & 31, bh = it >> 5; if (own > 0) att::moba_select_item(P, F.lds, bh >> 3, bh & 7, own, F.wave, F.lane, F.tid); }
    }
    SEAM(3);
    for (int rep = 0; rep < NREP(4); ++rep) { if (rep) { if (USE_XCD_BARRIER) xcd_barrier(xbar); else grid.sync(); }
    if (IN(4)) {
        LAS unsigned* pre = (LAS unsigned*)(F.lds + 70656);
        LAS unsigned* qw = (LAS unsigned*)(F.lds + 66560);
        if (F.wave == 0) {
            const unsigned* cnt = P.CNT(); unsigned loc[16]; unsigned s = 0u;
#pragma unroll
            for (int k = 0; k < 16; ++k) { loc[k] = (cnt[16 * F.lane + k] + 255u) >> 8; s += loc[k]; }
            unsigned inc = s;
#pragma unroll
            for (int o = 1; o < 64; o <<= 1) { const unsigned v = __shfl_up(inc, o); if (F.lane >= o) inc += v; }
            unsigned run = inc - s;
#pragma unroll
            for (int k = 0; k < 16; ++k) { pre[16 * F.lane + k] = run; run += loc[k]; }
            if (F.lane == 63) pre[1024] = run;
        }
        __syncthreads();
        const unsigned ntot = pre[1024];
        unsigned* qctr = (unsigned*)(ws + WS_CTL) + 8 + rep + args.rep;
        for (;;) {
            if (F.tid == 0) *qw = atomicAdd(qctr, 1u);
            __syncthreads();
            const unsigned n = *qw;
            __syncthreads();
            if (n >= ntot) break;
            int lo_ = 0, hi_ = 1024;
            while (hi_ - lo_ > 1) { const int mid = (lo_ + hi_) >> 1; if (pre[mid] <= n) lo_ = mid; else hi_ = mid; }
            att::moba_past_item(P, F.lds, lo_, (int)(n - pre[lo_]), F.wave, F.lane);
        }
    }
    }
    SEAM(4);
    for (int rep = 0; rep < NREP(5); ++rep) { if (rep) { if (USE_XCD_BARRIER) xcd_barrier(xbar); else grid.sync(); }
    if (IN(5)) {
        unsigned* qctr = (unsigned*)(ws + WS_CTL) + rep + args.rep;
        LAS unsigned* qw = (LAS unsigned*)(F.lds + 66560);
        for (;;) {
            if (F.tid == 0) *qw = atomicAdd(qctr, 1u);
            __syncthreads();
            const unsigned n = *qw;
            __syncthreads();
            if (n >= 2048u) break;
            if (n < 1024u) { const int c = 127 - (int)(n >> 3), bg = (int)(n & 7); att::nsa_item(P, F.lds, bg >> 1, bg & 1, c, F.wave, F.lane); }
            else { const unsigned k = n - 1024u; const int own = 31 - (int)(k >> 5), bh = (int)(k & 31); att::moba_own_item(P, F.lds, bh >> 3, bh & 7, own, F.wave, F.lane); }
        }
    }
    }
    SEAM(5);
    for (int rep = 0; rep < NREP(6); ++rep) { if (rep) { if (USE_XCD_BARRIER) xcd_barrier(xbar); else grid.sync(); }
    if (IN(6)) {
        pg8::Gemm g{(const bf16_t*)(ws + WS_Y), (const bf16_t*)(ws + WS_WOT), M, DM, DM}; pg8::StaticOrder S; S.init(M, DM, F.G, F.bx);
        pg8::EpiOut E{args.in[0], args.out, 1.189207115002721f};
        pg8::gemm_phase<pg8::EpiOut, pg8::StaticOrder, true, true>((PG8_LAS unsigned char*)F.lds, g, S, E);
    }
    SEAM(6);
    if (IN(7)) p5_ln(args, F);
    }
#undef IN
#undef SEAM
}
#ifndef N_LAUNCHES
#define N_LAUNCHES 1
#endif
extern "C" void kernel_launch(void* const* d_in, const int* in_sizes, int n_in, void* d_out, int out_size, void* d_ws, size_t ws_size, hipStream_t stream) {
    static int grid = 0;
    if (grid == 0) {
        if (n_in != 13 || in_sizes[0] != M * DM || out_size != M * DM || ws_size < WS_END) { fprintf(stderr, "kernel_launch: unexpected shapes (n_in %d, in0 %d, out %d, ws %zu)\n", n_in, n_in > 0 ? in_sizes[0] : -1, out_size, ws_size); grid = -1; return; }
        int dev = 0, cus = 0, per_cu = 0;
        (void)hipGetDevice(&dev); (void)hipDeviceGetAttribute(&cus, hipDeviceAttributeMultiprocessorCount, dev);
        if (hipFuncSetAttribute((const void*)hymba_fwd, hipFuncAttributeMaxDynamicSharedMemorySize, LDS_BYTES) != hipSuccess) { fprintf(stderr, "kernel_launch: hipFuncSetAttribute failed\n"); grid = -1; return; }
        if (hipOccupancyMaxActiveBlocksPerMultiprocessor(&per_cu, (const void*)hymba_fwd, NTHREADS, LDS_BYTES) != hipSuccess || per_cu < 1) { fprintf(stderr, "kernel_launch: occupancy query failed (%d)\n", per_cu); (void)hipGetLastError(); per_cu = 1; }
        grid = cus * (per_cu < 1 ? 1 : 1);
    }
    if (grid < 0) return;
    Args a{};
    for (int i = 0; i < 13; ++i) a.in[i] = (const float*)d_in[i];
    a.out = (float*)d_out; a.ws = (unsigned char*)d_ws;
#if N_LAUNCHES == 1
    a.ph_lo = 0; a.ph_hi = 8;
    void* kargs[] = {&a};
    hipError_t e = hipLaunchCooperativeKernel((const void*)hymba_fwd, dim3(grid), dim3(NTHREADS), kargs, LDS_BYTES, stream);
    if (e != hipSuccess) fprintf(stderr, "cooperative launch failed: %s (grid %d)\n", hipGetErrorString(e), grid);
#ifdef PROBE_RELAUNCH
    a.ph_lo = PROBE_RELAUNCH; a.ph_hi = PROBE_RELAUNCH_END; a.rep = 1;
    (void)hipLaunchCooperativeKernel((const void*)hymba_fwd, dim3(grid), dim3(NTHREADS), kargs, LDS_BYTES, stream);
#endif
#else
    for (int p = 0; p < 8; ++p) { a.ph_lo = p; a.ph_hi = p + 1; hipLaunchKernelGGL(hymba_fwd, dim3(grid), dim3(NTHREADS), LDS_BYTES, stream, a); }
#endif
}
```
